# Optimizing an MI355X kernel written in HIP

```python
import math
import jax, jax.numpy as jnp
from jax import lax
import numpy as np

D_MODEL = 1024
BATCH = 2
SEQ = 8192
DEPTH = 2

CHUNK = 64

A_HEADS = 4
A_HEAD_DIM = 64
A_DIM = A_HEADS * A_HEAD_DIM
LEFT_CHUNKS = 8
BAND = (LEFT_CHUNKS + 1) * CHUNK
MAX_REL = 128
N_REL = 2 * MAX_REL + 1

B_HEADS = 8
B_HEAD_DIM = 64
B_DIM = B_HEADS * B_HEAD_DIM
B_GROUPS = 2
B_STATE = 128
B_CONV = 4
XBC_DIM = B_DIM + 2 * B_GROUPS * B_STATE

C_DIM = 256
C_KERNEL = 31

D_MIX = A_DIM + B_DIM + C_DIM

OFF_Q = 0
OFF_K = OFF_Q + A_DIM
OFF_V = OFF_K + A_DIM
OFF_Z = OFF_V + A_DIM
OFF_XBC = OFF_Z + B_DIM
OFF_DT = OFF_XBC + XBC_DIM
OFF_GLU = OFF_DT + B_HEADS
N_IN = OFF_GLU + 2 * C_DIM

D_FF = int(math.ceil(8 * D_MODEL / 3 / 256) * 256)

EPS = 1e-6
NEG_INF = -1e30

kernel_name = "hybrid_chunked_attn_ssd_conformer_conv"


def rms_norm(x, g):
    xf = x.astype(jnp.float32)
    y = xf * lax.rsqrt(jnp.mean(xf * xf, axis=-1, keepdims=True) + EPS)
    return (y * g.astype(jnp.float32)).astype(x.dtype)


def layer_norm(x, g, b):
    xf = x.astype(jnp.float32)
    mu = jnp.mean(xf, axis=-1, keepdims=True)
    var = jnp.mean(jnp.square(xf - mu), axis=-1, keepdims=True)
    y = (xf - mu) * lax.rsqrt(var + EPS)
    return (y * g.astype(jnp.float32) + b.astype(jnp.float32)).astype(x.dtype)


def causal_dwconv(x, w, b):
    k, c = w.shape
    xp = jnp.pad(x, ((0, 0), (k - 1, 0), (0, 0)))
    y = lax.conv_general_dilated(
        xp, w.astype(x.dtype)[:, None, :], window_strides=(1,), padding="VALID",
        dimension_numbers=("NWC", "WIO", "NWC"), feature_group_count=c)
    return y + b.astype(x.dtype)


def chunked_rel_attention(q, k, v, rel_bias):
    bsz, s, h, dh = q.shape
    nc = s // CHUNK
    qc = q.reshape(bsz, nc, CHUNK, h, dh)
    pad = ((0, 0), (LEFT_CHUNKS * CHUNK, 0), (0, 0), (0, 0))
    kp = jnp.pad(k, pad).reshape(bsz, nc + LEFT_CHUNKS, CHUNK, h, dh)
    vp = jnp.pad(v, pad).reshape(bsz, nc + LEFT_CHUNKS, CHUNK, h, dh)
    band_idx = jnp.arange(nc)[:, None] + jnp.arange(LEFT_CHUNKS + 1)[None, :]
    kb = kp[:, band_idx].reshape(bsz, nc, BAND, h, dh)
    vb = vp[:, band_idx].reshape(bsz, nc, BAND, h, dh)
    scores = jnp.einsum("bcqhd,bckhd->bhcqk", qc, kb).astype(jnp.float32) * (dh ** -0.5)
    qi = jnp.arange(CHUNK)
    kj = jnp.arange(BAND)
    rel = qi[:, None] + LEFT_CHUNKS * CHUNK - kj[None, :]
    rel = jnp.clip(rel, -MAX_REL, MAX_REL) + MAX_REL
    bias = rel_bias.astype(jnp.float32)[:, rel]
    valid = (jnp.arange(nc)[:, None] + kj[None, :] // CHUNK) >= LEFT_CHUNKS
    scores = scores + bias[None, :, None]
    scores = jnp.where(valid[None, None, :, None, :], scores, NEG_INF)
    p = jax.nn.softmax(scores, axis=-1).astype(v.dtype)
    o = jnp.einsum("bhcqk,bckhd->bcqhd", p, vb)
    return o.reshape(bsz, s, h * dh)


def ssd_scan(x, a, bm, cm):
    bsz, s, h, p = x.shape
    nc = s // CHUNK
    rep = h // bm.shape[2]
    bh = jnp.repeat(bm, rep, axis=2).astype(jnp.float32)
    ch = jnp.repeat(cm, rep, axis=2).astype(jnp.float32)
    n = bh.shape[-1]
    xc = x.astype(jnp.float32).reshape(bsz, nc, CHUNK, h, p)
    bc = bh.reshape(bsz, nc, CHUNK, h, n)
    cc = ch.reshape(bsz, nc, CHUNK, h, n)
    ac = a.astype(jnp.float32).reshape(bsz, nc, CHUNK, h)
    a_cs = jnp.cumsum(ac, axis=2)
    causal = jnp.tril(jnp.ones((CHUNK, CHUNK), dtype=bool))[None, None, :, :, None]
    seg = a_cs[:, :, :, None, :] - a_cs[:, :, None, :, :]
    decay = jnp.exp(jnp.where(causal, seg, -jnp.inf))
    scores = jnp.einsum("bclhn,bcshn->bclsh", cc, bc) * decay
    y_diag = jnp.einsum("bclsh,bcshp->bclhp", scores, xc)
    decay_to_end = jnp.exp(a_cs[:, :, -1:, :] - a_cs)
    chunk_states = jnp.einsum("bclhn,bclh,bclhp->bchpn", bc, decay_to_end, xc)
    chunk_decay = jnp.exp(a_cs[:, :, -1, :])

    def step(state, inp):
        s_c, d_c = inp
        return state * d_c[..., None, None] + s_c, state

    init = jnp.zeros((bsz, h, p, n), dtype=chunk_states.dtype)
    _, prev = lax.scan(step, init, (jnp.moveaxis(chunk_states, 1, 0), jnp.moveaxis(chunk_decay, 1, 0)))
    prev = jnp.moveaxis(prev, 0, 1)
    y_off = jnp.einsum("bclhn,bchpn,bclh->bclhp", cc, prev, jnp.exp(a_cs))
    return (y_diag + y_off).reshape(bsz, s, h, p)


def ssd_mixer(z, xbc, dt_raw, conv_w, conv_b, dt_bias, a_log, d_skip, norm_g):
    bsz, s, _ = z.shape
    xbc = jax.nn.silu(causal_dwconv(xbc, conv_w, conv_b))
    xs = xbc[..., :B_DIM].reshape(bsz, s, B_HEADS, B_HEAD_DIM)
    bm = xbc[..., B_DIM:B_DIM + B_GROUPS * B_STATE].reshape(bsz, s, B_GROUPS, B_STATE)
    cm = xbc[..., B_DIM + B_GROUPS * B_STATE:].reshape(bsz, s, B_GROUPS, B_STATE)
    dt = jax.nn.softplus(dt_raw.astype(jnp.float32) + dt_bias.astype(jnp.float32))
    a = -jnp.exp(a_log.astype(jnp.float32))
    y = ssd_scan(xs.astype(jnp.float32) * dt[..., None], dt * a, bm, cm)
    y = y + xs.astype(jnp.float32) * d_skip.astype(jnp.float32)[:, None]
    y = y.reshape(bsz, s, B_DIM) * jax.nn.silu(z.astype(jnp.float32))
    yg = y.reshape(bsz, s, B_GROUPS, B_DIM // B_GROUPS)
    yg = yg * lax.rsqrt(jnp.mean(yg * yg, axis=-1, keepdims=True) + EPS)
    y = yg.reshape(bsz, s, B_DIM) * norm_g.astype(jnp.float32)
    return y.astype(z.dtype)


def conformer_conv(u, dw_w, dw_b, ln_g, ln_b):
    a, g = jnp.split(u, 2, axis=-1)
    h = a * jax.nn.sigmoid(g)
    h = causal_dwconv(h, dw_w, dw_b)
    h = layer_norm(h, ln_g, ln_b)
    return jax.nn.silu(h)


def setup_inputs(seed: int = 0) -> dict:
    key = jax.random.key(seed)
    ks = jax.random.split(key, 24)
    f32 = jnp.float32
    L = DEPTH
    nrm = lambda k, shape, scale: jax.random.normal(k, shape, f32) * scale
    dt0 = jnp.exp(jax.random.uniform(ks[8], (L, B_HEADS), f32, math.log(1e-3), math.log(1e-1)))
    return {
        "x": nrm(ks[0], (BATCH, SEQ, D_MODEL), 1.0),
        "norm1_g": 1.0 + nrm(ks[1], (L, D_MODEL), 0.02),
        "w_in": nrm(ks[2], (L, D_MODEL, N_IN), D_MODEL ** -0.5),
        "attn_rel_bias": nrm(ks[3], (L, A_HEADS, N_REL), 0.5),
        "ssm_conv_w": nrm(ks[4], (L, B_CONV, XBC_DIM), B_CONV ** -0.5),
        "ssm_conv_b": nrm(ks[5], (L, XBC_DIM), 0.02),
        "ssm_dt_bias": dt0 + jnp.log(-jnp.expm1(-dt0)),
        "ssm_a_log": jnp.log(jax.random.uniform(ks[6], (L, B_HEADS), f32, 1.0, 16.0)),
        "ssm_d": 1.0 + nrm(ks[7], (L, B_HEADS), 0.1),
        "ssm_norm_g": 1.0 + nrm(ks[9], (L, B_DIM), 0.02),
        "conv_dw_w": nrm(ks[10], (L, C_KERNEL, C_DIM), C_KERNEL ** -0.5),
        "conv_dw_b": nrm(ks[11], (L, C_DIM), 0.02),
        "conv_ln_g": 1.0 + nrm(ks[12], (L, C_DIM), 0.02),
        "conv_ln_b": nrm(ks[13], (L, C_DIM), 0.02),
        "w_out": nrm(ks[14], (L, D_MIX, D_MODEL), D_MIX ** -0.5),
        "norm2_g": 1.0 + nrm(ks[15], (L, D_MODEL), 0.02),
        "ffn_w_gate": nrm(ks[16], (L, D_MODEL, D_FF), D_MODEL ** -0.5),
        "ffn_w_up": nrm(ks[17], (L, D_MODEL, D_FF), D_MODEL ** -0.5),
        "ffn_w_down": nrm(ks[18], (L, D_FF, D_MODEL), D_FF ** -0.5),
        "final_norm_g": 1.0 + nrm(ks[19], (D_MODEL,), 0.02),
    }


def reference(x, norm1_g, w_in, attn_rel_bias, ssm_conv_w, ssm_conv_b, ssm_dt_bias,
              ssm_a_log, ssm_d, ssm_norm_g, conv_dw_w, conv_dw_b, conv_ln_g, conv_ln_b,
              w_out, norm2_g, ffn_w_gate, ffn_w_up, ffn_w_down, final_norm_g):
    bsz, s, _ = x.shape
    for l in range(DEPTH):
        h = rms_norm(x, norm1_g[l])
        proj = h @ w_in[l]
        q = proj[..., OFF_Q:OFF_K].reshape(bsz, s, A_HEADS, A_HEAD_DIM)
        k = proj[..., OFF_K:OFF_V].reshape(bsz, s, A_HEADS, A_HEAD_DIM)
        v = proj[..., OFF_V:OFF_Z].reshape(bsz, s, A_HEADS, A_HEAD_DIM)
        out_a = chunked_rel_attention(q, k, v, attn_rel_bias[l])
        out_b = ssd_mixer(proj[..., OFF_Z:OFF_XBC], proj[..., OFF_XBC:OFF_DT],
                          proj[..., OFF_DT:OFF_GLU], ssm_conv_w[l], ssm_conv_b[l],
                          ssm_dt_bias[l], ssm_a_log[l], ssm_d[l], ssm_norm_g[l])
        out_c = conformer_conv(proj[..., OFF_GLU:N_IN], conv_dw_w[l], conv_dw_b[l],
                               conv_ln_g[l], conv_ln_b[l])
        mix = jnp.concatenate([out_a, out_b, out_c], axis=-1)
        x = x + mix @ w_out[l]
        h = rms_norm(x, norm2_g[l])
        x = x + (jax.nn.silu(h @ ffn_w_gate[l]) * (h @ ffn_w_up[l])) @ ffn_w_down[l]
    return rms_norm(x, final_norm_g)
```

```cpp
#include <hip/hip_runtime.h>
#include <hip/hip_cooperative_groups.h>
#include <cstdio>
#include <cstdint>
namespace cg = cooperative_groups;
namespace pg8 {
#define PG8_LAS __attribute__((address_space(3)))
typedef unsigned short bf16_t;
typedef short bf16x8 __attribute__((ext_vector_type(8)));
typedef float f32x4 __attribute__((ext_vector_type(4)));
typedef unsigned u32x4 __attribute__((ext_vector_type(4)));
constexpr int BM = 256, BK = 64, HALF = 128, HTB = HALF * BK * 2  , STAGE_BYTES = 8 * HTB, NXCD = 8, WGM = 8;

__host__ __device__ __forceinline__ int lds_byte(int r, int c) { const int st = (r >> 4) * 2 + (c >> 5), rr = r & 15, cc = c & 31, ob = rr * 64 + cc * 2; return st * 1024 + (ob ^ (((ob >> 9) & 1) << 5)); }
__host__ __device__ __forceinline__ void stage_rc(int b, int& R, int& C) { const int st = b / 1024, sb = b % 1024, swz = sb ^ (((sb >> 9) & 1) << 5); R = (st >> 1) * 16 + swz / 64; C = (st & 1) * 32 + (swz % 64) / 2; }
__host__ __device__ __forceinline__ int perm32(int rho) { const int n = rho >> 4, i = rho & 15; return 8 * (i >> 2) + 4 * n + (i & 3); }

struct Unit { int pm, pn, idx; };
struct Gemm { const bf16_t* A; const bf16_t* Bt; int M, N, K; };

struct StaticOrder {
    int nM, nN, nwg, G, c;
    __host__ __device__ void init(int M, int N, int G_, int c_) { nM = M / BM; nN = N / BM; nwg = nM * nN; G = G_; c = c_; }
    __host__ __device__ bool next(int i, Unit& u) const {
        const long L = (long)i * G + c; if (L >= nwg) return false; u.idx = i;
        int wgid = (int)L; { const int q = nwg / NXCD, r = nwg % NXCD, xcd = wgid % NXCD, off = wgid / NXCD; wgid = (xcd < r ? xcd * (q + 1) : r * (q + 1) + (xcd - r) * q) + off; }
        const int nig = WGM * nN, gid = wgid / nig, fm = gid * WGM, gsz = (nM - fm) < WGM ? (nM - fm) : WGM;
        u.pm = fm + ((wgid % nig) % gsz); u.pn = (wgid % nig) / gsz; return true;
    }
    __device__ __forceinline__ void a_ready(const Unit&) const {}
    __device__ __forceinline__ void done(const Unit&) const {}
};

__device__ __forceinline__ unsigned cvt_pk_bf16(float lo, float hi) { unsigned r; asm volatile("v_cvt_pk_bf16_f32 %0, %1, %2" : "=v"(r) : "v"(lo), "v"(hi)); return r; }
__device__ __forceinline__ float shflx(float v, int mask, int lane) { return __int_as_float(__builtin_amdgcn_ds_bpermute((lane ^ mask) << 2, __float_as_int(v))); }
__device__ __forceinline__ float rstd_of(const float* ssq, int row) {
    const f32x4* p = (const f32x4*)(ssq + (size_t)row * 16);
    const f32x4 a = p[0], b = p[1], c = p[2], d = p[3];
    const float s = (((a[0] + a[1]) + (a[2] + a[3])) + ((b[0] + b[1]) + (b[2] + b[3]))) + (((c[0] + c[1]) + (c[2] + c[3])) + ((d[0] + d[1]) + (d[2] + d[3])));
    return __builtin_amdgcn_rsqf(s * (1.0f / 1024.0f) + 1e-6f);
}
__device__ __forceinline__ float silu_f(float x) { return x * __builtin_amdgcn_rcpf(1.0f + __builtin_amdgcn_exp2f(-1.4426950408889634f * x)); }
constexpr float QSCALE = 0.125f * 1.4426950408889634f;
struct EpiInProj {
    static constexpr bool PERM = true, AFTER_DRAIN = false;
    bf16_t* proj; float* dtraw; const PG8_LAS float* rsl;
    __device__ __forceinline__ void operator()(const f32x4 (&acc)[2][2][4][2], const Unit& u, int wr, int wc, int fr, int fq) const {
        const int row0 = u.pm * BM + wr * 64 + fr;
        const float sc = (u.pn == 0) ? QSCALE : 1.0f;
#pragma unroll
        for (int ai = 0; ai < 2; ++ai)
#pragma unroll
            for (int m = 0; m < 4; ++m) {
                const int row = row0 + ai * HALF + m * 16;
                const float rs = rsl[u.idx * 256 + (row & 255)] * sc;
                if (u.pn < 11) {
                    bf16_t* rowp = proj + (size_t)row * 2816 + u.pn * BM + wc * 32 + 8 * fq;
#pragma unroll
                    for (int bj = 0; bj < 2; ++bj) {
                        const f32x4 v0 = acc[ai][bj][m][0] * rs, v1 = acc[ai][bj][m][1] * rs;
                        u32x4 w; w.x = cvt_pk_bf16(v0[0], v0[1]); w.y = cvt_pk_bf16(v0[2], v0[3]); w.z = cvt_pk_bf16(v1[0], v1[1]); w.w = cvt_pk_bf16(v1[2], v1[3]);
                        *(u32x4*)(rowp + bj * HALF) = w;
                    }
                } else if (wc == 0 && fq == 0) {
                    *(f32x4*)(dtraw + (size_t)row * 8) = acc[ai][0][m][0] * rs;
                    *(f32x4*)(dtraw + (size_t)row * 8 + 4) = acc[ai][0][m][1] * rs;
                }
            }
    }
};
struct EpiResid {
    static constexpr bool PERM = true, AFTER_DRAIN = false;
    const float* base32; bf16_t* xb; float* ssq;
    __device__ __forceinline__ void operator()(const f32x4 (&acc)[2][2][4][2], const Unit& u, int wr, int wc, int fr, int fq) const {
        const int col0 = u.pn * BM + wc * 32 + 8 * fq, lane_ = fr + 16 * fq;
#pragma unroll
        for (int ai = 0; ai < 2; ++ai)
#pragma unroll
            for (int m = 0; m < 4; ++m) {
                const int row = u.pm * BM + ai * HALF + wr * 64 + m * 16 + fr;
                const size_t off = (size_t)row * 1024 + col0;
                float q = 0.f;
#pragma unroll
                for (int bj = 0; bj < 2; ++bj) {
                    f32x4 b0, b1;
                    if (base32) { b0 = *(const f32x4*)(base32 + off + bj * HALF); b1 = *(const f32x4*)(base32 + off + bj * HALF + 4); }
                    else { const u32x4 r = *(const u32x4*)(xb + off + bj * HALF);
                        b0 = (f32x4){__uint_as_float(r.x << 16), __uint_as_float(r.x & 0xffff0000u), __uint_as_float(r.y << 16), __uint_as_float(r.y & 0xffff0000u)};
                        b1 = (f32x4){__uint_as_float(r.z << 16), __uint_as_float(r.z & 0xffff0000u), __uint_as_float(r.w << 16), __uint_as_float(r.w & 0xffff0000u)}; }
                    const f32x4 o0 = b0 + acc[ai][bj][m][0], o1 = b1 + acc[ai][bj][m][1];
                    q += ((o0[0] * o0[0] + o0[1] * o0[1]) + (o0[2] * o0[2] + o0[3] * o0[3])) + ((o1[0] * o1[0] + o1[1] * o1[1]) + (o1[2] * o1[2] + o1[3] * o1[3]));
                    u32x4 w; w.x = cvt_pk_bf16(o0[0], o0[1]); w.y = cvt_pk_bf16(o0[2], o0[3]); w.z = cvt_pk_bf16(o1[0], o1[1]); w.w = cvt_pk_bf16(o1[2], o1[3]);
                    *(u32x4*)(xb + off + bj * HALF) = w;
                }
                q += shflx(q, 16, lane_); q += shflx(q, 32, lane_);
                if (fq == 0) ssq[(size_t)row * 16 + u.pn * 4 + wc] = q;
            }
    }
};
struct EpiGateUp {
    static constexpr bool PERM = true, AFTER_DRAIN = false;
    bf16_t* hdn; const PG8_LAS float* rsl;
    __device__ __forceinline__ void operator()(const f32x4 (&acc)[2][2][4][2], const Unit& u, int wr, int wc, int fr, int fq) const {
        const int row0 = u.pm * BM + wr * 64 + fr, col = u.pn * HALF + wc * 32 + 8 * fq;
#pragma unroll
        for (int ai = 0; ai < 2; ++ai)
#pragma unroll
            for (int m = 0; m < 4; ++m) {
                const int row = row0 + ai * HALF + m * 16;
                const float rs = rsl[u.idx * 256 + (row & 255)];
                const f32x4 g0 = acc[ai][0][m][0] * rs, g1 = acc[ai][0][m][1] * rs, u0 = acc[ai][1][m][0] * rs, u1 = acc[ai][1][m][1] * rs;
                u32x4 w;
                w.x = cvt_pk_bf16(silu_f(g0[0]) * u0[0], silu_f(g0[1]) * u0[1]); w.y = cvt_pk_bf16(silu_f(g0[2]) * u0[2], silu_f(g0[3]) * u0[3]);
                w.z = cvt_pk_bf16(silu_f(g1[0]) * u1[0], silu_f(g1[1]) * u1[1]); w.w = cvt_pk_bf16(silu_f(g1[2]) * u1[2], silu_f(g1[3]) * u1[3]);
                *(u32x4*)(hdn + (size_t)row * 2816 + col) = w;
            }
    }
};

struct EpiAny {
    static constexpr bool PERM = true, AFTER_DRAIN = false;
    int mode; EpiInProj e0; EpiResid e1; EpiGateUp e2;
    __device__ __forceinline__ void operator()(const f32x4 (&acc)[2][2][4][2], const Unit& u, int wr, int wc, int fr, int fq) const {
        if (mode == 0) e0(acc, u, wr, wc, fr, fq); else if (mode == 1) e1(acc, u, wr, wc, fr, fq); else e2(acc, u, wr, wc, fr, fq);
    }
};
template <class Epi, class Sched, bool ALIGN_EPI = false, bool SP2 = false>
__device__ __forceinline__ void gemm_phase(PG8_LAS unsigned char* lds, const Gemm g, const Sched& S, const Epi& E, const int tid) {
    const int wid = __builtin_amdgcn_readfirstlane(tid >> 6), lane = tid & 63, wr = wid >> 2, wc = wid & 3, fr = lane & 15, fq = lane >> 4;
    const int K = g.K, nt = K / BK;
    unsigned voffA[2], voffB[2];
#pragma unroll
    for (int i = 0; i < 2; ++i) { int R, C; stage_rc(tid * 16 + i * 8192, R, C); const int Rb = Epi::PERM ? ((R & ~31) + perm32(R & 31)) : R;
        voffA[i] = (unsigned)(R * K + C) * 2u; voffB[i] = (unsigned)(Rb * K + C) * 2u; }
    const size_t kstep = (size_t)(BK * 2);
    const size_t hstep = (size_t)HALF * K * 2;
    const size_t tstep = 2 * hstep;
    const unsigned ldsw = (unsigned)wid * 1024u;
    const int aoff = lds_byte(wr * 64 + fr, fq * 8), boff = lds_byte(wc * 32 + fr, fq * 8);
#define PG8_SA(b, h) (((b) * 2 + (h)) * HTB)
#define PG8_SB(b, h) ((4 + (b) * 2 + (h)) * HTB)
#define PG8_STAGE(bufoff, gbase, voff) do { _Pragma("unroll") for (int _i = 0; _i < 2; ++_i) \
        __builtin_amdgcn_global_load_lds((const unsigned*)((const char*)(gbase) + (voff)[_i]), (PG8_LAS unsigned*)(lds + (bufoff) + ldsw + _i * 8192), 16, 0, 0); } while (0)
#define PG8_LDA(dst, b, h) do { _Pragma("unroll") for (int m = 0; m < 4; ++m) _Pragma("unroll") for (int k = 0; k < 2; ++k) dst[m][k] = *(const PG8_LAS bf16x8*)(lds + PG8_SA(b, h) + aoff + m * 2048 + k * 1024); } while (0)
#define PG8_LDB(dst, b, h) do { _Pragma("unroll") for (int n = 0; n < 2; ++n) _Pragma("unroll") for (int k = 0; k < 2; ++k) dst[n][k] = *(const PG8_LAS bf16x8*)(lds + PG8_SB(b, h) + boff + n * 2048 + k * 1024); } while (0)
#define PG8_MMA(ai, bj, At, Bt) do { __builtin_amdgcn_s_setprio(1); _Pragma("unroll") for (int m = 0; m < 4; ++m) _Pragma("unroll") for (int n = 0; n < 2; ++n) _Pragma("unroll") for (int k = 0; k < 2; ++k) \
        acc[ai][bj][m][n] = __builtin_amdgcn_mfma_f32_16x16x32_bf16(Bt[n][k], At[m][k], acc[ai][bj][m][n], 0, 0, 0); __builtin_amdgcn_s_setprio(0); } while (0)
#define PG8_WAIT_V(n) asm volatile("s_waitcnt vmcnt(" #n ")" ::: "memory")
#define PG8_WAIT_L(n) asm volatile("s_waitcnt lgkmcnt(" #n ")" ::: "memory")
#define PG8_BAR __builtin_amdgcn_s_barrier()
#define PG8_SCHED __builtin_amdgcn_sched_barrier(0)
    Unit cur, nxt; int ui = 0;
    if (!S.next(0, cur)) return;
    f32x4 acc[2][2][4][2];
#pragma unroll
    for (int a = 0; a < 2; ++a)
#pragma unroll
        for (int b = 0; b < 2; ++b)
#pragma unroll
            for (int m = 0; m < 4; ++m)
#pragma unroll
                for (int n = 0; n < 2; ++n) acc[a][b][m][n] = (f32x4){0.f, 0.f, 0.f, 0.f};
    bf16x8 At[4][2], B0[2][2], B1[2][2];
    const char* cA = (const char*)g.A + (size_t)cur.pm * tstep; const char* cB = (const char*)g.Bt + (size_t)cur.pn * tstep;
    S.a_ready(cur);
    if constexpr (SP2) {
        PG8_STAGE(PG8_SB(0, 0), cB, voffB); PG8_STAGE(PG8_SB(0, 1), cB + hstep, voffB); PG8_STAGE(PG8_SA(0, 0), cA, voffA); PG8_STAGE(PG8_SA(0, 1), cA + hstep, voffA);
        if (wr == 1) PG8_BAR;
        PG8_WAIT_V(2); PG8_BAR;
        PG8_STAGE(PG8_SB(1, 0), cB + kstep, voffB); PG8_STAGE(PG8_SA(1, 0), cA + kstep, voffA); PG8_STAGE(PG8_SB(1, 1), cB + hstep + kstep, voffB);
        PG8_WAIT_V(6); PG8_BAR;
    } else {
        PG8_STAGE(PG8_SB(0, 0), cB, voffB); PG8_STAGE(PG8_SA(0, 0), cA, voffA); PG8_STAGE(PG8_SB(0, 1), cB + hstep, voffB); PG8_STAGE(PG8_SA(0, 1), cA + hstep, voffA);
        if (wr == 1) PG8_BAR;
        PG8_WAIT_V(4); PG8_BAR;
        PG8_STAGE(PG8_SB(1, 0), cB + kstep, voffB); PG8_STAGE(PG8_SA(1, 0), cA + kstep, voffA); PG8_STAGE(PG8_SB(1, 1), cB + hstep + kstep, voffB);
        PG8_WAIT_V(6); PG8_BAR;
    }
    for (;;) {
        const bool has_next = S.next(ui + 1, nxt);
        const char* nA = has_next ? (const char*)g.A + (size_t)nxt.pm * tstep : cA; const char* nB = has_next ? (const char*)g.Bt + (size_t)nxt.pn * tstep : cB;
        for (int t = 0; t < nt; t += 2) {
            const bool last = (t == nt - 2);
            const char* a1 = cA + (size_t)(t + 1) * kstep;
            const char* a2 = last ? nA : cA + (size_t)(t + 2) * kstep; const char* b2 = last ? nB : cB + (size_t)(t + 2) * kstep;
            const char* a3 = a2 + kstep; const char* b3 = b2 + kstep;
            if (last && has_next) S.a_ready(nxt);
            if constexpr (SP2) {
            PG8_LDB(B0, 0, 0); PG8_LDB(B1, 0, 1); PG8_SCHED; PG8_LDA(At, 0, 0); PG8_STAGE(PG8_SA(1, 1), a1 + hstep, voffA);
            PG8_WAIT_V(8); PG8_WAIT_L(0); PG8_BAR; PG8_MMA(0, 0, At, B0); PG8_MMA(0, 1, At, B1); PG8_BAR; PG8_SCHED;
            PG8_LDA(At, 0, 1); PG8_STAGE(PG8_SB(0, 0), b2, voffB); PG8_STAGE(PG8_SB(0, 1), b2 + hstep, voffB); PG8_STAGE(PG8_SA(0, 0), a2, voffA);
            PG8_WAIT_V(8); PG8_WAIT_L(0); PG8_BAR; PG8_MMA(1, 0, At, B0); PG8_MMA(1, 1, At, B1); PG8_BAR; PG8_SCHED;
            PG8_LDB(B0, 1, 0); PG8_LDB(B1, 1, 1); PG8_SCHED; PG8_LDA(At, 1, 0); PG8_STAGE(PG8_SA(0, 1), a2 + hstep, voffA);
            PG8_WAIT_V(8); PG8_WAIT_L(0); PG8_BAR; PG8_MMA(0, 0, At, B0); PG8_MMA(0, 1, At, B1); PG8_BAR; PG8_SCHED;
            PG8_LDA(At, 1, 1); PG8_STAGE(PG8_SB(1, 0), b3, voffB); PG8_STAGE(PG8_SB(1, 1), b3 + hstep, voffB); PG8_STAGE(PG8_SA(1, 0), a3, voffA);
            PG8_WAIT_V(8); PG8_WAIT_L(0); PG8_BAR; PG8_MMA(1, 0, At, B0); PG8_MMA(1, 1, At, B1); PG8_BAR; PG8_SCHED;
            } else {
            PG8_LDB(B0, 0, 0); PG8_SCHED; PG8_LDA(At, 0, 0); PG8_STAGE(PG8_SA(1, 1), a1 + hstep, voffA);
            PG8_WAIT_L(8); PG8_BAR; PG8_WAIT_L(0); PG8_MMA(0, 0, At, B0); PG8_BAR; PG8_SCHED;
            PG8_LDB(B1, 0, 1); PG8_STAGE(PG8_SB(0, 0), b2, voffB);
            PG8_BAR; PG8_WAIT_L(0); PG8_MMA(0, 1, At, B1); PG8_BAR;
            PG8_LDA(At, 0, 1); PG8_STAGE(PG8_SA(0, 0), a2, voffA);
            PG8_BAR; PG8_WAIT_L(0); PG8_MMA(1, 0, At, B0); PG8_BAR; PG8_SCHED;
            PG8_STAGE(PG8_SB(0, 1), b2 + hstep, voffB);
            PG8_WAIT_V(6); PG8_BAR; PG8_MMA(1, 1, At, B1); PG8_BAR;
            PG8_LDB(B0, 1, 0); PG8_SCHED; PG8_LDA(At, 1, 0); PG8_STAGE(PG8_SA(0, 1), a2 + hstep, voffA);
            PG8_WAIT_L(8); PG8_BAR; PG8_WAIT_L(0); PG8_MMA(0, 0, At, B0); PG8_BAR; PG8_SCHED;
            PG8_LDB(B1, 1, 1); PG8_STAGE(PG8_SB(1, 0), b3, voffB);
            PG8_BAR; PG8_WAIT_L(0); PG8_MMA(0, 1, At, B1); PG8_BAR;
            PG8_LDA(At, 1, 1); PG8_STAGE(PG8_SA(1, 0), a3, voffA);
            PG8_BAR; PG8_WAIT_L(0); PG8_MMA(1, 0, At, B0); PG8_BAR; PG8_SCHED;
            PG8_STAGE(PG8_SB(1, 1), b3 + hstep, voffB);
            PG8_WAIT_V(6); PG8_BAR; PG8_MMA(1, 1, At, B1); PG8_BAR;
            }
        }
        if constexpr (ALIGN_EPI) { if (wr == 0) PG8_BAR; }
        if constexpr (!Epi::AFTER_DRAIN) { E(acc, cur, wr, wc, fr, fq); S.done(cur); }
        if (!has_next) break;
#pragma unroll
        for (int a = 0; a < 2; ++a)
#pragma unroll
            for (int b = 0; b < 2; ++b)
#pragma unroll
                for (int m = 0; m < 4; ++m)
#pragma unroll
                    for (int n = 0; n < 2; ++n) acc[a][b][m][n] = (f32x4){0.f, 0.f, 0.f, 0.f};
        cur = nxt; cA = nA; cB = nB; ++ui;
        if constexpr (ALIGN_EPI) { if (wr == 1) PG8_BAR; }
    }
    PG8_WAIT_V(0);
    if constexpr (!ALIGN_EPI) { if (wr == 0) PG8_BAR; }
    PG8_BAR;
    if constexpr (Epi::AFTER_DRAIN) { E.fused(acc, cur, wr, wc, fr, fq, lds, wid, lane); S.done(cur); }
#undef PG8_SA
#undef PG8_SB
#undef PG8_STAGE
#undef PG8_LDA
#undef PG8_LDB
#undef PG8_MMA
#undef PG8_WAIT_V
#undef PG8_WAIT_L
#undef PG8_BAR
#undef PG8_SCHED
}
}

#define LAS __attribute__((address_space(3)))
typedef unsigned short bf16;
typedef float f32x4 __attribute__((ext_vector_type(4)));
typedef float f32x2 __attribute__((ext_vector_type(2)));
typedef short bf16x8 __attribute__((ext_vector_type(8)));
typedef unsigned u32x4 __attribute__((ext_vector_type(4)));
typedef unsigned u32x2 __attribute__((ext_vector_type(2)));
typedef __bf16 bf16x2_t __attribute__((ext_vector_type(2)));
typedef short s16x4 __attribute__((ext_vector_type(4)));

constexpr int M = 16384, DM = 1024, NPROJ = 2816, NCHUNK = 256;
constexpr int PJ_Q = 0, PJ_K = 256, PJ_V = 512, PJ_Z = 768, PJ_XBC = 1280, PJ_GLU = 2304;
constexpr int MX_A = 0, MX_B = 256, MX_C = 768;
constexpr size_t MiB = 1u << 20;
constexpr size_t WS_SSQ = 1 * MiB, WS_DT = 2 * MiB, WS_CD = 2 * MiB + 512 * 1024, WS_WIN = 4 * MiB, WS_WOUT = 16 * MiB, WS_WGU = 20 * MiB, WS_WDN = 42 * MiB,
                 WS_XB = 54 * MiB, WS_MIX = 86 * MiB, WS_ST = 118 * MiB, WS_PROJ = 150 * MiB, WS_END = 238 * MiB;
constexpr int LDS_BYTES = 153600;
constexpr float LOG2E = 1.4426950408889634f;
constexpr int NPHASES = 16;

__device__ __forceinline__ float bflo(unsigned u) { return __uint_as_float(u << 16); }
__device__ __forceinline__ float bfhi(unsigned u) { return __uint_as_float(u & 0xffff0000u); }
__device__ __forceinline__ float bf2f(bf16 h) { return __uint_as_float((unsigned)h << 16); }
__device__ __forceinline__ unsigned pk2(float lo, float hi) { f32x2 v = {lo, hi}; bf16x2_t b = __builtin_convertvector(v, bf16x2_t); return __builtin_bit_cast(unsigned, b); }
__device__ __forceinline__ bf16 f2bf(float f) { return (bf16)(pk2(f, 0.f) & 0xffffu); }
__device__ __forceinline__ f32x4 mfma16(bf16x8 a, bf16x8 b, f32x4 c) { return __builtin_amdgcn_mfma_f32_16x16x32_bf16(a, b, c, 0, 0, 0); }
__device__ __forceinline__ float fsilu(float x) { return x * __builtin_amdgcn_rcpf(1.0f + __builtin_amdgcn_exp2f(-LOG2E * x)); }
__device__ __forceinline__ float fsigmoid(float x) { return __builtin_amdgcn_rcpf(1.0f + __builtin_amdgcn_exp2f(-LOG2E * x)); }
__device__ __forceinline__ float fexp(float x) { return __builtin_amdgcn_exp2f(LOG2E * x); }
using pg8::shflx;
__device__ __forceinline__ float wave_sum(float v, int lane) {
#pragma unroll
    for (int o = 1; o < 64; o <<= 1) v += shflx(v, o, lane);
    return v;
}

template <class T> __device__ __forceinline__ T* launder(T* p) { asm volatile("" : "+s"(p)); return p; }
struct Args { const float* in[20]; float* out; unsigned char* ws; int ph_lo, ph_hi, coop, pad; };
struct Ctx {
    LAS unsigned char* lds; int tid, lane, wave, bid, nblk;
    const float* in[20]; float* out;
    bf16 *Win, *Wout, *Wgu, *Wdn, *xb, *mix, *states, *proj;
    float *ssq, *dtraw, *cdecay;
};

struct P0Item { const float* W; const float* gain; bf16* WT; int nsrc, col, valid, K, drow, k0; };
__device__ __forceinline__ P0Item p0_decode(const Ctx& C, int it) {
    constexpr int I_IN = 16 * 96, I_OUT = 16 * 32, I_GU = 16 * 176, I_DN = 44 * 32, I_L = I_IN + I_OUT + I_GU + I_DN;
    P0Item P; const int l = it / I_L; int r = it % I_L;
    if (r < I_IN) {
        const int kb = r / 96, n0 = 32 * (r % 96);
        int col, valid;
        if (n0 < 2304) { col = n0; valid = 32; } else if (n0 < 2816) { col = n0 + 8; valid = 32; } else if (n0 == 2816) { col = 2304; valid = 8; } else { col = 0; valid = 0; }
        P.W = C.in[2] + (size_t)l * 1024 * 2824; P.nsrc = 2824; P.col = col; P.valid = valid; P.gain = C.in[1] + l * 1024; P.K = 1024; P.WT = C.Win + (size_t)l * 3072 * 1024; P.drow = n0; P.k0 = 64 * kb;
        return P;
    }
    r -= I_IN;
    if (r < I_OUT) { const int kb = r / 32, n0 = 32 * (r % 32);
        P.W = C.in[14] + (size_t)l * 1024 * 1024; P.nsrc = 1024; P.col = n0; P.valid = 32; P.gain = nullptr; P.K = 1024; P.WT = C.Wout + (size_t)l * 1024 * 1024; P.drow = n0; P.k0 = 64 * kb; return P; }
    r -= I_OUT;
    if (r < I_GU) { const int kb = r / 176, n0 = 32 * (r % 176); const int t = n0 >> 8, hs = (n0 >> 7) & 1, i = n0 & 127;
        P.W = (hs ? C.in[17] : C.in[16]) + (size_t)l * 1024 * 2816; P.nsrc = 2816; P.col = 128 * t + i; P.valid = 32; P.gain = C.in[15] + l * 1024; P.K = 1024; P.WT = C.Wgu + (size_t)l * 5632 * 1024; P.drow = n0; P.k0 = 64 * kb; return P; }
    r -= I_GU;
    { const int kb = r / 32, n0 = 32 * (r % 32);
        P.W = C.in[18] + (size_t)l * 2816 * 1024; P.nsrc = 1024; P.col = n0; P.valid = 32; P.gain = nullptr; P.K = 2816; P.WT = C.Wdn + (size_t)l * 1024 * 2816; P.drow = n0; P.k0 = 64 * kb; return P; }
}
__device__ __forceinline__ void p0_load(const P0Item& P, float (&wv)[32], int lane) {
    const int c31 = lane & 31;
#pragma unroll
    for (int i = 0; i < 32; ++i) { const int kk = 2 * i + (lane >> 5); wv[i] = (c31 < P.valid) ? P.W[(size_t)(P.k0 + kk) * P.nsrc + P.col + c31] : 0.f; }
}
__device__ __forceinline__ void p0_finish(const P0Item& P, float (&wv)[32], LAS float* scr, int lane) {
    const int c31 = lane & 31;
    if (P.gain) {
#pragma unroll
        for (int i = 0; i < 32; ++i) wv[i] *= P.gain[P.k0 + 2 * i + (lane >> 5)];
    }
#pragma unroll
    for (int i = 0; i < 32; ++i) scr[(2 * i + (lane >> 5)) * 33 + c31] = wv[i];
    const int c = lane & 7;
#pragma unroll
    for (int j = 0; j < 4; ++j) {
        const int n = (lane >> 3) + 8 * j; const LAS float* s = scr + (8 * c) * 33 + n;
        u32x4 o; o.x = pk2(s[0 * 33], s[1 * 33]); o.y = pk2(s[2 * 33], s[3 * 33]); o.z = pk2(s[4 * 33], s[5 * 33]); o.w = pk2(s[6 * 33], s[7 * 33]);
        *(u32x4*)(P.WT + (size_t)(P.drow + n) * P.K + P.k0 + 8 * c) = o;
    }
}
__device__ __forceinline__ void p0_convert(const Ctx& C, int it_begin, int it_end, int gw, int NGW, LAS float* scr, int lane) {
#pragma unroll 1
    for (int it = it_begin + gw; it < it_end; it += NGW) {
        float wa[32];
        const P0Item pa = p0_decode(C, it);
        p0_load(pa, wa, lane);
        p0_finish(pa, wa, scr, lane);
    }
}
constexpr int P0_FIRST = 16 * 96;
constexpr int P0_SPLIT = (16 * 96 + 16 * 32 + 16 * 176 + 44 * 32) + 16 * 96;
constexpr int P0_ALL = 2 * (16 * 96 + 16 * 32 + 16 * 176 + 44 * 32);
#ifndef M1P
#define M1P 7
#endif
__device__ __forceinline__ void ssd_dt_acs(const Ctx& C, int layer, int ck, LAS float* sDT, LAS float* sACS, LAS float* sW, bool has_w, int lane, int wave) {
    const int h = wave, t0 = ck * 64;
    const float raw = C.dtraw[(size_t)(t0 + lane) * 8 + h] + C.in[6][layer * 8 + h];
    const float dt = fmaxf(raw, 0.f) + log1pf(expf(-fabsf(raw)));
    const float av = -expf(C.in[7][layer * 8 + h]) * dt;
    float cs = av;
#pragma unroll
    for (int o = 1; o < 64; o <<= 1) { const float v = __int_as_float(__builtin_amdgcn_ds_bpermute(((lane - o) & 63) << 2, __float_as_int(cs))); if (lane >= o) cs += v; }
    const float aend = __int_as_float(__builtin_amdgcn_readlane(__float_as_int(cs), 63));
    sDT[h * 64 + lane] = dt; sACS[h * 64 + lane] = cs;
    if (has_w) { sW[h * 64 + lane] = dt * expf(aend - cs); if (lane == 63) C.cdecay[ck * 8 + h] = expf(cs); }
}

__device__ __forceinline__ void mix1_phase(const Ctx& C, int layer) {
    LAS float* sDT = (LAS float*)(C.lds); LAS float* sACS = (LAS float*)(C.lds + 2048); LAS float* sW = (LAS float*)(C.lds + 4096);
    LAS bf16* sT = (LAS bf16*)(C.lds + 8192);
    LAS float* sBias = (LAS float*)(C.lds + 122880);
    for (int i = C.tid; i < 4 * 257; i += 512) sBias[i] = C.in[3][layer * 4 * 257 + i] * LOG2E;
    for (int ck = ((C.nblk & 7) == 0 ? (C.bid & 7) * (C.nblk >> 3) + (C.bid >> 3) : C.bid); ck < NCHUNK; ck += C.nblk) {
        int tid = C.tid; asm volatile("" : "+v"(tid));
        const int lane = tid & 63, wave = __builtin_amdgcn_readfirstlane(tid >> 6), fr = lane & 15, fq = lane >> 4;
        const int cin = ck & 127, t0 = ck * 64; const bool first = (cin == 0);
        const float* cw = launder(C.in[4]) + (size_t)layer * 4 * 1024; const float* cb = launder(C.in[5]) + layer * 1024;
        ssd_dt_acs(C, layer, ck, sDT, sACS, sW, true, lane, wave);
        __syncthreads();
        if (tid < 384) {
            const int ch0 = 2 * tid;
            const f32x2 w0 = *(const f32x2*)(cw + 0 * 1024 + ch0), w1 = *(const f32x2*)(cw + 1 * 1024 + ch0), w2 = *(const f32x2*)(cw + 2 * 1024 + ch0), w3 = *(const f32x2*)(cw + 3 * 1024 + ch0);
            const f32x2 bb = *(const f32x2*)(cb + ch0);
            const unsigned* src = (const unsigned*)(C.proj + (size_t)t0 * NPROJ + PJ_XBC + ch0);
            f32x2 xm3 = {0.f, 0.f}, xm2 = {0.f, 0.f}, xm1 = {0.f, 0.f};
            if (!first) { const unsigned a = src[-3 * (NPROJ / 2)], b = src[-2 * (NPROJ / 2)], c = src[-1 * (NPROJ / 2)];
                xm3 = (f32x2){bflo(a), bfhi(a)}; xm2 = (f32x2){bflo(b), bfhi(b)}; xm1 = (f32x2){bflo(c), bfhi(c)}; }
            const int hh = ch0 >> 6; const bool isx = ch0 < 512;
#pragma unroll 1
            for (int l0 = 0; l0 < 64; l0 += 16) {
            unsigned uu[16];
#pragma unroll
            for (int i = 0; i < 16; ++i) uu[i] = src[(l0 + i) * (NPROJ / 2)];
#pragma unroll
            for (int li = 0; li < 16; li += 2) {
                const int l = l0 + li;
                const unsigned ua = uu[li], ub = uu[li + 1];
                const f32x2 xa = {bflo(ua), bfhi(ua)}, xc = {bflo(ub), bfhi(ub)};
                f32x2 ya = bb + w0 * xm3 + w1 * xm2 + w2 * xm1 + w3 * xa;
                f32x2 yb = bb + w0 * xm2 + w1 * xm1 + w2 * xa + w3 * xc;
                xm3 = xm1; xm2 = xa; xm1 = xc;
                ya.x = fsilu(ya.x); ya.y = fsilu(ya.y); yb.x = fsilu(yb.x); yb.y = fsilu(yb.y);
                if (isx) { const float wa = sW[hh * 64 + l], wb = sW[hh * 64 + l + 1]; ya = ya * wa; yb = yb * wb; }
                *(LAS unsigned*)(sT + ch0 * 72 + l) = pk2(ya.x, yb.x);
                *(LAS unsigned*)(sT + (ch0 + 1) * 72 + l) = pk2(ya.y, yb.y);
            }
            }
        }
        __syncthreads();
        if (M1P & 1) {
            const int h = wave, g = h >> 2;
            bf16x8 xf[4][2];
#pragma unroll
            for (int pt = 0; pt < 4; ++pt)
#pragma unroll
                for (int ks = 0; ks < 2; ++ks) xf[pt][ks] = *(const LAS bf16x8*)(sT + (h * 64 + 16 * pt + fr) * 72 + 32 * ks + 8 * fq);
            bf16* st = C.states + (size_t)(ck * 8 + h) * 64 * 128;
#pragma unroll 1
            for (int nt = 0; nt < 8; ++nt) {
                bf16x8 bfr[2];
#pragma unroll
                for (int ks = 0; ks < 2; ++ks) bfr[ks] = *(const LAS bf16x8*)(sT + (512 + g * 128 + 16 * nt + fr) * 72 + 32 * ks + 8 * fq);
#pragma unroll
                for (int pt = 0; pt < 4; ++pt) {
                    f32x4 acc = {0.f, 0.f, 0.f, 0.f};
#pragma unroll
                    for (int ks = 0; ks < 2; ++ks) acc = mfma16(bfr[ks], xf[pt][ks], acc);
                    u32x2 w; w.x = pk2(acc[0], acc[1]); w.y = pk2(acc[2], acc[3]);
                    *(u32x2*)(st + (16 * pt + fr) * 128 + 16 * nt + 4 * fq) = w;
                }
            }
        }
        __syncthreads();
        if (M1P & 2) {
            LAS bf16* G = (LAS bf16*)(C.lds + 8192);
            LAS float* CO = (LAS float*)(C.lds + 8192 + 48128);
            const int c = tid & 255, half = tid >> 8;
#pragma unroll
            for (int it = 0; it < 6; ++it) {
                const int u = tid + 512 * it, r = u >> 5, c8 = u & 31;
                if (u < 94 * 32) {
                    u32x4 o = {0u, 0u, 0u, 0u};
                    if (!(first && r < 30)) {
                        const bf16* p = C.proj + (size_t)(t0 - 30 + r) * NPROJ + PJ_GLU + 8 * c8;
                        const u32x4 av = *(const u32x4*)p, gv = *(const u32x4*)(p + 256);
#pragma unroll
                        for (int e = 0; e < 4; ++e) o[e] = pk2(bflo(av[e]) * fsigmoid(bflo(gv[e])), bfhi(av[e]) * fsigmoid(bfhi(gv[e])));
                    }
                    *(LAS u32x4*)(G + r * 256 + 8 * c8) = o;
                }
            }
            __syncthreads();
            {
                const float* dww = launder(C.in[10]) + (size_t)layer * 31 * 256 + c;
                float w[31];
#pragma unroll
                for (int k = 0; k < 31; ++k) w[k] = dww[k * 256];
                const float bias = launder(C.in[11])[layer * 256 + c];
#pragma unroll 1
                for (int grp = 0; grp < 4; ++grp) {
                    float o[8];
#pragma unroll
                    for (int i = 0; i < 8; ++i) o[i] = bias;
                    const LAS bf16* gp = G + (half * 32 + grp * 8) * 256 + c;
#pragma unroll
                    for (int r = 0; r < 38; ++r) {
                        const float v = bf2f(gp[r * 256]);
#pragma unroll
                        for (int i = 0; i < 8; ++i) { const int k = r - i; if (k >= 0 && k <= 30) o[i] += w[k] * v; }
                    }
#pragma unroll
                    for (int i = 0; i < 8; ++i) CO[(half * 32 + grp * 8 + i) * 256 + c] = o[i];
                }
            }
            __syncthreads();
            {
                const f32x4 lg = *((const f32x4*)(launder(C.in[12]) + layer * 256) + lane), lb = *((const f32x4*)(launder(C.in[13]) + layer * 256) + lane);
#pragma unroll 2
                for (int i = 0; i < 8; ++i) {
                    const int l = wave * 8 + i;
                    const f32x4 v = *((const LAS f32x4*)(CO + l * 256) + lane);
                    const float s = wave_sum((v[0] + v[1]) + (v[2] + v[3]), lane);
                    const float mu = s * (1.f / 256.f);
                    const f32x4 d = v - mu;
                    const float s2 = wave_sum((d[0] * d[0] + d[1] * d[1]) + (d[2] * d[2] + d[3] * d[3]), lane);
                    const float rstd = 1.0f / sqrtf(s2 * (1.f / 256.f) + 1e-6f);
                    const f32x4 y = d * rstd * lg + lb;
                    u32x2 w; w.x = pk2(fsilu(y[0]), fsilu(y[1])); w.y = pk2(fsilu(y[2]), fsilu(y[3]));
                    *((u32x2*)(C.mix + (size_t)(t0 + l) * DM + MX_C) + lane) = w;
                }
            }
        }
        __syncthreads();
        if (M1P & 4) {
            LAS bf16* sK = (LAS bf16*)(C.lds + 8192);
            LAS bf16* sV = (LAS bf16*)(C.lds + 8192 + 33792);
            const int h = wave >> 1, qh = wave & 1, q4 = (lane & 15) >> 2, p4 = lane & 3;
            bf16x8 qf[2][2];
#pragma unroll
            for (int qt = 0; qt < 2; ++qt)
#pragma unroll
                for (int ks = 0; ks < 2; ++ks) qf[qt][ks] = *(const bf16x8*)(C.proj + (size_t)(t0 + 32 * qh + 16 * qt + fr) * NPROJ + PJ_Q + h * 64 + 32 * ks + 8 * fq);
            float mrun[2] = {-1e30f, -1e30f}, lsum[2] = {0.f, 0.f};
            f32x4 oacc[4][2];
#pragma unroll
            for (int dt = 0; dt < 4; ++dt)
#pragma unroll
                for (int qt = 0; qt < 2; ++qt) oacc[dt][qt] = (f32x4){0.f, 0.f, 0.f, 0.f};
            const int jmin = cin >= 8 ? 0 : 8 - cin;
            u32x4 kreg[4], vreg[4];
#define ATT_LOAD(jj) do { const bf16* base_ = C.proj + (size_t)(t0 + ((jj) - 8) * 64) * NPROJ; _Pragma("unroll") for (int i = 0; i < 4; ++i) { const int u = tid + 512 * i, row = u >> 5, c8 = u & 31; \
                kreg[i] = *(const u32x4*)(base_ + (size_t)row * NPROJ + PJ_K + 8 * c8); vreg[i] = *(const u32x4*)(base_ + (size_t)row * NPROJ + PJ_V + 8 * c8); } } while (0)
            ATT_LOAD(jmin);
            for (int j = jmin; j <= 8; ++j) {
#pragma unroll
                for (int i = 0; i < 4; ++i) { const int u = tid + 512 * i, row = u >> 5, c8 = u & 31;
                    *(LAS u32x4*)(sK + row * 264 + 8 * c8) = kreg[i]; *(LAS u32x4*)(sV + row * 264 + 8 * c8) = vreg[i]; }
                __syncthreads();
                if (j < 8) ATT_LOAD(j + 1);
                f32x4 st[4][2];
#pragma unroll
                for (int kt = 0; kt < 4; ++kt) {
                    bf16x8 kf[2];
#pragma unroll
                    for (int ks = 0; ks < 2; ++ks) kf[ks] = *(const LAS bf16x8*)(sK + (16 * kt + fr) * 264 + h * 64 + 32 * ks + 8 * fq);
#pragma unroll
                    for (int qt = 0; qt < 2; ++qt) { f32x4 acc = {0.f, 0.f, 0.f, 0.f};
#pragma unroll
                        for (int ks = 0; ks < 2; ++ks) acc = mfma16(kf[ks], qf[qt][ks], acc);
                        st[kt][qt] = acc; }
                }
                if (j >= 6) {
#pragma unroll
                    for (int kt = 0; kt < 4; ++kt)
#pragma unroll
                        for (int qt = 0; qt < 2; ++qt)
#pragma unroll
                            for (int e = 0; e < 4; ++e) {
                                const int rel = (32 * qh + 16 * qt + fr) + 512 - 64 * j - (16 * kt + 4 * fq + e);
                                const int idx = (rel < -128 ? -128 : (rel > 128 ? 128 : rel)) + 128;
                                st[kt][qt][e] += sBias[h * 257 + idx];
                            }
                } else {
                    const float bc = sBias[h * 257 + 256];
#pragma unroll
                    for (int kt = 0; kt < 4; ++kt)
#pragma unroll
                        for (int qt = 0; qt < 2; ++qt) st[kt][qt] = st[kt][qt] + bc;
                }
#pragma unroll
                for (int qt = 0; qt < 2; ++qt) {
                    float mx = -1e30f;
#pragma unroll
                    for (int kt = 0; kt < 4; ++kt)
#pragma unroll
                        for (int e = 0; e < 4; ++e) mx = fmaxf(mx, st[kt][qt][e]);
                    mx = fmaxf(mx, shflx(mx, 16, lane)); mx = fmaxf(mx, shflx(mx, 32, lane));
                    const float mnew = fmaxf(mrun[qt], mx), alpha = __builtin_amdgcn_exp2f(mrun[qt] - mnew);
                    mrun[qt] = mnew;
                    float ps = 0.f;
#pragma unroll
                    for (int kt = 0; kt < 4; ++kt)
#pragma unroll
                        for (int e = 0; e < 4; ++e) { const float p = __builtin_amdgcn_exp2f(st[kt][qt][e] - mnew); st[kt][qt][e] = p; ps += p; }
                    lsum[qt] = lsum[qt] * alpha + ps;
#pragma unroll
                    for (int dt = 0; dt < 4; ++dt) oacc[dt][qt] = oacc[dt][qt] * alpha;
                }
                bf16x8 pf[2][2];
#pragma unroll
                for (int s2 = 0; s2 < 2; ++s2)
#pragma unroll
                    for (int qt = 0; qt < 2; ++qt) {
                        u32x4 w; w.x = pk2(st[2 * s2][qt][0], st[2 * s2][qt][1]); w.y = pk2(st[2 * s2][qt][2], st[2 * s2][qt][3]);
                        w.z = pk2(st[2 * s2 + 1][qt][0], st[2 * s2 + 1][qt][1]); w.w = pk2(st[2 * s2 + 1][qt][2], st[2 * s2 + 1][qt][3]);
                        pf[s2][qt] = __builtin_bit_cast(bf16x8, w);
                    }
#pragma unroll
                for (int dt = 0; dt < 4; ++dt)
#pragma unroll
                    for (int s2 = 0; s2 < 2; ++s2) {
                        const s16x4 lo = __builtin_amdgcn_ds_read_tr16_b64_v4i16((LAS s16x4*)(sV + (32 * s2 + 4 * fq + q4) * 264 + h * 64 + 16 * dt + 4 * p4));
                        const s16x4 hi = __builtin_amdgcn_ds_read_tr16_b64_v4i16((LAS s16x4*)(sV + (32 * s2 + 16 + 4 * fq + q4) * 264 + h * 64 + 16 * dt + 4 * p4));
                        const bf16x8 vf = __builtin_shufflevector(lo, hi, 0, 1, 2, 3, 4, 5, 6, 7);
#pragma unroll
                        for (int qt = 0; qt < 2; ++qt) oacc[dt][qt] = mfma16(vf, pf[s2][qt], oacc[dt][qt]);
                    }
                __syncthreads();
            }
#undef ATT_LOAD
#pragma unroll
            for (int qt = 0; qt < 2; ++qt) {
                float l = lsum[qt]; l += shflx(l, 16, lane); l += shflx(l, 32, lane);
                const float inv = 1.0f / l;
                bf16* op = C.mix + (size_t)(t0 + 32 * qh + 16 * qt + fr) * DM + MX_A + h * 64 + 4 * fq;
#pragma unroll
                for (int dt = 0; dt < 4; ++dt) { u32x2 w; w.x = pk2(oacc[dt][qt][0] * inv, oacc[dt][qt][1] * inv); w.y = pk2(oacc[dt][qt][2] * inv, oacc[dt][qt][3] * inv);
                    *(u32x2*)(op + 16 * dt) = w; }
            }
        }
        __syncthreads();
    }
}

__device__ __forceinline__ void aux_phase(const Ctx& C, int mode, int layer) {
    int cb = 0, ce = 0, gw = 0, ngw = 1;
    if (mode == 0) {
        const int NGW = C.nblk * 8; gw = C.bid * 8 + C.wave; const int lane = C.lane;
        const float* x = C.in[0];
    for (int row0 = gw * 2; row0 < M; row0 += NGW * 2) {
        f32x4 v[2][4];
#pragma unroll
        for (int r = 0; r < 2; ++r)
#pragma unroll
            for (int j = 0; j < 4; ++j) v[r][j] = *((const f32x4*)(x + (size_t)(row0 + r) * DM) + lane + 64 * j);
#pragma unroll
        for (int r = 0; r < 2; ++r) {
            float s = 0.f;
#pragma unroll
            for (int j = 0; j < 4; ++j) s += (v[r][j][0] * v[r][j][0] + v[r][j][1] * v[r][j][1]) + (v[r][j][2] * v[r][j][2] + v[r][j][3] * v[r][j][3]);
            s = wave_sum(s, lane);
            u32x2* o = (u32x2*)(C.xb + (size_t)(row0 + r) * DM) + lane;
#pragma unroll
            for (int j = 0; j < 4; ++j) { u32x2 w; w.x = pk2(v[r][j][0], v[r][j][1]); w.y = pk2(v[r][j][2], v[r][j][3]); o[64 * j] = w; }
            if (lane < 16) C.ssq[(size_t)(row0 + r) * 16 + lane] = (lane == 0) ? s : 0.f;
        }
    }

        cb = 0; ce = P0_FIRST; ngw = NGW;
    } else if (C.tid < 256) {
        for (int gt = C.bid * 256 + C.tid; gt < 65536; gt += C.nblk * 256) {
            const int b = gt >> 15, e2 = gt & 32767, h = __builtin_amdgcn_readfirstlane(e2 >> 12);
            const unsigned* p = (const unsigned*)C.states + (size_t)b * 128 * 32768 + e2;
            unsigned* q = (unsigned*)C.states + (size_t)b * 128 * 32768 + e2;
            const float* cd = C.cdecay + __builtin_amdgcn_readfirstlane(b) * 128 * 8 + h;
            float s0 = 0.f, s1 = 0.f;
#pragma unroll 1
            for (int c0 = 0; c0 < 128; c0 += 16) {
                unsigned u[16];
#pragma unroll
                for (int i = 0; i < 16; ++i) u[i] = p[(size_t)(c0 + i) * 32768];
#pragma unroll
                for (int i = 0; i < 16; ++i) { const float d = cd[(c0 + i) * 8]; q[(size_t)(c0 + i) * 32768] = pk2(s0, s1); s0 = s0 * d + bflo(u[i]); s1 = s1 * d + bfhi(u[i]); }
            }
        }
    } else { cb = layer == 0 ? P0_FIRST : P0_SPLIT; ce = layer == 0 ? P0_SPLIT : P0_ALL; gw = C.bid * 4 + (C.wave - 4); ngw = C.nblk * 4; }
    if (ce > cb) p0_convert(C, cb, ce, gw, ngw, (LAS float*)(C.lds + C.wave * 8448), C.lane);
}

__device__ __forceinline__ void mix3_phase(const Ctx& C, int layer) {
    LAS float* sDT = (LAS float*)(C.lds); LAS float* sACS = (LAS float*)(C.lds + 2048); LAS float* sPART = (LAS float*)(C.lds + 4096);
    LAS bf16* sC = (LAS bf16*)(C.lds + 8192);
    LAS bf16* sB = (LAS bf16*)(C.lds + 41984);
    LAS float* sCB = (LAS float*)(C.lds + 41984);
    LAS bf16* sXT = (LAS bf16*)(C.lds + 75776);
    for (int ck = ((C.nblk & 7) == 0 ? (C.bid & 7) * (C.nblk >> 3) + (C.bid >> 3) : C.bid); ck < NCHUNK; ck += C.nblk) {
        int tid = C.tid; asm volatile("" : "+v"(tid));
        const int lane = tid & 63, wave = __builtin_amdgcn_readfirstlane(tid >> 6), fr = lane & 15, fq = lane >> 4;
        const int cin = ck & 127, t0 = ck * 64; const bool first = (cin == 0);
        const float* cw = launder(C.in[4]) + (size_t)layer * 4 * 1024; const float* cb = launder(C.in[5]) + layer * 1024;
        ssd_dt_acs(C, layer, ck, sDT, sACS, sPART, false, lane, wave);
        {
            const int ch0 = 2 * tid;
            const f32x2 w0 = *(const f32x2*)(cw + 0 * 1024 + ch0), w1 = *(const f32x2*)(cw + 1 * 1024 + ch0), w2 = *(const f32x2*)(cw + 2 * 1024 + ch0), w3 = *(const f32x2*)(cw + 3 * 1024 + ch0);
            const f32x2 bb = *(const f32x2*)(cb + ch0);
            const unsigned* src = (const unsigned*)(C.proj + (size_t)t0 * NPROJ + PJ_XBC + ch0);
            f32x2 xm3 = {0.f, 0.f}, xm2 = {0.f, 0.f}, xm1 = {0.f, 0.f};
            if (!first) { const unsigned a = src[-3 * (NPROJ / 2)], b = src[-2 * (NPROJ / 2)], c = src[-1 * (NPROJ / 2)];
                xm3 = (f32x2){bflo(a), bfhi(a)}; xm2 = (f32x2){bflo(b), bfhi(b)}; xm1 = (f32x2){bflo(c), bfhi(c)}; }
            LAS bf16* nat = (ch0 < 768) ? (sB + (ch0 - 512)) : (sC + (ch0 - 768));
#pragma unroll 1
            for (int l0 = 0; l0 < 64; l0 += 16) {
            unsigned uu[16];
#pragma unroll
            for (int i = 0; i < 16; ++i) uu[i] = src[(l0 + i) * (NPROJ / 2)];
#pragma unroll
            for (int li = 0; li < 16; li += 2) {
                const int l = l0 + li;
                const unsigned ua = uu[li], ub = uu[li + 1];
                const f32x2 xa = {bflo(ua), bfhi(ua)}, xc = {bflo(ub), bfhi(ub)};
                f32x2 ya = bb + w0 * xm3 + w1 * xm2 + w2 * xm1 + w3 * xa;
                f32x2 yb = bb + w0 * xm2 + w1 * xm1 + w2 * xa + w3 * xc;
                xm3 = xm1; xm2 = xa; xm1 = xc;
                ya.x = fsilu(ya.x); ya.y = fsilu(ya.y); yb.x = fsilu(yb.x); yb.y = fsilu(yb.y);
                if (ch0 < 512) {
                    *(LAS unsigned*)(sXT + ch0 * 72 + l) = pk2(ya.x, yb.x);
                    *(LAS unsigned*)(sXT + (ch0 + 1) * 72 + l) = pk2(ya.y, yb.y);
                } else {
                    *(LAS unsigned*)(nat + l * 264) = pk2(ya.x, ya.y);
                    *(LAS unsigned*)(nat + (l + 1) * 264) = pk2(yb.x, yb.y);
                }
            }
            }
        }
        __syncthreads();
        {
            const int g = wave >> 2, lt = wave & 3;
            f32x4 acc[4];
#pragma unroll
            for (int st = 0; st < 4; ++st) acc[st] = (f32x4){0.f, 0.f, 0.f, 0.f};
#pragma unroll
            for (int ks = 0; ks < 4; ++ks) {
                const bf16x8 af = *(const LAS bf16x8*)(sC + (16 * lt + fr) * 264 + g * 128 + 32 * ks + 8 * fq);
#pragma unroll
                for (int st = 0; st < 4; ++st) { const bf16x8 bfr = *(const LAS bf16x8*)(sB + (16 * st + fr) * 264 + g * 128 + 32 * ks + 8 * fq); acc[st] = mfma16(af, bfr, acc[st]); }
            }
            __syncthreads();
#pragma unroll
            for (int st = 0; st < 4; ++st)
#pragma unroll
                for (int e = 0; e < 4; ++e) sCB[(g * 64 + 16 * lt + 4 * fq + e) * 66 + 16 * st + fr] = acc[st][e];
        }
        __syncthreads();
        {
            const int h = wave, g = h >> 2;
            f32x4 acc[4][4];
#pragma unroll
            for (int lt = 0; lt < 4; ++lt)
#pragma unroll
                for (int pt = 0; pt < 4; ++pt) acc[lt][pt] = (f32x4){0.f, 0.f, 0.f, 0.f};
            const bf16* prev = C.states + (size_t)(ck * 8 + h) * 64 * 128;
#pragma unroll
            for (int ks = 0; ks < 4; ++ks) {
                bf16x8 cf[4];
#pragma unroll
                for (int lt = 0; lt < 4; ++lt) cf[lt] = *(const LAS bf16x8*)(sC + (16 * lt + fr) * 264 + g * 128 + 32 * ks + 8 * fq);
#pragma unroll
                for (int pt = 0; pt < 4; ++pt) {
                    const bf16x8 pfr = *(const bf16x8*)(prev + (16 * pt + fr) * 128 + 32 * ks + 8 * fq);
#pragma unroll
                    for (int lt = 0; lt < 4; ++lt) acc[lt][pt] = mfma16(pfr, cf[lt], acc[lt][pt]);
                }
                __builtin_amdgcn_sched_barrier(0);
            }
#pragma unroll
            for (int lt = 0; lt < 4; ++lt) {
                const float ea = fexp(sACS[h * 64 + 16 * lt + fr]);
#pragma unroll
                for (int pt = 0; pt < 4; ++pt) acc[lt][pt] = acc[lt][pt] * ea;
            }
#pragma unroll
            for (int ks2 = 0; ks2 < 2; ++ks2) {
                bf16x8 xf[4];
#pragma unroll
                for (int pt = 0; pt < 4; ++pt) xf[pt] = *(const LAS bf16x8*)(sXT + (h * 64 + 16 * pt + fr) * 72 + 32 * ks2 + 8 * fq);
                const f32x4 as0 = *(const LAS f32x4*)(sACS + h * 64 + 32 * ks2 + 8 * fq), as1 = *(const LAS f32x4*)(sACS + h * 64 + 32 * ks2 + 8 * fq + 4);
                const f32x4 dt0 = *(const LAS f32x4*)(sDT + h * 64 + 32 * ks2 + 8 * fq), dt1 = *(const LAS f32x4*)(sDT + h * 64 + 32 * ks2 + 8 * fq + 4);
#pragma unroll
                for (int lt = 0; lt < 4; ++lt) {
                    if (ks2 == 1 && lt < 2) continue;
                    const int l = 16 * lt + fr; const float al = sACS[h * 64 + l];
                    const LAS f32x2* cbp = (const LAS f32x2*)(sCB + (g * 64 + l) * 66 + 32 * ks2 + 8 * fq);
                    const f32x2 c01 = cbp[0], c23 = cbp[1], c45 = cbp[2], c67 = cbp[3];
                    const float cbv[8] = {c01.x, c01.y, c23.x, c23.y, c45.x, c45.y, c67.x, c67.y};
                    const float asv[8] = {as0[0], as0[1], as0[2], as0[3], as1[0], as1[1], as1[2], as1[3]};
                    const float dtv[8] = {dt0[0], dt0[1], dt0[2], dt0[3], dt1[0], dt1[1], dt1[2], dt1[3]};
                    float v[8];
#pragma unroll
                    for (int jj = 0; jj < 8; ++jj) { const int sidx = 32 * ks2 + 8 * fq + jj; const float t = cbv[jj] * fexp(al - asv[jj]) * dtv[jj]; v[jj] = (sidx <= l) ? t : 0.f; }
                    u32x4 w; w.x = pk2(v[0], v[1]); w.y = pk2(v[2], v[3]); w.z = pk2(v[4], v[5]); w.w = pk2(v[6], v[7]);
                    const bf16x8 af = __builtin_bit_cast(bf16x8, w);
#pragma unroll
                    for (int pt = 0; pt < 4; ++pt) acc[lt][pt] = mfma16(xf[pt], af, acc[lt][pt]);
                }
            }
            const float Dh = launder(C.in[8])[layer * 8 + h];
#pragma unroll
            for (int lt = 0; lt < 4; ++lt) {
                const int l = 16 * lt + fr; float q = 0.f;
#pragma unroll
                for (int pt = 0; pt < 4; ++pt) {
                    const int p0 = 16 * pt + 4 * fq;
                    const u32x2 zz = *(const u32x2*)(C.proj + (size_t)(t0 + l) * NPROJ + PJ_Z + h * 64 + p0);
                    const float zv[4] = {bflo(zz.x), bfhi(zz.x), bflo(zz.y), bfhi(zz.y)};
#pragma unroll
                    for (int e = 0; e < 4; ++e) {
                        const float xv = bf2f(sXT[(h * 64 + p0 + e) * 72 + l]);
                        const float y = (acc[lt][pt][e] + xv * Dh) * fsilu(zv[e]);
                        acc[lt][pt][e] = y; q += y * y;
                    }
                }
                q += shflx(q, 16, lane); q += shflx(q, 32, lane);
                if (fq == 0) sPART[h * 64 + l] = q;
            }
            __syncthreads();
            const float* ng = launder(C.in[9]) + layer * 512 + h * 64;
#pragma unroll
            for (int lt = 0; lt < 4; ++lt) {
                const int l = 16 * lt + fr;
                const float tot = (sPART[(4 * g) * 64 + l] + sPART[(4 * g + 1) * 64 + l]) + (sPART[(4 * g + 2) * 64 + l] + sPART[(4 * g + 3) * 64 + l]);
                const float rs = 1.0f / sqrtf(tot * (1.f / 256.f) + 1e-6f);
#pragma unroll
                for (int pt = 0; pt < 4; ++pt) {
                    const int p0 = 16 * pt + 4 * fq;
                    const f32x4 gg = *(const f32x4*)(ng + p0);
                    u32x2 w; w.x = pk2(acc[lt][pt][0] * rs * gg[0], acc[lt][pt][1] * rs * gg[1]); w.y = pk2(acc[lt][pt][2] * rs * gg[2], acc[lt][pt][3] * rs * gg[3]);
                    *(u32x2*)(C.mix + (size_t)(t0 + l) * DM + MX_B + h * 64 + p0) = w;
                }
            }
        }
        __syncthreads();
    }
}

__device__ __forceinline__ void final_phase(const Ctx& C) {
    const int gw = C.bid * 8 + C.wave, NGW = C.nblk * 8, lane = C.lane;
    f32x4 gg[2][2];
#pragma unroll
    for (int j = 0; j < 2; ++j) { gg[j][0] = *(const f32x4*)(C.in[19] + 512 * j + 8 * lane); gg[j][1] = *(const f32x4*)(C.in[19] + 512 * j + 8 * lane + 4); }
    for (int row0 = gw * 2; row0 < M; row0 += NGW * 2) {
        u32x4 v[2][2]; float rs[2];
#pragma unroll
        for (int r = 0; r < 2; ++r) {
            rs[r] = pg8::rstd_of(C.ssq, row0 + r);
#pragma unroll
            for (int j = 0; j < 2; ++j) v[r][j] = *(const u32x4*)(C.xb + (size_t)(row0 + r) * DM + 512 * j + 8 * lane);
        }
#pragma unroll
        for (int r = 0; r < 2; ++r)
#pragma unroll
            for (int j = 0; j < 2; ++j) {
                const u32x4 w = v[r][j];
                const f32x4 a = {bflo(w.x), bfhi(w.x), bflo(w.y), bfhi(w.y)}, b = {bflo(w.z), bfhi(w.z), bflo(w.w), bfhi(w.w)};
                float* o = C.out + (size_t)(row0 + r) * DM + 512 * j + 8 * lane;
                *(f32x4*)o = a * rs[r] * gg[j][0]; *(f32x4*)(o + 4) = b * rs[r] * gg[j][1];
            }
    }
}

#define XB_TMO      128
#define XB_XCNT(j)  (256  + 64 * (j))
#define XB_XSUB(j)  (1280 + 64 * (j))
#define XB_XGEN(j)  (2304 + 64 * (j))
#define XB_TOP      3328
#define XB_TOPGEN   3392
#define XCD_BAR_WORDS 3456
#define XB_SPIN_CAP (1u << 18)

__device__ __forceinline__ unsigned xb_ld(unsigned* p)              { return __hip_atomic_load(p, __ATOMIC_RELAXED, __HIP_MEMORY_SCOPE_AGENT); }
__device__ __forceinline__ unsigned xb_add(unsigned* p, unsigned v) { return __hip_atomic_fetch_add(p, v, __ATOMIC_RELAXED, __HIP_MEMORY_SCOPE_AGENT); }
__device__ __forceinline__ unsigned xb_xcc_id() { return (unsigned)__builtin_amdgcn_s_getreg((3 << 11) | 20) & 0xFu; }
#define XB_SPIN(cond, bar) do { unsigned _sp = 0; while (cond) { __builtin_amdgcn_s_sleep(1); \
    if ((++_sp & 255u) == 0u) { if (xb_ld(&(bar)[XB_TMO])) break; if (_sp > XB_SPIN_CAP) { atomicAdd(&(bar)[XB_TMO], 1u); break; } } } } while (0)

struct XcdBarrier {
    unsigned* bar; unsigned x;
    volatile LAS unsigned* st;
};

__device__ __forceinline__ XcdBarrier xcd_barrier_post(unsigned* bar, volatile LAS unsigned* st) {
    XcdBarrier b; b.bar = bar; b.x = xb_xcc_id(); b.st = st;
    if (threadIdx.x == 0) (void)xb_add(&bar[XB_XCNT(b.x)], 1u);
    return b;
}
__device__ __forceinline__ void xcd_barrier_complete(unsigned* bar, unsigned x, unsigned& nloc, unsigned& nx) {
    const unsigned G = gridDim.x * gridDim.y * gridDim.z;
    unsigned sum, cnt, mine, sp = 0u;
    for (;;) {
        sum = 0u; cnt = 0u; mine = 0u;
#pragma unroll
        for (unsigned j = 0; j < 16; ++j) { const unsigned c = xb_ld(&bar[XB_XCNT(j)]); sum += c; cnt += (c > 0u) ? 1u : 0u; mine = (j == x) ? c : mine; }
        if (sum == G) break;
        __builtin_amdgcn_s_sleep(1);
        if ((++sp & 255u) == 0u) { if (xb_ld(&bar[XB_TMO])) break; if (sp > XB_SPIN_CAP) { atomicAdd(&bar[XB_TMO], 1u); break; } }
    }
    nloc = mine > 0u ? mine : 1u; nx = cnt > 0u ? cnt : 1u;
}

__device__ __forceinline__ void xcd_barrier(const XcdBarrier& b) {
    asm volatile("s_waitcnt vmcnt(0)" ::: "memory");
    __syncthreads();
    if (threadIdx.x == 0) {
        unsigned* bar = b.bar;
        __builtin_amdgcn_s_waitcnt(0);
        unsigned nloc = b.st[0], nx = b.st[1];
        if (nloc == 0u) { xcd_barrier_complete(bar, b.x, nloc, nx); b.st[0] = nloc; b.st[1] = nx; }
        const unsigned old = xb_add(&bar[XB_XSUB(b.x)], 1u);
        const unsigned gen = old / nloc;
        if (old + 1u == (gen + 1u) * nloc) {
            __builtin_amdgcn_fence(__ATOMIC_RELEASE, "agent");
            asm volatile("s_waitcnt vmcnt(0)" ::: "memory");
            const unsigned og = xb_add(&bar[XB_TOP], 1u);
            const unsigned tg = og / nx;
            if (og + 1u == (tg + 1u) * nx) xb_add(&bar[XB_TOPGEN], 1u);
            else XB_SPIN(xb_ld(&bar[XB_TOPGEN]) == tg, bar);
            __builtin_amdgcn_fence(__ATOMIC_ACQUIRE, "agent");
            xb_add(&bar[XB_XGEN(b.x)], 1u);
            asm volatile("s_waitcnt vmcnt(0)" ::: "memory");
        } else {
            XB_SPIN(xb_ld(&bar[XB_XGEN(b.x)]) == gen, bar);
            __builtin_amdgcn_fence(__ATOMIC_ACQUIRE, "agent");
            asm volatile("s_waitcnt vmcnt(0)" ::: "memory");
        }
    }
    __syncthreads();
}

#ifndef PHMASK
#define PHMASK 0x1ff
#endif
#define PHEN(x) (((PHMASK) >> (x)) & 1)
#define CAS __attribute__((address_space(4)))
__device__ __forceinline__ Ctx make_ctx(const CAS Args* ap, LAS unsigned char* lds, int tidv, int bid, int nblk) {
    Ctx C; C.bid = bid; C.nblk = nblk;
    C.lds = lds; C.tid = tidv; C.lane = tidv & 63; C.wave = __builtin_amdgcn_readfirstlane(tidv >> 6);
#pragma unroll
    for (int i = 0; i < 20; ++i) C.in[i] = ap->in[i];
    C.out = ap->out;
    unsigned char* ws = ap->ws;
    C.Win = (bf16*)(ws + WS_WIN); C.Wout = (bf16*)(ws + WS_WOUT); C.Wgu = (bf16*)(ws + WS_WGU); C.Wdn = (bf16*)(ws + WS_WDN);
    C.xb = (bf16*)(ws + WS_XB); C.mix = (bf16*)(ws + WS_MIX); C.states = (bf16*)(ws + WS_ST); C.proj = (bf16*)(ws + WS_PROJ);
    C.ssq = (float*)(ws + WS_SSQ); C.dtraw = (float*)(ws + WS_DT); C.cdecay = (float*)(ws + WS_CD);
    return C;
}
__global__ void __launch_bounds__(512, 2) fwd_kernel(Args a_unused) {
    extern __shared__ __attribute__((aligned(16))) unsigned char lds_raw[];
    cg::grid_group grid = cg::this_grid();
    LAS unsigned char* lds = (LAS unsigned char*)lds_raw;
    const CAS Args* ap0 = (const CAS Args*)__builtin_amdgcn_kernarg_segment_ptr();
    const int ph_lo = ap0->ph_lo, ph_hi = ap0->ph_hi, coop = ap0->coop;
    volatile LAS unsigned* MISC = (volatile LAS unsigned*)(lds + LDS_BYTES - 64);
    if (threadIdx.x < 16) MISC[threadIdx.x] = 0u;
    __syncthreads();
    unsigned* barw = (unsigned*)(ap0->ws);
    XcdBarrier bar; bar.bar = barw; bar.x = 0; bar.st = MISC;
    bool bar_ready = false;
    for (int ph = ph_lo; ph < ph_hi; ++ph) {
        const CAS Args* ap = ap0; asm volatile("" : "+s"(ap));
        int tidv = threadIdx.x; asm volatile("" : "+v"(tidv));
        int bid = blockIdx.x, nblk = gridDim.x; asm volatile("" : "+s"(bid), "+s"(nblk));
        if (ph == NPHASES - 1) { if (PHEN(8)) { const Ctx C = make_ctx(ap, lds, tidv, bid, nblk); final_phase(C); } }
        else {
            const int l = (ph == 0) ? 0 : (ph - 1) / 7, t = (ph == 0) ? 2 : (ph - 1) % 7;
            if (t == 0 || t >= 4) { if (PHEN(1)) {
                const Ctx C = make_ctx(ap, lds, tidv, bid, nblk);
                pg8::Gemm g; int N;
                pg8::EpiAny E; E.e0 = pg8::EpiInProj{C.proj, C.dtraw, (const LAS float*)(lds + 131072)}; E.e1 = pg8::EpiResid{(l == 0 && t == 4) ? C.in[0] : (const float*)nullptr, C.xb, C.ssq}; E.e2 = pg8::EpiGateUp{C.proj, (const LAS float*)(lds + 131072)};
                if (t == 0)      { g = pg8::Gemm{C.xb, C.Win + (size_t)l * 3072 * 1024, M, 3072, 1024}; N = 3072; E.mode = 0; }
                else if (t == 4) { g = pg8::Gemm{C.mix, C.Wout + (size_t)l * 1024 * 1024, M, 1024, 1024}; N = 1024; E.mode = 1; }
                else if (t == 5) { g = pg8::Gemm{C.xb, C.Wgu + (size_t)l * 5632 * 1024, M, 5632, 1024}; N = 5632; E.mode = 2; }
                else             { g = pg8::Gemm{C.proj, C.Wdn + (size_t)l * 1024 * 2816, M, 1024, 2816}; N = 1024; E.mode = 1; }
                pg8::StaticOrder S; S.init(M, N, nblk, bid);
                LAS float* rsl = (LAS float*)(lds + 131072);
                if (E.mode != 1) {
                    pg8::Unit uu;
                    for (int i = 0; i < 16 && S.next(i, uu); ++i) if (tidv < 256) rsl[i * 256 + tidv] = pg8::rstd_of(C.ssq, uu.pm * 256 + tidv);
                    __syncthreads();
                }
                pg8::gemm_phase<pg8::EpiAny, pg8::StaticOrder, true, true>(lds, g, S, E, tidv); }
            } else if (t == 1) { if (PHEN(2)) { const Ctx C = make_ctx(ap, lds, tidv, bid, nblk); mix1_phase(C, l); } }
            else if (t == 2) { if (PHEN(3)) { const Ctx C = make_ctx(ap, lds, tidv, bid, nblk); aux_phase(C, ph == 0 ? 0 : 1, l); } }
            else { if (PHEN(4)) { const Ctx C = make_ctx(ap, lds, tidv, bid, nblk); mix3_phase(C, l); } }
        }
        if (ph + 1 < ph_hi && coop) {
            if (!bar_ready) {
                if (bid == 0) for (int i = tidv; i < XCD_BAR_WORDS; i += 512) __hip_atomic_store(barw + i, 0u, __ATOMIC_RELAXED, __HIP_MEMORY_SCOPE_AGENT);
                grid.sync();
                bar = xcd_barrier_post(barw, MISC); bar_ready = true;
            } else xcd_barrier(bar);
        }
    }
}

#ifndef MK_MULTI
#define MK_MULTI 0
#endif
extern "C" void kernel_launch(void* const* d_in, const int* in_sizes, int n_in, void* d_out, int out_size, void* d_ws, size_t ws_size, hipStream_t stream) {
    static int grid = 0;
    if (grid == 0) {
        if (n_in != 20 || out_size != M * DM || ws_size < WS_END) { fprintf(stderr, "kernel_launch: unexpected shapes (n_in %d out %d ws %zu)\n", n_in, out_size, ws_size); grid = -1; return; }
        int dev = 0, cus = 0, per_cu = 0;
        hipGetDevice(&dev); hipDeviceGetAttribute(&cus, hipDeviceAttributeMultiprocessorCount, dev);
        if (hipFuncSetAttribute((const void*)fwd_kernel, hipFuncAttributeMaxDynamicSharedMemorySize, LDS_BYTES) != hipSuccess) { fprintf(stderr, "kernel_launch: hipFuncSetAttribute failed\n"); grid = -1; return; }
        if (hipOccupancyMaxActiveBlocksPerMultiprocessor(&per_cu, (const void*)fwd_kernel, 512, LDS_BYTES) != hipSuccess || per_cu < 1) { fprintf(stderr, "kernel_launch: occupancy query gave %d\n", per_cu); per_cu = 1; (void)hipGetLastError(); }
        grid = cus * per_cu; if (grid > 256) grid = 256;
    }
    if (grid < 0) return;
    Args a{};
    for (int i = 0; i < 20; ++i) a.in[i] = (const float*)d_in[i];
    a.out = (float*)d_out; a.ws = (unsigned char*)d_ws;
#if MK_MULTI
    a.coop = 0;
    for (int ph = 0; ph < NPHASES; ++ph) { a.ph_lo = ph; a.ph_hi = ph + 1; hipLaunchKernelGGL(fwd_kernel, dim3(grid), dim3(512), LDS_BYTES, stream, a); }
#else
    a.coop = 1; a.ph_lo = 0; a.ph_hi = NPHASES;
    void* args[] = {&a};
    hipError_t e = hipLaunchCooperativeKernel((const void*)fwd_kernel, dim3(grid), dim3(512), args, LDS_BYTES, stream);
    if (e != hipSuccess) fprintf(stderr, "kernel_launch: cooperative launch failed: %s (grid %d)\n", hipGetErrorString(e), grid);
#endif
}
```

```cpp
#include <hip/hip_runtime.h>
#include <hip/hip_cooperative_groups.h>
#include <cstdio>
#include <cstdint>
namespace cg = cooperative_groups;
namespace pg8 {
#define PG8_LAS __attribute__((address_space(3)))
typedef unsigned short bf16_t;
typedef short bf16x8 __attribute__((ext_vector_type(8)));
typedef float f32x4 __attribute__((ext_vector_type(4)));
typedef unsigned u32x4 __attribute__((ext_vector_type(4)));
constexpr int BM = 256, BK = 64, HALF = 128, HTB = HALF * BK * 2  , STAGE_BYTES = 8 * HTB, NXCD = 8, WGM = 8;

__host__ __device__ __forceinline__ int lds_byte(int r, int c) { const int st = (r >> 4) * 2 + (c >> 5), rr = r & 15, cc = c & 31, ob = rr * 64 + cc * 2; return st * 1024 + (ob ^ (((ob >> 9) & 1) << 5)); }
__host__ __device__ __forceinline__ void stage_rc(int b, int& R, int& C) { const int st = b / 1024, sb = b % 1024, swz = sb ^ (((sb >> 9) & 1) << 5); R = (st >> 1) * 16 + swz / 64; C = (st & 1) * 32 + (swz % 64) / 2; }
__host__ __device__ __forceinline__ int perm32(int rho) { const int n = rho >> 4, i = rho & 15; return 8 * (i >> 2) + 4 * n + (i & 3); }

struct Unit { int pm, pn, idx; };
struct Gemm { const bf16_t* A; const bf16_t* Bt; int M, N, K; };

struct StaticOrder {
    int nM, nN, nwg, G, c;
    __host__ __device__ void init(int M, int N, int G_, int c_) { nM = M / BM; nN = N / BM; nwg = nM * nN; G = G_; c = c_; }
    __host__ __device__ bool next(int i, Unit& u) const {
        const long L = (long)i * G + c; if (L >= nwg) return false; u.idx = i;
        int wgid = (int)L; { const int q = nwg / NXCD, r = nwg % NXCD, xcd = wgid % NXCD, off = wgid / NXCD; wgid = (xcd < r ? xcd * (q + 1) : r * (q + 1) + (xcd - r) * q) + off; }
        const int nig = WGM * nN, gid = wgid / nig, fm = gid * WGM, gsz = (nM - fm) < WGM ? (nM - fm) : WGM;
        u.pm = fm + ((wgid % nig) % gsz); u.pn = (wgid % nig) / gsz; return true;
    }
    __device__ __forceinline__ void a_ready(const Unit&) const {}
    __device__ __forceinline__ void done(const Unit&) const {}
};

__device__ __forceinline__ unsigned cvt_pk_bf16(float lo, float hi) { unsigned r; asm volatile("v_cvt_pk_bf16_f32 %0, %1, %2" : "=v"(r) : "v"(lo), "v"(hi)); return r; }
__device__ __forceinline__ float shflx(float v, int mask, int lane) { return __int_as_float(__builtin_amdgcn_ds_bpermute((lane ^ mask) << 2, __float_as_int(v))); }
__device__ __forceinline__ float rstd_of(const float* ssq, int row) {
    const f32x4* p = (const f32x4*)(ssq + (size_t)row * 16);
    const f32x4 a = p[0], b = p[1], c = p[2], d = p[3];
    const float s = (((a[0] + a[1]) + (a[2] + a[3])) + ((b[0] + b[1]) + (b[2] + b[3]))) + (((c[0] + c[1]) + (c[2] + c[3])) + ((d[0] + d[1]) + (d[2] + d[3])));
    return __builtin_amdgcn_rsqf(s * (1.0f / 1024.0f) + 1e-6f);
}
__device__ __forceinline__ float silu_f(float x) { return x * __builtin_amdgcn_rcpf(1.0f + __builtin_amdgcn_exp2f(-1.4426950408889634f * x)); }
constexpr float QSCALE = 0.125f * 1.4426950408889634f;
struct EpiInProj {
    static constexpr bool PERM = true, AFTER_DRAIN = false;
    bf16_t* proj; float* dtraw; const PG8_LAS float* rsl;
    __device__ __forceinline__ void operator()(const f32x4 (&acc)[2][2][4][2], const Unit& u, int wr, int wc, int fr, int fq) const {
        const int row0 = u.pm * BM + wr * 64 + fr;
        const float sc = (u.pn == 0) ? QSCALE : 1.0f;
#pragma unroll
        for (int ai = 0; ai < 2; ++ai)
#pragma unroll
            for (int m = 0; m < 4; ++m) {
                const int row = row0 + ai * HALF + m * 16;
                const float rs = rsl[u.idx * 256 + (row & 255)] * sc;
                if (u.pn < 11) {
                    bf16_t* rowp = proj + (size_t)row * 2816 + u.pn * BM + wc * 32 + 8 * fq;
#pragma unroll
                    for (int bj = 0; bj < 2; ++bj) {
                        const f32x4 v0 = acc[ai][bj][m][0] * rs, v1 = acc[ai][bj][m][1] * rs;
                        u32x4 w; w.x = cvt_pk_bf16(v0[0], v0[1]); w.y = cvt_pk_bf16(v0[2], v0[3]); w.z = cvt_pk_bf16(v1[0], v1[1]); w.w = cvt_pk_bf16(v1[2], v1[3]);
                        *(u32x4*)(rowp + bj * HALF) = w;
                    }
                } else if (wc == 0 && fq == 0) {
                    *(f32x4*)(dtraw + (size_t)row * 8) = acc[ai][0][m][0] * rs;
                    *(f32x4*)(dtraw + (size_t)row * 8 + 4) = acc[ai][0][m][1] * rs;
                }
            }
    }
};
struct EpiResid {
    static constexpr bool PERM = true, AFTER_DRAIN = false;
    const float* base32; bf16_t* xb; float* ssq;
    __device__ __forceinline__ void operator()(const f32x4 (&acc)[2][2][4][2], const Unit& u, int wr, int wc, int fr, int fq) const {
        const int col0 = u.pn * BM + wc * 32 + 8 * fq, lane_ = fr + 16 * fq;
#pragma unroll
        for (int ai = 0; ai < 2; ++ai)
#pragma unroll
            for (int m = 0; m < 4; ++m) {
                const int row = u.pm * BM + ai * HALF + wr * 64 + m * 16 + fr;
                const size_t off = (size_t)row * 1024 + col0;
                float q = 0.f;
#pragma unroll
                for (int bj = 0; bj < 2; ++bj) {
                    const u32x4 r = *(const u32x4*)(xb + off + bj * HALF);
                    const f32x4 b0 = {__uint_as_float(r.x << 16), __uint_as_float(r.x & 0xffff0000u), __uint_as_float(r.y << 16), __uint_as_float(r.y & 0xffff0000u)};
                    const f32x4 b1 = {__uint_as_float(r.z << 16), __uint_as_float(r.z & 0xffff0000u), __uint_as_float(r.w << 16), __uint_as_float(r.w & 0xffff0000u)};
                    const f32x4 o0 = b0 + acc[ai][bj][m][0], o1 = b1 + acc[ai][bj][m][1];
                    q += ((o0[0] * o0[0] + o0[1] * o0[1]) + (o0[2] * o0[2] + o0[3] * o0[3])) + ((o1[0] * o1[0] + o1[1] * o1[1]) + (o1[2] * o1[2] + o1[3] * o1[3]));
                    u32x4 w; w.x = cvt_pk_bf16(o0[0], o0[1]); w.y = cvt_pk_bf16(o0[2], o0[3]); w.z = cvt_pk_bf16(o1[0], o1[1]); w.w = cvt_pk_bf16(o1[2], o1[3]);
                    *(u32x4*)(xb + off + bj * HALF) = w;
                }
                q += shflx(q, 16, lane_); q += shflx(q, 32, lane_);
                if (fq == 0) ssq[(size_t)row * 16 + u.pn * 4 + wc] = q;
            }
    }
};
struct EpiGateUp {
    static constexpr bool PERM = true, AFTER_DRAIN = false;
    bf16_t* hdn; const PG8_LAS float* rsl;
    __device__ __forceinline__ void operator()(const f32x4 (&acc)[2][2][4][2], const Unit& u, int wr, int wc, int fr, int fq) const {
        const int row0 = u.pm * BM + wr * 64 + fr, col = u.pn * HALF + wc * 32 + 8 * fq;
#pragma unroll
        for (int ai = 0; ai < 2; ++ai)
#pragma unroll
            for (int m = 0; m < 4; ++m) {
                const int row = row0 + ai * HALF + m * 16;
                const float rs = rsl[u.idx * 256 + (row & 255)];
                const f32x4 g0 = acc[ai][0][m][0] * rs, g1 = acc[ai][0][m][1] * rs, u0 = acc[ai][1][m][0] * rs, u1 = acc[ai][1][m][1] * rs;
                u32x4 w;
                w.x = cvt_pk_bf16(silu_f(g0[0]) * u0[0], silu_f(g0[1]) * u0[1]); w.y = cvt_pk_bf16(silu_f(g0[2]) * u0[2], silu_f(g0[3]) * u0[3]);
                w.z = cvt_pk_bf16(silu_f(g1[0]) * u1[0], silu_f(g1[1]) * u1[1]); w.w = cvt_pk_bf16(silu_f(g1[2]) * u1[2], silu_f(g1[3]) * u1[3]);
                *(u32x4*)(hdn + (size_t)row * 2816 + col) = w;
            }
    }
};

struct EpiAny {
    static constexpr bool PERM = true, AFTER_DRAIN = false;
    int mode; EpiInProj e0; EpiResid e1; EpiGateUp e2;
    __device__ __forceinline__ void operator()(const f32x4 (&acc)[2][2][4][2], const Unit& u, int wr, int wc, int fr, int fq) const {
        if (mode == 0) e0(acc, u, wr, wc, fr, fq); else if (mode == 1) e1(acc, u, wr, wc, fr, fq); else e2(acc, u, wr, wc, fr, fq);
    }
};
template <class Epi, class Sched, bool ALIGN_EPI = false, bool SP2 = false>
__device__ __forceinline__ void gemm_phase(PG8_LAS unsigned char* lds, const Gemm g, const Sched& S, const Epi& E, const int tid) {
    const int wid = __builtin_amdgcn_readfirstlane(tid >> 6), lane = tid & 63, wr = wid >> 2, wc = wid & 3, fr = lane & 15, fq = lane >> 4;
    const int K = g.K, nt = K / BK;
    unsigned voffA[2], voffB[2];
#pragma unroll
    for (int i = 0; i < 2; ++i) { int R, C; stage_rc(tid * 16 + i * 8192, R, C); const int Rb = Epi::PERM ? ((R & ~31) + perm32(R & 31)) : R;
        voffA[i] = (unsigned)(R * K + C) * 2u; voffB[i] = (unsigned)(Rb * K + C) * 2u; }
    const size_t kstep = (size_t)(BK * 2);
    const size_t hstep = (size_t)HALF * K * 2;
    const size_t tstep = 2 * hstep;
    const unsigned ldsw = (unsigned)wid * 1024u;
    const int aoff = lds_byte(wr * 64 + fr, fq * 8), boff = lds_byte(wc * 32 + fr, fq * 8);
#define PG8_SA(b, h) (((b) * 2 + (h)) * HTB)
#define PG8_SB(b, h) ((4 + (b) * 2 + (h)) * HTB)
#define PG8_STAGE(bufoff, gbase, voff) do { _Pragma("unroll") for (int _i = 0; _i < 2; ++_i) \
        __builtin_amdgcn_global_load_lds((const unsigned*)((const char*)(gbase) + (voff)[_i]), (PG8_LAS unsigned*)(lds + (bufoff) + ldsw + _i * 8192), 16, 0, 0); } while (0)
#define PG8_LDA(dst, b, h) do { _Pragma("unroll") for (int m = 0; m < 4; ++m) _Pragma("unroll") for (int k = 0; k < 2; ++k) dst[m][k] = *(const PG8_LAS bf16x8*)(lds + PG8_SA(b, h) + aoff + m * 2048 + k * 1024); } while (0)
#define PG8_LDB(dst, b, h) do { _Pragma("unroll") for (int n = 0; n < 2; ++n) _Pragma("unroll") for (int k = 0; k < 2; ++k) dst[n][k] = *(const PG8_LAS bf16x8*)(lds + PG8_SB(b, h) + boff + n * 2048 + k * 1024); } while (0)
#define PG8_MMA(ai, bj, At, Bt) do { __builtin_amdgcn_s_setprio(1); _Pragma("unroll") for (int m = 0; m < 4; ++m) _Pragma("unroll") for (int n = 0; n < 2; ++n) _Pragma("unroll") for (int k = 0; k < 2; ++k) \
        acc[ai][bj][m][n] = __builtin_amdgcn_mfma_f32_16x16x32_bf16(Bt[n][k], At[m][k], acc[ai][bj][m][n], 0, 0, 0); __builtin_amdgcn_s_setprio(0); } while (0)
#define PG8_WAIT_V(n) asm volatile("s_waitcnt vmcnt(" #n ")" ::: "memory")
#define PG8_WAIT_L(n) asm volatile("s_waitcnt lgkmcnt(" #n ")" ::: "memory")
#define PG8_BAR __builtin_amdgcn_s_barrier()
#define PG8_SCHED __builtin_amdgcn_sched_barrier(0)
    Unit cur, nxt; int ui = 0;
    if (!S.next(0, cur)) return;
    f32x4 acc[2][2][4][2];
#pragma unroll
    for (int a = 0; a < 2; ++a)
#pragma unroll
        for (int b = 0; b < 2; ++b)
#pragma unroll
            for (int m = 0; m < 4; ++m)
#pragma unroll
                for (int n = 0; n < 2; ++n) acc[a][b][m][n] = (f32x4){0.f, 0.f, 0.f, 0.f};
    bf16x8 At[4][2], B0[2][2], B1[2][2];
    const char* cA = (const char*)g.A + (size_t)cur.pm * tstep; const char* cB = (const char*)g.Bt + (size_t)cur.pn * tstep;
    S.a_ready(cur);
    if constexpr (SP2) {
        PG8_STAGE(PG8_SB(0, 0), cB, voffB); PG8_STAGE(PG8_SB(0, 1), cB + hstep, voffB); PG8_STAGE(PG8_SA(0, 0), cA, voffA); PG8_STAGE(PG8_SA(0, 1), cA + hstep, voffA);
        if (wr == 1) PG8_BAR;
        PG8_WAIT_V(2); PG8_BAR;
        PG8_STAGE(PG8_SB(1, 0), cB + kstep, voffB); PG8_STAGE(PG8_SA(1, 0), cA + kstep, voffA); PG8_STAGE(PG8_SB(1, 1), cB + hstep + kstep, voffB);
        PG8_WAIT_V(6); PG8_BAR;
    } else {
        PG8_STAGE(PG8_SB(0, 0), cB, voffB); PG8_STAGE(PG8_SA(0, 0), cA, voffA); PG8_STAGE(PG8_SB(0, 1), cB + hstep, voffB); PG8_STAGE(PG8_SA(0, 1), cA + hstep, voffA);
        if (wr == 1) PG8_BAR;
        PG8_WAIT_V(4); PG8_BAR;
        PG8_STAGE(PG8_SB(1, 0), cB + kstep, voffB); PG8_STAGE(PG8_SA(1, 0), cA + kstep, voffA); PG8_STAGE(PG8_SB(1, 1), cB + hstep + kstep, voffB);
        PG8_WAIT_V(6); PG8_BAR;
    }
    for (;;) {
        const bool has_next = S.next(ui + 1, nxt);
        const char* nA = has_next ? (const char*)g.A + (size_t)nxt.pm * tstep : cA; const char* nB = has_next ? (const char*)g.Bt + (size_t)nxt.pn * tstep : cB;
        for (int t = 0; t < nt; t += 2) {
            const bool last = (t == nt - 2);
            const char* a1 = cA + (size_t)(t + 1) * kstep;
            const char* a2 = last ? nA : cA + (size_t)(t + 2) * kstep; const char* b2 = last ? nB : cB + (size_t)(t + 2) * kstep;
            const char* a3 = a2 + kstep; const char* b3 = b2 + kstep;
            if (last && has_next) S.a_ready(nxt);
            if constexpr (SP2) {
            PG8_LDB(B0, 0, 0); PG8_LDB(B1, 0, 1); PG8_SCHED; PG8_LDA(At, 0, 0); PG8_STAGE(PG8_SA(1, 1), a1 + hstep, voffA);
            PG8_WAIT_V(8); PG8_WAIT_L(0); PG8_BAR; PG8_MMA(0, 0, At, B0); PG8_MMA(0, 1, At, B1); PG8_BAR; PG8_SCHED;
            PG8_LDA(At, 0, 1); PG8_STAGE(PG8_SB(0, 0), b2, voffB); PG8_STAGE(PG8_SB(0, 1), b2 + hstep, voffB); PG8_STAGE(PG8_SA(0, 0), a2, voffA);
            PG8_WAIT_V(8); PG8_WAIT_L(0); PG8_BAR; PG8_MMA(1, 0, At, B0); PG8_MMA(1, 1, At, B1); PG8_BAR; PG8_SCHED;
            PG8_LDB(B0, 1, 0); PG8_LDB(B1, 1, 1); PG8_SCHED; PG8_LDA(At, 1, 0); PG8_STAGE(PG8_SA(0, 1), a2 + hstep, voffA);
            PG8_WAIT_V(8); PG8_WAIT_L(0); PG8_BAR; PG8_MMA(0, 0, At, B0); PG8_MMA(0, 1, At, B1); PG8_BAR; PG8_SCHED;
            PG8_LDA(At, 1, 1); PG8_STAGE(PG8_SB(1, 0), b3, voffB); PG8_STAGE(PG8_SB(1, 1), b3 + hstep, voffB); PG8_STAGE(PG8_SA(1, 0), a3, voffA);
            PG8_WAIT_V(8); PG8_WAIT_L(0); PG8_BAR; PG8_MMA(1, 0, At, B0); PG8_MMA(1, 1, At, B1); PG8_BAR; PG8_SCHED;
            } else {
            PG8_LDB(B0, 0, 0); PG8_SCHED; PG8_LDA(At, 0, 0); PG8_STAGE(PG8_SA(1, 1), a1 + hstep, voffA);
            PG8_WAIT_L(8); PG8_BAR; PG8_WAIT_L(0); PG8_MMA(0, 0, At, B0); PG8_BAR; PG8_SCHED;
            PG8_LDB(B1, 0, 1); PG8_STAGE(PG8_SB(0, 0), b2, voffB);
            PG8_BAR; PG8_WAIT_L(0); PG8_MMA(0, 1, At, B1); PG8_BAR;
            PG8_LDA(At, 0, 1); PG8_STAGE(PG8_SA(0, 0), a2, voffA);
            PG8_BAR; PG8_WAIT_L(0); PG8_MMA(1, 0, At, B0); PG8_BAR; PG8_SCHED;
            PG8_STAGE(PG8_SB(0, 1), b2 + hstep, voffB);
            PG8_WAIT_V(6); PG8_BAR; PG8_MMA(1, 1, At, B1); PG8_BAR;
            PG8_LDB(B0, 1, 0); PG8_SCHED; PG8_LDA(At, 1, 0); PG8_STAGE(PG8_SA(0, 1), a2 + hstep, voffA);
            PG8_WAIT_L(8); PG8_BAR; PG8_WAIT_L(0); PG8_MMA(0, 0, At, B0); PG8_BAR; PG8_SCHED;
            PG8_LDB(B1, 1, 1); PG8_STAGE(PG8_SB(1, 0), b3, voffB);
            PG8_BAR; PG8_WAIT_L(0); PG8_MMA(0, 1, At, B1); PG8_BAR;
            PG8_LDA(At, 1, 1); PG8_STAGE(PG8_SA(1, 0), a3, voffA);
            PG8_BAR; PG8_WAIT_L(0); PG8_MMA(1, 0, At, B0); PG8_BAR; PG8_SCHED;
            PG8_STAGE(PG8_SB(1, 1), b3 + hstep, voffB);
            PG8_WAIT_V(6); PG8_BAR; PG8_MMA(1, 1, At, B1); PG8_BAR;
            }
        }
        if constexpr (ALIGN_EPI) { if (wr == 0) PG8_BAR; }
        if constexpr (!Epi::AFTER_DRAIN) { E(acc, cur, wr, wc, fr, fq); S.done(cur); }
        if (!has_next) break;
#pragma unroll
        for (int a = 0; a < 2; ++a)
#pragma unroll
            for (int b = 0; b < 2; ++b)
#pragma unroll
                for (int m = 0; m < 4; ++m)
#pragma unroll
                    for (int n = 0; n < 2; ++n) acc[a][b][m][n] = (f32x4){0.f, 0.f, 0.f, 0.f};
        cur = nxt; cA = nA; cB = nB; ++ui;
        if constexpr (ALIGN_EPI) { if (wr == 1) PG8_BAR; }
    }
    PG8_WAIT_V(0);
    if constexpr (!ALIGN_EPI) { if (wr == 0) PG8_BAR; }
    PG8_BAR;
    if constexpr (Epi::AFTER_DRAIN) { E.fused(acc, cur, wr, wc, fr, fq, lds, wid, lane); S.done(cur); }
#undef PG8_SA
#undef PG8_SB
#undef PG8_STAGE
#undef PG8_LDA
#undef PG8_LDB
#undef PG8_MMA
#undef PG8_WAIT_V
#undef PG8_WAIT_L
#undef PG8_BAR
#undef PG8_SCHED
}
}

#define LAS __attribute__((address_space(3)))
typedef unsigned short bf16;
typedef float f32x4 __attribute__((ext_vector_type(4)));
typedef float f32x2 __attribute__((ext_vector_type(2)));
typedef short bf16x8 __attribute__((ext_vector_type(8)));
typedef unsigned u32x4 __attribute__((ext_vector_type(4)));
typedef unsigned u32x2 __attribute__((ext_vector_type(2)));
typedef __bf16 bf16x2_t __attribute__((ext_vector_type(2)));
typedef short s16x4 __attribute__((ext_vector_type(4)));

constexpr int M = 16384, DM = 1024, NPROJ = 2816, NCHUNK = 256;
constexpr int PJ_Q = 0, PJ_K = 256, PJ_V = 512, PJ_Z = 768, PJ_XBC = 1280, PJ_GLU = 2304;
constexpr int MX_A = 0, MX_B = 256, MX_C = 768;
constexpr size_t MiB = 1u << 20;
constexpr size_t WS_SSQ = 1 * MiB, WS_DT = 2 * MiB, WS_CD = 2 * MiB + 512 * 1024, WS_WIN = 4 * MiB, WS_WOUT = 16 * MiB, WS_WGU = 20 * MiB, WS_WDN = 42 * MiB,
                 WS_XB = 54 * MiB, WS_MIX = 86 * MiB, WS_ST = 118 * MiB, WS_PROJ = 150 * MiB, WS_END = 238 * MiB;
constexpr int LDS_BYTES = 153600;
constexpr float LOG2E = 1.4426950408889634f;
constexpr int NPHASES = 16;

__device__ __forceinline__ float bflo(unsigned u) { return __uint_as_float(u << 16); }
__device__ __forceinline__ float bfhi(unsigned u) { return __uint_as_float(u & 0xffff0000u); }
__device__ __forceinline__ float bf2f(bf16 h) { return __uint_as_float((unsigned)h << 16); }
__device__ __forceinline__ unsigned pk2(float lo, float hi) { f32x2 v = {lo, hi}; bf16x2_t b = __builtin_convertvector(v, bf16x2_t); return __builtin_bit_cast(unsigned, b); }
__device__ __forceinline__ bf16 f2bf(float f) { return (bf16)(pk2(f, 0.f) & 0xffffu); }
__device__ __forceinline__ f32x4 mfma16(bf16x8 a, bf16x8 b, f32x4 c) { return __builtin_amdgcn_mfma_f32_16x16x32_bf16(a, b, c, 0, 0, 0); }
__device__ __forceinline__ float fsilu(float x) { return x * __builtin_amdgcn_rcpf(1.0f + __builtin_amdgcn_exp2f(-LOG2E * x)); }
__device__ __forceinline__ float fsigmoid(float x) { return __builtin_amdgcn_rcpf(1.0f + __builtin_amdgcn_exp2f(-LOG2E * x)); }
__device__ __forceinline__ float fexp(float x) { return __builtin_amdgcn_exp2f(LOG2E * x); }
using pg8::shflx;
__device__ __forceinline__ float wave_sum(float v, int lane) {
#pragma unroll
    for (int o = 1; o < 64; o <<= 1) v += shflx(v, o, lane);
    return v;
}

template <class T> __device__ __forceinline__ T* launder(T* p) { asm volatile("" : "+s"(p)); return p; }
struct Args { const float* in[20]; float* out; unsigned char* ws; int ph_lo, ph_hi, coop, pad; };
struct Ctx {
    LAS unsigned char* lds; int tid, lane, wave, bid, nblk;
    const float* in[20]; float* out;
    bf16 *Win, *Wout, *Wgu, *Wdn, *xb, *mix, *states, *proj;
    float *ssq, *dtraw, *cdecay;
};

struct P0Item { const float* W; const float* gain; bf16* WT; int nsrc, col, valid, K, drow, k0; };
__device__ __forceinline__ P0Item p0_decode(const Ctx& C, int it) {
    constexpr int I_IN = 16 * 96, I_OUT = 16 * 32, I_GU = 16 * 176, I_DN = 44 * 32, I_L = I_IN + I_OUT + I_GU + I_DN;
    P0Item P; const int l = it / I_L; int r = it % I_L;
    if (r < I_IN) {
        const int kb = r / 96, n0 = 32 * (r % 96);
        int col, valid;
        if (n0 < 2304) { col = n0; valid = 32; } else if (n0 < 2816) { col = n0 + 8; valid = 32; } else if (n0 == 2816) { col = 2304; valid = 8; } else { col = 0; valid = 0; }
        P.W = C.in[2] + (size_t)l * 1024 * 2824; P.nsrc = 2824; P.col = col; P.valid = valid; P.gain = C.in[1] + l * 1024; P.K = 1024; P.WT = C.Win + (size_t)l * 3072 * 1024; P.drow = n0; P.k0 = 64 * kb;
        return P;
    }
    r -= I_IN;
    if (r < I_OUT) { const int kb = r / 32, n0 = 32 * (r % 32);
        P.W = C.in[14] + (size_t)l * 1024 * 1024; P.nsrc = 1024; P.col = n0; P.valid = 32; P.gain = nullptr; P.K = 1024; P.WT = C.Wout + (size_t)l * 1024 * 1024; P.drow = n0; P.k0 = 64 * kb; return P; }
    r -= I_OUT;
    if (r < I_GU) { const int kb = r / 176, n0 = 32 * (r % 176); const int t = n0 >> 8, hs = (n0 >> 7) & 1, i = n0 & 127;
        P.W = (hs ? C.in[17] : C.in[16]) + (size_t)l * 1024 * 2816; P.nsrc = 2816; P.col = 128 * t + i; P.valid = 32; P.gain = C.in[15] + l * 1024; P.K = 1024; P.WT = C.Wgu + (size_t)l * 5632 * 1024; P.drow = n0; P.k0 = 64 * kb; return P; }
    r -= I_GU;
    { const int kb = r / 32, n0 = 32 * (r % 32);
        P.W = C.in[18] + (size_t)l * 2816 * 1024; P.nsrc = 1024; P.col = n0; P.valid = 32; P.gain = nullptr; P.K = 2816; P.WT = C.Wdn + (size_t)l * 1024 * 2816; P.drow = n0; P.k0 = 64 * kb; return P; }
}
__device__ __forceinline__ void p0_load(const P0Item& P, float (&wv)[32], int lane) {
    const int c31 = lane & 31;
#pragma unroll
    for (int i = 0; i < 32; ++i) { const int kk = 2 * i + (lane >> 5); wv[i] = (c31 < P.valid) ? P.W[(size_t)(P.k0 + kk) * P.nsrc + P.col + c31] : 0.f; }
}
__device__ __forceinline__ void p0_finish(const P0Item& P, float (&wv)[32], LAS float* scr, int lane) {
    const int c31 = lane & 31;
    if (P.gain) {
#pragma unroll
        for (int i = 0; i < 32; ++i) wv[i] *= P.gain[P.k0 + 2 * i + (lane >> 5)];
    }
#pragma unroll
    for (int i = 0; i < 32; ++i) scr[(2 * i + (lane >> 5)) * 33 + c31] = wv[i];
    const int c = lane & 7;
#pragma unroll
    for (int j = 0; j < 4; ++j) {
        const int n = (lane >> 3) + 8 * j; const LAS float* s = scr + (8 * c) * 33 + n;
        u32x4 o; o.x = pk2(s[0 * 33], s[1 * 33]); o.y = pk2(s[2 * 33], s[3 * 33]); o.z = pk2(s[4 * 33], s[5 * 33]); o.w = pk2(s[6 * 33], s[7 * 33]);
        *(u32x4*)(P.WT + (size_t)(P.drow + n) * P.K + P.k0 + 8 * c) = o;
    }
}
__device__ __forceinline__ void p0_convert(const Ctx& C, int it_begin, int it_end, int gw, int NGW, LAS float* scr, int lane) {
#pragma unroll 1
    for (int it = it_begin + gw; it < it_end; it += NGW) {
        float wa[32];
        const P0Item pa = p0_decode(C, it);
        p0_load(pa, wa, lane);
        p0_finish(pa, wa, scr, lane);
    }
}
constexpr int P0_FIRST = 16 * 96;
constexpr int P0_SPLIT = (16 * 96 + 16 * 32 + 16 * 176 + 44 * 32) + 16 * 96;
constexpr int P0_ALL = 2 * (16 * 96 + 16 * 32 + 16 * 176 + 44 * 32);
#ifndef M1P
#define M1P 7
#endif
__device__ __forceinline__ void ssd_dt_acs(const Ctx& C, int layer, int ck, LAS float* sDT, LAS float* sACS, LAS float* sW, bool has_w, int lane, int wave) {
    const int h = wave, t0 = ck * 64;
    const float raw = C.dtraw[(size_t)(t0 + lane) * 8 + h] + C.in[6][layer * 8 + h];
    const float dt = fmaxf(raw, 0.f) + log1pf(expf(-fabsf(raw)));
    const float av = -expf(C.in[7][layer * 8 + h]) * dt;
    float cs = av;
#pragma unroll
    for (int o = 1; o < 64; o <<= 1) { const float v = __int_as_float(__builtin_amdgcn_ds_bpermute(((lane - o) & 63) << 2, __float_as_int(cs))); if (lane >= o) cs += v; }
    const float aend = __int_as_float(__builtin_amdgcn_readlane(__float_as_int(cs), 63));
    sDT[h * 64 + lane] = dt; sACS[h * 64 + lane] = cs;
    if (has_w) { sW[h * 64 + lane] = dt * expf(aend - cs); if (lane == 63) C.cdecay[ck * 8 + h] = expf(cs); }
}

__device__ __forceinline__ void mix1_phase(const Ctx& C, int layer) {
    LAS float* sDT = (LAS float*)(C.lds); LAS float* sACS = (LAS float*)(C.lds + 2048); LAS float* sW = (LAS float*)(C.lds + 4096);
    LAS bf16* sT = (LAS bf16*)(C.lds + 8192);
    LAS float* sBias = (LAS float*)(C.lds + 122880);
    for (int i = C.tid; i < 4 * 257; i += 512) sBias[i] = C.in[3][layer * 4 * 257 + i] * LOG2E;
    for (int ck = ((C.nblk & 7) == 0 ? (C.bid & 7) * (C.nblk >> 3) + (C.bid >> 3) : C.bid); ck < NCHUNK; ck += C.nblk) {
        int tid = C.tid; asm volatile("" : "+v"(tid));
        const int lane = tid & 63, wave = __builtin_amdgcn_readfirstlane(tid >> 6), fr = lane & 15, fq = lane >> 4;
        const int cin = ck & 127, t0 = ck * 64; const bool first = (cin == 0);
        const float* cw = launder(C.in[4]) + (size_t)layer * 4 * 1024; const float* cb = launder(C.in[5]) + layer * 1024;
        ssd_dt_acs(C, layer, ck, sDT, sACS, sW, true, lane, wave);
        __syncthreads();
        if (tid < 384) {
            const int ch0 = 2 * tid;
            const f32x2 w0 = *(const f32x2*)(cw + 0 * 1024 + ch0), w1 = *(const f32x2*)(cw + 1 * 1024 + ch0), w2 = *(const f32x2*)(cw + 2 * 1024 + ch0), w3 = *(const f32x2*)(cw + 3 * 1024 + ch0);
            const f32x2 bb = *(const f32x2*)(cb + ch0);
            const unsigned* src = (const unsigned*)(C.proj + (size_t)t0 * NPROJ + PJ_XBC + ch0);
            f32x2 xm3 = {0.f, 0.f}, xm2 = {0.f, 0.f}, xm1 = {0.f, 0.f};
            if (!first) { const unsigned a = src[-3 * (NPROJ / 2)], b = src[-2 * (NPROJ / 2)], c = src[-1 * (NPROJ / 2)];
                xm3 = (f32x2){bflo(a), bfhi(a)}; xm2 = (f32x2){bflo(b), bfhi(b)}; xm1 = (f32x2){bflo(c), bfhi(c)}; }
            const int hh = ch0 >> 6; const bool isx = ch0 < 512;
#pragma unroll 1
            for (int l0 = 0; l0 < 64; l0 += 16) {
            unsigned uu[16];
#pragma unroll
            for (int i = 0; i < 16; ++i) uu[i] = src[(l0 + i) * (NPROJ / 2)];
#pragma unroll
            for (int li = 0; li < 16; li += 2) {
                const int l = l0 + li;
                const unsigned ua = uu[li], ub = uu[li + 1];
                const f32x2 xa = {bflo(ua), bfhi(ua)}, xc = {bflo(ub), bfhi(ub)};
                f32x2 ya = bb + w0 * xm3 + w1 * xm2 + w2 * xm1 + w3 * xa;
                f32x2 yb = bb + w0 * xm2 + w1 * xm1 + w2 * xa + w3 * xc;
                xm3 = xm1; xm2 = xa; xm1 = xc;
                ya.x = fsilu(ya.x); ya.y = fsilu(ya.y); yb.x = fsilu(yb.x); yb.y = fsilu(yb.y);
                if (isx) { const float wa = sW[hh * 64 + l], wb = sW[hh * 64 + l + 1]; ya = ya * wa; yb = yb * wb; }
                *(LAS unsigned*)(sT + ch0 * 72 + l) = pk2(ya.x, yb.x);
                *(LAS unsigned*)(sT + (ch0 + 1) * 72 + l) = pk2(ya.y, yb.y);
            }
            }
        }
        __syncthreads();
        if (M1P & 1) {
            const int h = wave, g = h >> 2;
            bf16x8 xf[4][2];
#pragma unroll
            for (int pt = 0; pt < 4; ++pt)
#pragma unroll
                for (int ks = 0; ks < 2; ++ks) xf[pt][ks] = *(const LAS bf16x8*)(sT + (h * 64 + 16 * pt + fr) * 72 + 32 * ks + 8 * fq);
            bf16* st = C.states + (size_t)(ck * 8 + h) * 64 * 128;
#pragma unroll 1
            for (int nt = 0; nt < 8; ++nt) {
                bf16x8 bfr[2];
#pragma unroll
                for (int ks = 0; ks < 2; ++ks) bfr[ks] = *(const LAS bf16x8*)(sT + (512 + g * 128 + 16 * nt + fr) * 72 + 32 * ks + 8 * fq);
#pragma unroll
                for (int pt = 0; pt < 4; ++pt) {
                    f32x4 acc = {0.f, 0.f, 0.f, 0.f};
#pragma unroll
                    for (int ks = 0; ks < 2; ++ks) acc = mfma16(bfr[ks], xf[pt][ks], acc);
                    u32x2 w; w.x = pk2(acc[0], acc[1]); w.y = pk2(acc[2], acc[3]);
                    *(u32x2*)(st + (16 * pt + fr) * 128 + 16 * nt + 4 * fq) = w;
                }
            }
        }
        __syncthreads();
        if (M1P & 2) {
            LAS bf16* G = (LAS bf16*)(C.lds + 8192);
            LAS float* CO = (LAS float*)(C.lds + 8192 + 48128);
            const int c = tid & 255, half = tid >> 8;
#pragma unroll
            for (int it = 0; it < 6; ++it) {
                const int u = tid + 512 * it, r = u >> 5, c8 = u & 31;
                if (u < 94 * 32) {
                    u32x4 o = {0u, 0u, 0u, 0u};
                    if (!(first && r < 30)) {
                        const bf16* p = C.proj + (size_t)(t0 - 30 + r) * NPROJ + PJ_GLU + 8 * c8;
                        const u32x4 av = *(const u32x4*)p, gv = *(const u32x4*)(p + 256);
#pragma unroll
                        for (int e = 0; e < 4; ++e) o[e] = pk2(bflo(av[e]) * fsigmoid(bflo(gv[e])), bfhi(av[e]) * fsigmoid(bfhi(gv[e])));
                    }
                    *(LAS u32x4*)(G + r * 256 + 8 * c8) = o;
                }
            }
            __syncthreads();
            {
                const float* dww = launder(C.in[10]) + (size_t)layer * 31 * 256 + c;
                float w[31];
#pragma unroll
                for (int k = 0; k < 31; ++k) w[k] = dww[k * 256];
                const float bias = launder(C.in[11])[layer * 256 + c];
#pragma unroll 1
                for (int grp = 0; grp < 4; ++grp) {
                    float o[8];
#pragma unroll
                    for (int i = 0; i < 8; ++i) o[i] = bias;
                    const LAS bf16* gp = G + (half * 32 + grp * 8) * 256 + c;
#pragma unroll
                    for (int r = 0; r < 38; ++r) {
                        const float v = bf2f(gp[r * 256]);
#pragma unroll
                        for (int i = 0; i < 8; ++i) { const int k = r - i; if (k >= 0 && k <= 30) o[i] += w[k] * v; }
                    }
#pragma unroll
                    for (int i = 0; i < 8; ++i) CO[(half * 32 + grp * 8 + i) * 256 + c] = o[i];
                }
            }
            __syncthreads();
            {
                const f32x4 lg = *((const f32x4*)(launder(C.in[12]) + layer * 256) + lane), lb = *((const f32x4*)(launder(C.in[13]) + layer * 256) + lane);
#pragma unroll 2
                for (int i = 0; i < 8; ++i) {
                    const int l = wave * 8 + i;
                    const f32x4 v = *((const LAS f32x4*)(CO + l * 256) + lane);
                    const float s = wave_sum((v[0] + v[1]) + (v[2] + v[3]), lane);
                    const float mu = s * (1.f / 256.f);
                    const f32x4 d = v - mu;
                    const float s2 = wave_sum((d[0] * d[0] + d[1] * d[1]) + (d[2] * d[2] + d[3] * d[3]), lane);
                    const float rstd = 1.0f / sqrtf(s2 * (1.f / 256.f) + 1e-6f);
                    const f32x4 y = d * rstd * lg + lb;
                    u32x2 w; w.x = pk2(fsilu(y[0]), fsilu(y[1])); w.y = pk2(fsilu(y[2]), fsilu(y[3]));
                    *((u32x2*)(C.mix + (size_t)(t0 + l) * DM + MX_C) + lane) = w;
                }
            }
        }
        __syncthreads();
        if (M1P & 4) {
            LAS bf16* sK = (LAS bf16*)(C.lds + 8192);
            LAS bf16* sV = (LAS bf16*)(C.lds + 8192 + 33792);
            const int h = wave >> 1, qh = wave & 1, q4 = (lane & 15) >> 2, p4 = lane & 3;
            bf16x8 qf[2][2];
#pragma unroll
            for (int qt = 0; qt < 2; ++qt)
#pragma unroll
                for (int ks = 0; ks < 2; ++ks) qf[qt][ks] = *(const bf16x8*)(C.proj + (size_t)(t0 + 32 * qh + 16 * qt + fr) * NPROJ + PJ_Q + h * 64 + 32 * ks + 8 * fq);
            float mrun[2] = {-1e30f, -1e30f}, lsum[2] = {0.f, 0.f};
            f32x4 oacc[4][2];
#pragma unroll
            for (int dt = 0; dt < 4; ++dt)
#pragma unroll
                for (int qt = 0; qt < 2; ++qt) oacc[dt][qt] = (f32x4){0.f, 0.f, 0.f, 0.f};
            const int jmin = cin >= 8 ? 0 : 8 - cin;
            u32x4 kreg[4], vreg[4];
#define ATT_LOAD(jj) do { const bf16* base_ = C.proj + (size_t)(t0 + ((jj) - 8) * 64) * NPROJ; _Pragma("unroll") for (int i = 0; i < 4; ++i) { const int u = tid + 512 * i, row = u >> 5, c8 = u & 31; \
                kreg[i] = *(const u32x4*)(base_ + (size_t)row * NPROJ + PJ_K + 8 * c8); vreg[i] = *(const u32x4*)(base_ + (size_t)row * NPROJ + PJ_V + 8 * c8); } } while (0)
            ATT_LOAD(jmin);
            for (int j = jmin; j <= 8; ++j) {
#pragma unroll
                for (int i = 0; i < 4; ++i) { const int u = tid + 512 * i, row = u >> 5, c8 = u & 31;
                    *(LAS u32x4*)(sK + row * 264 + 8 * c8) = kreg[i]; *(LAS u32x4*)(sV + row * 264 + 8 * c8) = vreg[i]; }
                __syncthreads();
                if (j < 8) ATT_LOAD(j + 1);
                f32x4 st[4][2];
#pragma unroll
                for (int kt = 0; kt < 4; ++kt) {
                    bf16x8 kf[2];
#pragma unroll
                    for (int ks = 0; ks < 2; ++ks) kf[ks] = *(const LAS bf16x8*)(sK + (16 * kt + fr) * 264 + h * 64 + 32 * ks + 8 * fq);
#pragma unroll
                    for (int qt = 0; qt < 2; ++qt) { f32x4 acc = {0.f, 0.f, 0.f, 0.f};
#pragma unroll
                        for (int ks = 0; ks < 2; ++ks) acc = mfma16(kf[ks], qf[qt][ks], acc);
                        st[kt][qt] = acc; }
                }
                if (j >= 6) {
#pragma unroll
                    for (int kt = 0; kt < 4; ++kt)
#pragma unroll
                        for (int qt = 0; qt < 2; ++qt)
#pragma unroll
                            for (int e = 0; e < 4; ++e) {
                                const int rel = (32 * qh + 16 * qt + fr) + 512 - 64 * j - (16 * kt + 4 * fq + e);
                                const int idx = (rel < -128 ? -128 : (rel > 128 ? 128 : rel)) + 128;
                                st[kt][qt][e] += sBias[h * 257 + idx];
                            }
                } else {
                    const float bc = sBias[h * 257 + 256];
#pragma unroll
                    for (int kt = 0; kt < 4; ++kt)
#pragma unroll
                        for (int qt = 0; qt < 2; ++qt) st[kt][qt] = st[kt][qt] + bc;
                }
#pragma unroll
                for (int qt = 0; qt < 2; ++qt) {
                    float mx = -1e30f;
#pragma unroll
                    for (int kt = 0; kt < 4; ++kt)
#pragma unroll
                        for (int e = 0; e < 4; ++e) mx = fmaxf(mx, st[kt][qt][e]);
                    mx = fmaxf(mx, shflx(mx, 16, lane)); mx = fmaxf(mx, shflx(mx, 32, lane));
                    const float mnew = fmaxf(mrun[qt], mx), alpha = __builtin_amdgcn_exp2f(mrun[qt] - mnew);
                    mrun[qt] = mnew;
                    float ps = 0.f;
#pragma unroll
                    for (int kt = 0; kt < 4; ++kt)
#pragma unroll
                        for (int e = 0; e < 4; ++e) { const float p = __builtin_amdgcn_exp2f(st[kt][qt][e] - mnew); st[kt][qt][e] = p; ps += p; }
                    lsum[qt] = lsum[qt] * alpha + ps;
#pragma unroll
                    for (int dt = 0; dt < 4; ++dt) oacc[dt][qt] = oacc[dt][qt] * alpha;
                }
                bf16x8 pf[2][2];
#pragma unroll
                for (int s2 = 0; s2 < 2; ++s2)
#pragma unroll
                    for (int qt = 0; qt < 2; ++qt) {
                        u32x4 w; w.x = pk2(st[2 * s2][qt][0], st[2 * s2][qt][1]); w.y = pk2(st[2 * s2][qt][2], st[2 * s2][qt][3]);
                        w.z = pk2(st[2 * s2 + 1][qt][0], st[2 * s2 + 1][qt][1]); w.w = pk2(st[2 * s2 + 1][qt][2], st[2 * s2 + 1][qt][3]);
                        pf[s2][qt] = __builtin_bit_cast(bf16x8, w);
                    }
#pragma unroll
                for (int dt = 0; dt < 4; ++dt)
#pragma unroll
                    for (int s2 = 0; s2 < 2; ++s2) {
                        const s16x4 lo = __builtin_amdgcn_ds_read_tr16_b64_v4i16((LAS s16x4*)(sV + (32 * s2 + 4 * fq + q4) * 264 + h * 64 + 16 * dt + 4 * p4));
                        const s16x4 hi = __builtin_amdgcn_ds_read_tr16_b64_v4i16((LAS s16x4*)(sV + (32 * s2 + 16 + 4 * fq + q4) * 264 + h * 64 + 16 * dt + 4 * p4));
                        const bf16x8 vf = __builtin_shufflevector(lo, hi, 0, 1, 2, 3, 4, 5, 6, 7);
#pragma unroll
                        for (int qt = 0; qt < 2; ++qt) oacc[dt][qt] = mfma16(vf, pf[s2][qt], oacc[dt][qt]);
                    }
                __syncthreads();
            }
#undef ATT_LOAD
#pragma unroll
            for (int qt = 0; qt < 2; ++qt) {
                float l = lsum[qt]; l += shflx(l, 16, lane); l += shflx(l, 32, lane);
                const float inv = 1.0f / l;
                bf16* op = C.mix + (size_t)(t0 + 32 * qh + 16 * qt + fr) * DM + MX_A + h * 64 + 4 * fq;
#pragma unroll
                for (int dt = 0; dt < 4; ++dt) { u32x2 w; w.x = pk2(oacc[dt][qt][0] * inv, oacc[dt][qt][1] * inv); w.y = pk2(oacc[dt][qt][2] * inv, oacc[dt][qt][3] * inv);
                    *(u32x2*)(op + 16 * dt) = w; }
            }
        }
        __syncthreads();
    }
}

__device__ __forceinline__ void aux_phase(const Ctx& C, int mode, int layer) {
    int cb = 0, ce = 0, gw = 0, ngw = 1;
    if (mode == 0) {
        const int NGW = C.nblk * 8; gw = C.bid * 8 + C.wave; const int lane = C.lane;
        const float* x = C.in[0];
    for (int row0 = gw * 2; row0 < M; row0 += NGW * 2) {
        f32x4 v[2][4];
#pragma unroll
        for (int r = 0; r < 2; ++r)
#pragma unroll
            for (int j = 0; j < 4; ++j) v[r][j] = *((const f32x4*)(x + (size_t)(row0 + r) * DM) + lane + 64 * j);
#pragma unroll
        for (int r = 0; r < 2; ++r) {
            float s = 0.f;
#pragma unroll
            for (int j = 0; j < 4; ++j) s += (v[r][j][0] * v[r][j][0] + v[r][j][1] * v[r][j][1]) + (v[r][j][2] * v[r][j][2] + v[r][j][3] * v[r][j][3]);
            s = wave_sum(s, lane);
            u32x2* o = (u32x2*)(C.xb + (size_t)(row0 + r) * DM) + lane;
#pragma unroll
            for (int j = 0; j < 4; ++j) { u32x2 w; w.x = pk2(v[r][j][0], v[r][j][1]); w.y = pk2(v[r][j][2], v[r][j][3]); o[64 * j] = w; }
            if (lane < 16) C.ssq[(size_t)(row0 + r) * 16 + lane] = (lane == 0) ? s : 0.f;
        }
    }

        cb = 0; ce = P0_FIRST; ngw = NGW;
    } else if (C.tid < 256) {
        for (int gt = C.bid * 256 + C.tid; gt < 65536; gt += C.nblk * 256) {
            const int b = gt >> 15, e2 = gt & 32767, h = __builtin_amdgcn_readfirstlane(e2 >> 12);
            const unsigned* p = (const unsigned*)C.states + (size_t)b * 128 * 32768 + e2;
            unsigned* q = (unsigned*)C.states + (size_t)b * 128 * 32768 + e2;
            const float* cd = C.cdecay + __builtin_amdgcn_readfirstlane(b) * 128 * 8 + h;
            float s0 = 0.f, s1 = 0.f;
#pragma unroll 1
            for (int c0 = 0; c0 < 128; c0 += 16) {
                unsigned u[16];
#pragma unroll
                for (int i = 0; i < 16; ++i) u[i] = p[(size_t)(c0 + i) * 32768];
#pragma unroll
                for (int i = 0; i < 16; ++i) { const float d = cd[(c0 + i) * 8]; q[(size_t)(c0 + i) * 32768] = pk2(s0, s1); s0 = s0 * d + bflo(u[i]); s1 = s1 * d + bfhi(u[i]); }
            }
        }
    } else { cb = layer == 0 ? P0_FIRST : P0_SPLIT; ce = layer == 0 ? P0_SPLIT : P0_ALL; gw = C.bid * 4 + (C.wave - 4); ngw = C.nblk * 4; }
    if (ce > cb) p0_convert(C, cb, ce, gw, ngw, (LAS float*)(C.lds + C.wave * 8448), C.lane);
}

__device__ __forceinline__ void mix3_phase(const Ctx& C, int layer) {
    LAS float* sDT = (LAS float*)(C.lds); LAS float* sACS = (LAS float*)(C.lds + 2048); LAS float* sPART = (LAS float*)(C.lds + 4096);
    LAS bf16* sC = (LAS bf16*)(C.lds + 8192);
    LAS bf16* sB = (LAS bf16*)(C.lds + 41984);
    LAS float* sCB = (LAS float*)(C.lds + 41984);
    LAS bf16* sXT = (LAS bf16*)(C.lds + 75776);
    for (int ck = ((C.nblk & 7) == 0 ? (C.bid & 7) * (C.nblk >> 3) + (C.bid >> 3) : C.bid); ck < NCHUNK; ck += C.nblk) {
        int tid = C.tid; asm volatile("" : "+v"(tid));
        const int lane = tid & 63, wave = __builtin_amdgcn_readfirstlane(tid >> 6), fr = lane & 15, fq = lane >> 4;
        const int cin = ck & 127, t0 = ck * 64; const bool first = (cin == 0);
        const float* cw = launder(C.in[4]) + (size_t)layer * 4 * 1024; const float* cb = launder(C.in[5]) + layer * 1024;
        ssd_dt_acs(C, layer, ck, sDT, sACS, sPART, false, lane, wave);
        {
            const int ch0 = 2 * tid;
            const f32x2 w0 = *(const f32x2*)(cw + 0 * 1024 + ch0), w1 = *(const f32x2*)(cw + 1 * 1024 + ch0), w2 = *(const f32x2*)(cw + 2 * 1024 + ch0), w3 = *(const f32x2*)(cw + 3 * 1024 + ch0);
            const f32x2 bb = *(const f32x2*)(cb + ch0);
            const unsigned* src = (const unsigned*)(C.proj + (size_t)t0 * NPROJ + PJ_XBC + ch0);
            f32x2 xm3 = {0.f, 0.f}, xm2 = {0.f, 0.f}, xm1 = {0.f, 0.f};
            if (!first) { const unsigned a = src[-3 * (NPROJ / 2)], b = src[-2 * (NPROJ / 2)], c = src[-1 * (NPROJ / 2)];
                xm3 = (f32x2){bflo(a), bfhi(a)}; xm2 = (f32x2){bflo(b), bfhi(b)}; xm1 = (f32x2){bflo(c), bfhi(c)}; }
            LAS bf16* nat = (ch0 < 768) ? (sB + (ch0 - 512)) : (sC + (ch0 - 768));
#pragma unroll 1
            for (int l0 = 0; l0 < 64; l0 += 16) {
            unsigned uu[16];
#pragma unroll
            for (int i = 0; i < 16; ++i) uu[i] = src[(l0 + i) * (NPROJ / 2)];
#pragma unroll
            for (int li = 0; li < 16; li += 2) {
                const int l = l0 + li;
                const unsigned ua = uu[li], ub = uu[li + 1];
                const f32x2 xa = {bflo(ua), bfhi(ua)}, xc = {bflo(ub), bfhi(ub)};
                f32x2 ya = bb + w0 * xm3 + w1 * xm2 + w2 * xm1 + w3 * xa;
                f32x2 yb = bb + w0 * xm2 + w1 * xm1 + w2 * xa + w3 * xc;
                xm3 = xm1; xm2 = xa; xm1 = xc;
                ya.x = fsilu(ya.x); ya.y = fsilu(ya.y); yb.x = fsilu(yb.x); yb.y = fsilu(yb.y);
                if (ch0 < 512) {
                    *(LAS unsigned*)(sXT + ch0 * 72 + l) = pk2(ya.x, yb.x);
                    *(LAS unsigned*)(sXT + (ch0 + 1) * 72 + l) = pk2(ya.y, yb.y);
                } else {
                    *(LAS unsigned*)(nat + l * 264) = pk2(ya.x, ya.y);
                    *(LAS unsigned*)(nat + (l + 1) * 264) = pk2(yb.x, yb.y);
                }
            }
            }
        }
        __syncthreads();
        {
            const int g = wave >> 2, lt = wave & 3;
            f32x4 acc[4];
#pragma unroll
            for (int st = 0; st < 4; ++st) acc[st] = (f32x4){0.f, 0.f, 0.f, 0.f};
#pragma unroll
            for (int ks = 0; ks < 4; ++ks) {
                const bf16x8 af = *(const LAS bf16x8*)(sC + (16 * lt + fr) * 264 + g * 128 + 32 * ks + 8 * fq);
#pragma unroll
                for (int st = 0; st < 4; ++st) { const bf16x8 bfr = *(const LAS bf16x8*)(sB + (16 * st + fr) * 264 + g * 128 + 32 * ks + 8 * fq); acc[st] = mfma16(af, bfr, acc[st]); }
            }
            __syncthreads();
#pragma unroll
            for (int st = 0; st < 4; ++st)
#pragma unroll
                for (int e = 0; e < 4; ++e) sCB[(g * 64 + 16 * lt + 4 * fq + e) * 66 + 16 * st + fr] = acc[st][e];
        }
        __syncthreads();
        {
            const int h = wave, g = h >> 2;
            f32x4 acc[4][4];
#pragma unroll
            for (int lt = 0; lt < 4; ++lt)
#pragma unroll
                for (int pt = 0; pt < 4; ++pt) acc[lt][pt] = (f32x4){0.f, 0.f, 0.f, 0.f};
            const bf16* prev = C.states + (size_t)(ck * 8 + h) * 64 * 128;
#pragma unroll
            for (int ks = 0; ks < 4; ++ks) {
                bf16x8 cf[4];
#pragma unroll
                for (int lt = 0; lt < 4; ++lt) cf[lt] = *(const LAS bf16x8*)(sC + (16 * lt + fr) * 264 + g * 128 + 32 * ks + 8 * fq);
#pragma unroll
                for (int pt = 0; pt < 4; ++pt) {
                    const bf16x8 pfr = *(const bf16x8*)(prev + (16 * pt + fr) * 128 + 32 * ks + 8 * fq);
#pragma unroll
                    for (int lt = 0; lt < 4; ++lt) acc[lt][pt] = mfma16(pfr, cf[lt], acc[lt][pt]);
                }
                __builtin_amdgcn_sched_barrier(0);
            }
#pragma unroll
            for (int lt = 0; lt < 4; ++lt) {
                const float ea = fexp(sACS[h * 64 + 16 * lt + fr]);
#pragma unroll
                for (int pt = 0; pt < 4; ++pt) acc[lt][pt] = acc[lt][pt] * ea;
            }
#pragma unroll
            for (int ks2 = 0; ks2 < 2; ++ks2) {
                bf16x8 xf[4];
#pragma unroll
                for (int pt = 0; pt < 4; ++pt) xf[pt] = *(const LAS bf16x8*)(sXT + (h * 64 + 16 * pt + fr) * 72 + 32 * ks2 + 8 * fq);
                const f32x4 as0 = *(const LAS f32x4*)(sACS + h * 64 + 32 * ks2 + 8 * fq), as1 = *(const LAS f32x4*)(sACS + h * 64 + 32 * ks2 + 8 * fq + 4);
                const f32x4 dt0 = *(const LAS f32x4*)(sDT + h * 64 + 32 * ks2 + 8 * fq), dt1 = *(const LAS f32x4*)(sDT + h * 64 + 32 * ks2 + 8 * fq + 4);
#pragma unroll
                for (int lt = 0; lt < 4; ++lt) {
                    if (ks2 == 1 && lt < 2) continue;
                    const int l = 16 * lt + fr; const float al = sACS[h * 64 + l];
                    const LAS f32x2* cbp = (const LAS f32x2*)(sCB + (g * 64 + l) * 66 + 32 * ks2 + 8 * fq);
                    const f32x2 c01 = cbp[0], c23 = cbp[1], c45 = cbp[2], c67 = cbp[3];
                    const float cbv[8] = {c01.x, c01.y, c23.x, c23.y, c45.x, c45.y, c67.x, c67.y};
                    const float asv[8] = {as0[0], as0[1], as0[2], as0[3], as1[0], as1[1], as1[2], as1[3]};
                    const float dtv[8] = {dt0[0], dt0[1], dt0[2], dt0[3], dt1[0], dt1[1], dt1[2], dt1[3]};
                    float v[8];
#pragma unroll
                    for (int jj = 0; jj < 8; ++jj) { const int sidx = 32 * ks2 + 8 * fq + jj; const float t = cbv[jj] * fexp(al - asv[jj]) * dtv[jj]; v[jj] = (sidx <= l) ? t : 0.f; }
                    u32x4 w; w.x = pk2(v[0], v[1]); w.y = pk2(v[2], v[3]); w.z = pk2(v[4], v[5]); w.w = pk2(v[6], v[7]);
                    const bf16x8 af = __builtin_bit_cast(bf16x8, w);
#pragma unroll
                    for (int pt = 0; pt < 4; ++pt) acc[lt][pt] = mfma16(xf[pt], af, acc[lt][pt]);
                }
            }
            const float Dh = launder(C.in[8])[layer * 8 + h];
#pragma unroll
            for (int lt = 0; lt < 4; ++lt) {
                const int l = 16 * lt + fr; float q = 0.f;
#pragma unroll
                for (int pt = 0; pt < 4; ++pt) {
                    const int p0 = 16 * pt + 4 * fq;
                    const u32x2 zz = *(const u32x2*)(C.proj + (size_t)(t0 + l) * NPROJ + PJ_Z + h * 64 + p0);
                    const float zv[4] = {bflo(zz.x), bfhi(zz.x), bflo(zz.y), bfhi(zz.y)};
#pragma unroll
                    for (int e = 0; e < 4; ++e) {
                        const float xv = bf2f(sXT[(h * 64 + p0 + e) * 72 + l]);
                        const float y = (acc[lt][pt][e] + xv * Dh) * fsilu(zv[e]);
                        acc[lt][pt][e] = y; q += y * y;
                    }
                }
                q += shflx(q, 16, lane); q += shflx(q, 32, lane);
                if (fq == 0) sPART[h * 64 + l] = q;
            }
            __syncthreads();
            const float* ng = launder(C.in[9]) + layer * 512 + h * 64;
#pragma unroll
            for (int lt = 0; lt < 4; ++lt) {
                const int l = 16 * lt + fr;
                const float tot = (sPART[(4 * g) * 64 + l] + sPART[(4 * g + 1) * 64 + l]) + (sPART[(4 * g + 2) * 64 + l] + sPART[(4 * g + 3) * 64 + l]);
                const float rs = 1.0f / sqrtf(tot * (1.f / 256.f) + 1e-6f);
#pragma unroll
                for (int pt = 0; pt < 4; ++pt) {
                    const int p0 = 16 * pt + 4 * fq;
                    const f32x4 gg = *(const f32x4*)(ng + p0);
                    u32x2 w; w.x = pk2(acc[lt][pt][0] * rs * gg[0], acc[lt][pt][1] * rs * gg[1]); w.y = pk2(acc[lt][pt][2] * rs * gg[2], acc[lt][pt][3] * rs * gg[3]);
                    *(u32x2*)(C.mix + (size_t)(t0 + l) * DM + MX_B + h * 64 + p0) = w;
                }
            }
        }
        __syncthreads();
    }
}

__device__ __forceinline__ void final_phase(const Ctx& C) {
    const int gw = C.bid * 8 + C.wave, NGW = C.nblk * 8, lane = C.lane;
    f32x4 gg[2][2];
#pragma unroll
    for (int j = 0; j < 2; ++j) { gg[j][0] = *(const f32x4*)(C.in[19] + 512 * j + 8 * lane); gg[j][1] = *(const f32x4*)(C.in[19] + 512 * j + 8 * lane + 4); }
    for (int row0 = gw * 2; row0 < M; row0 += NGW * 2) {
        u32x4 v[2][2]; float rs[2];
#pragma unroll
        for (int r = 0; r < 2; ++r) {
            rs[r] = pg8::rstd_of(C.ssq, row0 + r);
#pragma unroll
            for (int j = 0; j < 2; ++j) v[r][j] = *(const u32x4*)(C.xb + (size_t)(row0 + r) * DM + 512 * j + 8 * lane);
        }
#pragma unroll
        for (int r = 0; r < 2; ++r)
#pragma unroll
            for (int j = 0; j < 2; ++j) {
                const u32x4 w = v[r][j];
                const f32x4 a = {bflo(w.x), bfhi(w.x), bflo(w.y), bfhi(w.y)}, b = {bflo(w.z), bfhi(w.z), bflo(w.w), bfhi(w.w)};
                float* o = C.out + (size_t)(row0 + r) * DM + 512 * j + 8 * lane;
                *(f32x4*)o = a * rs[r] * gg[j][0]; *(f32x4*)(o + 4) = b * rs[r] * gg[j][1];
            }
    }
}

#define XB_TMO      128
#define XB_XCNT(j)  (256  + 64 * (j))
#define XB_XSUB(j)  (1280 + 64 * (j))
#define XB_XGEN(j)  (2304 + 64 * (j))
#define XB_TOP      3328
#define XB_TOPGEN   3392
#define XCD_BAR_WORDS 3456
#define XB_SPIN_CAP (1u << 18)

__device__ __forceinline__ unsigned xb_ld(unsigned* p)              { return __hip_atomic_load(p, __ATOMIC_RELAXED, __HIP_MEMORY_SCOPE_AGENT); }
__device__ __forceinline__ unsigned xb_add(unsigned* p, unsigned v) { return __hip_atomic_fetch_add(p, v, __ATOMIC_RELAXED, __HIP_MEMORY_SCOPE_AGENT); }
__device__ __forceinline__ unsigned xb_xcc_id() { return (unsigned)__builtin_amdgcn_s_getreg((3 << 11) | 20) & 0xFu; }
#define XB_SPIN(cond, bar) do { unsigned _sp = 0; while (cond) { __builtin_amdgcn_s_sleep(1); \
    if ((++_sp & 255u) == 0u) { if (xb_ld(&(bar)[XB_TMO])) break; if (_sp > XB_SPIN_CAP) { atomicAdd(&(bar)[XB_TMO], 1u); break; } } } } while (0)

struct XcdBarrier {
    unsigned* bar; unsigned x;
    volatile LAS unsigned* st;
};

__device__ __forceinline__ XcdBarrier xcd_barrier_post(unsigned* bar, volatile LAS unsigned* st) {
    XcdBarrier b; b.bar = bar; b.x = xb_xcc_id(); b.st = st;
    if (threadIdx.x == 0) (void)xb_add(&bar[XB_XCNT(b.x)], 1u);
    return b;
}
__device__ __forceinline__ void xcd_barrier_complete(unsigned* bar, unsigned x, unsigned& nloc, unsigned& nx) {
    const unsigned G = gridDim.x * gridDim.y * gridDim.z;
    unsigned sum, cnt, mine, sp = 0u;
    for (;;) {
        sum = 0u; cnt = 0u; mine = 0u;
#pragma unroll
        for (unsigned j = 0; j < 16; ++j) { const unsigned c = xb_ld(&bar[XB_XCNT(j)]); sum += c; cnt += (c > 0u) ? 1u : 0u; mine = (j == x) ? c : mine; }
        if (sum == G) break;
        __builtin_amdgcn_s_sleep(1);
        if ((++sp & 255u) == 0u) { if (xb_ld(&bar[XB_TMO])) break; if (sp > XB_SPIN_CAP) { atomicAdd(&bar[XB_TMO], 1u); break; } }
    }
    nloc = mine > 0u ? mine : 1u; nx = cnt > 0u ? cnt : 1u;
}

__device__ __forceinline__ void xcd_barrier(const XcdBarrier& b) {
    asm volatile("s_waitcnt vmcnt(0)" ::: "memory");
    __syncthreads();
    if (threadIdx.x == 0) {
        unsigned* bar = b.bar;
        __builtin_amdgcn_s_waitcnt(0);
        unsigned nloc = b.st[0], nx = b.st[1];
        if (nloc == 0u) { xcd_barrier_complete(bar, b.x, nloc, nx); b.st[0] = nloc; b.st[1] = nx; }
        const unsigned old = xb_add(&bar[XB_XSUB(b.x)], 1u);
        const unsigned gen = old / nloc;
        if (old + 1u == (gen + 1u) * nloc) {
            __builtin_amdgcn_fence(__ATOMIC_RELEASE, "agent");
            asm volatile("s_waitcnt vmcnt(0)" ::: "memory");
            const unsigned og = xb_add(&bar[XB_TOP], 1u);
            const unsigned tg = og / nx;
            if (og + 1u == (tg + 1u) * nx) xb_add(&bar[XB_TOPGEN], 1u);
            else XB_SPIN(xb_ld(&bar[XB_TOPGEN]) == tg, bar);
            __builtin_amdgcn_fence(__ATOMIC_ACQUIRE, "agent");
            xb_add(&bar[XB_XGEN(b.x)], 1u);
            asm volatile("s_waitcnt vmcnt(0)" ::: "memory");
        } else {
            XB_SPIN(xb_ld(&bar[XB_XGEN(b.x)]) == gen, bar);
            __builtin_amdgcn_fence(__ATOMIC_ACQUIRE, "agent");
            asm volatile("s_waitcnt vmcnt(0)" ::: "memory");
        }
    }
    __syncthreads();
}

#ifndef PHMASK
#define PHMASK 0x1ff
#endif
#define PHEN(x) (((PHMASK) >> (x)) & 1)
#define CAS __attribute__((address_space(4)))
__device__ __forceinline__ Ctx make_ctx(const CAS Args* ap, LAS unsigned char* lds, int tidv, int bid, int nblk) {
    Ctx C; C.bid = bid; C.nblk = nblk;
    C.lds = lds; C.tid = tidv; C.lane = tidv & 63; C.wave = __builtin_amdgcn_readfirstlane(tidv >> 6);
#pragma unroll
    for (int i = 0; i < 20; ++i) C.in[i] = ap->in[i];
    C.out = ap->out;
    unsigned char* ws = ap->ws;
    C.Win = (bf16*)(ws + WS_WIN); C.Wout = (bf16*)(ws + WS_WOUT); C.Wgu = (bf16*)(ws + WS_WGU); C.Wdn = (bf16*)(ws + WS_WDN);
    C.xb = (bf16*)(ws + WS_XB); C.mix = (bf16*)(ws + WS_MIX); C.states = (bf16*)(ws + WS_ST); C.proj = (bf16*)(ws + WS_PROJ);
    C.ssq = (float*)(ws + WS_SSQ); C.dtraw = (float*)(ws + WS_DT); C.cdecay = (float*)(ws + WS_CD);
    return C;
}
__global__ void __launch_bounds__(512, 2) fwd_kernel(Args a_unused) {
    extern __shared__ __attribute__((aligned(16))) unsigned char lds_raw[];
    cg::grid_group grid = cg::this_grid();
    LAS unsigned char* lds = (LAS unsigned char*)lds_raw;
    const CAS Args* ap0 = (const CAS Args*)__builtin_amdgcn_kernarg_segment_ptr();
    const int ph_lo = ap0->ph_lo, ph_hi = ap0->ph_hi, coop = ap0->coop;
    volatile LAS unsigned* MISC = (volatile LAS unsigned*)(lds + LDS_BYTES - 64);
    if (threadIdx.x < 16) MISC[threadIdx.x] = 0u;
    __syncthreads();
    unsigned* barw = (unsigned*)(ap0->ws);
    XcdBarrier bar; bar.bar = barw; bar.x = 0; bar.st = MISC;
    bool bar_ready = false;
    for (int ph = ph_lo; ph < ph_hi; ++ph) {
        const CAS Args* ap = ap0; asm volatile("" : "+s"(ap));
        int tidv = threadIdx.x; asm volatile("" : "+v"(tidv));
        int bid = blockIdx.x, nblk = gridDim.x; asm volatile("" : "+s"(bid), "+s"(nblk));
        if (ph == NPHASES - 1) { if (PHEN(8)) { const Ctx C = make_ctx(ap, lds, tidv, bid, nblk); final_phase(C); } }
        else {
            const int l = (ph == 0) ? 0 : (ph - 1) / 7, t = (ph == 0) ? 2 : (ph - 1) % 7;
            if (t == 0 || t >= 4) { if (PHEN(1)) {
                const Ctx C = make_ctx(ap, lds, tidv, bid, nblk);
                pg8::Gemm g; int N;
                pg8::EpiAny E; E.e0 = pg8::EpiInProj{C.proj, C.dtraw, (const LAS float*)(lds + 131072)}; E.e1 = pg8::EpiResid{(l == 0 && t == 4) ? C.in[0] : (const float*)nullptr, C.xb, C.ssq}; E.e2 = pg8::EpiGateUp{C.proj, (const LAS float*)(lds + 131072)};
                if (t == 0)      { g = pg8::Gemm{C.xb, C.Win + (size_t)l * 3072 * 1024, M, 3072, 1024}; N = 3072; E.mode = 0; }
                else if (t == 4) { g = pg8::Gemm{C.mix, C.Wout + (size_t)l * 1024 * 1024, M, 1024, 1024}; N = 1024; E.mode = 1; }
                else if (t == 5) { g = pg8::Gemm{C.xb, C.Wgu + (size_t)l * 5632 * 1024, M, 5632, 1024}; N = 5632; E.mode = 2; }
                else             { g = pg8::Gemm{C.proj, C.Wdn + (size_t)l * 1024 * 2816, M, 1024, 2816}; N = 1024; E.mode = 1; }
                pg8::StaticOrder S; S.init(M, N, nblk, bid);
                LAS float* rsl = (LAS float*)(lds + 131072);
                if (E.mode != 1) {
                    pg8::Unit uu;
                    for (int i = 0; i < 16 && S.next(i, uu); ++i) if (tidv < 256) rsl[i * 256 + tidv] = pg8::rstd_of(C.ssq, uu.pm * 256 + tidv);
                    __syncthreads();
                }
                pg8::gemm_phase<pg8::EpiAny, pg8::StaticOrder, true, true>(lds, g, S, E, tidv); }
            } else if (t == 1) { if (PHEN(2)) { const Ctx C = make_ctx(ap, lds, tidv, bid, nblk); mix1_phase(C, l); } }
            else if (t == 2) { if (PHEN(3)) { const Ctx C = make_ctx(ap, lds, tidv, bid, nblk); aux_phase(C, ph == 0 ? 0 : 1, l); } }
            else { if (PHEN(4)) { const Ctx C = make_ctx(ap, lds, tidv, bid, nblk); mix3_phase(C, l); } }
        }
        if (ph + 1 < ph_hi && coop) {
            if (!bar_ready) {
                if (bid == 0) for (int i = tidv; i < XCD_BAR_WORDS; i += 512) __hip_atomic_store(barw + i, 0u, __ATOMIC_RELAXED, __HIP_MEMORY_SCOPE_AGENT);
                grid.sync();
                bar = xcd_barrier_post(barw, MISC); bar_ready = true;
            } else xcd_barrier(bar);
        }
    }
}

#ifndef MK_MULTI
#define MK_MULTI 0
#endif
extern "C" void kernel_launch(void* const* d_in, const int* in_sizes, int n_in, void* d_out, int out_size, void* d_ws, size_t ws_size, hipStream_t stream) {
    static int grid = 0;
    if (grid == 0) {
        if (n_in != 20 || out_size != M * DM || ws_size < WS_END) { fprintf(stderr, "kernel_launch: unexpected shapes (n_in %d out %d ws %zu)\n", n_in, out_size, ws_size); grid = -1; return; }
        int dev = 0, cus = 0, per_cu = 0;
        hipGetDevice(&dev); hipDeviceGetAttribute(&cus, hipDeviceAttributeMultiprocessorCount, dev);
        if (hipFuncSetAttribute((const void*)fwd_kernel, hipFuncAttributeMaxDynamicSharedMemorySize, LDS_BYTES) != hipSuccess) { fprintf(stderr, "kernel_launch: hipFuncSetAttribute failed\n"); grid = -1; return; }
        if (hipOccupancyMaxActiveBlocksPerMultiprocessor(&per_cu, (const void*)fwd_kernel, 512, LDS_BYTES) != hipSuccess || per_cu < 1) { fprintf(stderr, "kernel_launch: occupancy query gave %d\n", per_cu); per_cu = 1; (void)hipGetLastError(); }
        grid = cus * per_cu; if (grid > 256) grid = 256;
    }
    if (grid < 0) return;
    Args a{};
    for (int i = 0; i < 20; ++i) a.in[i] = (const float*)d_in[i];
    a.out = (float*)d_out; a.ws = (unsigned char*)d_ws;
#if MK_MULTI
    a.coop = 0;
    for (int ph = 0; ph < NPHASES; ++ph) { a.ph_lo = ph; a.ph_hi = ph + 1; hipLaunchKernelGGL(fwd_kernel, dim3(grid), dim3(512), LDS_BYTES, stream, a); }
#else
    a.coop = 1; a.ph_lo = 0; a.ph_hi = NPHASES;
    void* args[] = {&a};
    hipError_t e = hipLaunchCooperativeKernel((const void*)fwd_kernel, dim3(grid), dim3(512), args, LDS_BYTES, stream);
    if (e != hipSuccess) fprintf(stderr, "kernel_launch: cooperative launch failed: %s (grid %d)\n", hipGetErrorString(e), grid);
#endif
}
```

```cpp
#include <hip/hip_runtime.h>
#include <hip/hip_cooperative_groups.h>
#include <cstdio>
#include <cstdint>
namespace cg = cooperative_groups;
namespace pg8 {
#define PG8_LAS __attribute__((address_space(3)))
typedef unsigned short bf16_t;
typedef short bf16x8 __attribute__((ext_vector_type(8)));
typedef float f32x4 __attribute__((ext_vector_type(4)));
typedef unsigned u32x4 __attribute__((ext_vector_type(4)));
constexpr int BM = 256, BK = 64, HALF = 128, HTB = HALF * BK * 2  , STAGE_BYTES = 8 * HTB, NXCD = 8, WGM = 8;

__host__ __device__ __forceinline__ int lds_byte(int r, int c) { const int st = (r >> 4) * 2 + (c >> 5), rr = r & 15, cc = c & 31, ob = rr * 64 + cc * 2; return st * 1024 + (ob ^ (((ob >> 9) & 1) << 5)); }
__host__ __device__ __forceinline__ void stage_rc(int b, int& R, int& C) { const int st = b / 1024, sb = b % 1024, swz = sb ^ (((sb >> 9) & 1) << 5); R = (st >> 1) * 16 + swz / 64; C = (st & 1) * 32 + (swz % 64) / 2; }
__host__ __device__ __forceinline__ int perm32(int rho) { const int n = rho >> 4, i = rho & 15; return 8 * (i >> 2) + 4 * n + (i & 3); }

struct Unit { int pm, pn, idx; };
struct Gemm { const bf16_t* A; const bf16_t* Bt; int M, N, K; };

struct StaticOrder {
    int nM, nN, nwg, G, c;
    __host__ __device__ void init(int M, int N, int G_, int c_) { nM = M / BM; nN = N / BM; nwg = nM * nN; G = G_; c = c_; }
    __host__ __device__ bool next(int i, Unit& u) const {
        const long L = (long)i * G + c; if (L >= nwg) return false; u.idx = i;
        int wgid = (int)L; { const int q = nwg / NXCD, r = nwg % NXCD, xcd = wgid % NXCD, off = wgid / NXCD; wgid = (xcd < r ? xcd * (q + 1) : r * (q + 1) + (xcd - r) * q) + off; }
        const int nig = WGM * nN, gid = wgid / nig, fm = gid * WGM, gsz = (nM - fm) < WGM ? (nM - fm) : WGM;
        u.pm = fm + ((wgid % nig) % gsz); u.pn = (wgid % nig) / gsz; return true;
    }
    __device__ __forceinline__ void a_ready(const Unit&) const {}
    __device__ __forceinline__ void done(const Unit&) const {}
};

__device__ __forceinline__ unsigned cvt_pk_bf16(float lo, float hi) { unsigned r; asm volatile("v_cvt_pk_bf16_f32 %0, %1, %2" : "=v"(r) : "v"(lo), "v"(hi)); return r; }
__device__ __forceinline__ float shflx(float v, int mask, int lane) { return __int_as_float(__builtin_amdgcn_ds_bpermute((lane ^ mask) << 2, __float_as_int(v))); }
__device__ __forceinline__ float rstd_of(const float* ssq, int row) {
    const f32x4* p = (const f32x4*)(ssq + (size_t)row * 16);
    const f32x4 a = p[0], b = p[1], c = p[2], d = p[3];
    const float s = (((a[0] + a[1]) + (a[2] + a[3])) + ((b[0] + b[1]) + (b[2] + b[3]))) + (((c[0] + c[1]) + (c[2] + c[3])) + ((d[0] + d[1]) + (d[2] + d[3])));
    return __builtin_amdgcn_rsqf(s * (1.0f / 1024.0f) + 1e-6f);
}
__device__ __forceinline__ float silu_f(float x) { return x * __builtin_amdgcn_rcpf(1.0f + __builtin_amdgcn_exp2f(-1.4426950408889634f * x)); }
constexpr float QSCALE = 0.125f * 1.4426950408889634f;
struct EpiInProj {
    static constexpr bool PERM = true, AFTER_DRAIN = false;
    bf16_t* proj; float* dtraw; const PG8_LAS float* rsl;
    __device__ __forceinline__ void operator()(const f32x4 (&acc)[2][2][4][2], const Unit& u, int wr, int wc, int fr, int fq) const {
        const int row0 = u.pm * BM + wr * 64 + fr;
        const float sc = (u.pn == 0) ? QSCALE : 1.0f;
#pragma unroll
        for (int ai = 0; ai < 2; ++ai)
#pragma unroll
            for (int m = 0; m < 4; ++m) {
                const int row = row0 + ai * HALF + m * 16;
                const float rs = rsl[u.idx * 256 + (row & 255)] * sc;
                if (u.pn < 11) {
                    bf16_t* rowp = proj + (size_t)row * 2816 + u.pn * BM + wc * 32 + 8 * fq;
#pragma unroll
                    for (int bj = 0; bj < 2; ++bj) {
                        const f32x4 v0 = acc[ai][bj][m][0] * rs, v1 = acc[ai][bj][m][1] * rs;
                        u32x4 w; w.x = cvt_pk_bf16(v0[0], v0[1]); w.y = cvt_pk_bf16(v0[2], v0[3]); w.z = cvt_pk_bf16(v1[0], v1[1]); w.w = cvt_pk_bf16(v1[2], v1[3]);
                        *(u32x4*)(rowp + bj * HALF) = w;
                    }
                } else if (wc == 0 && fq == 0) {
                    *(f32x4*)(dtraw + (size_t)row * 8) = acc[ai][0][m][0] * rs;
                    *(f32x4*)(dtraw + (size_t)row * 8 + 4) = acc[ai][0][m][1] * rs;
                }
            }
    }
};
struct EpiResid {
    static constexpr bool PERM = true, AFTER_DRAIN = false;
    const float* base32; bf16_t* xb; float* ssq;
    __device__ __forceinline__ void operator()(const f32x4 (&acc)[2][2][4][2], const Unit& u, int wr, int wc, int fr, int fq) const {
        const int col0 = u.pn * BM + wc * 32 + 8 * fq, lane_ = fr + 16 * fq;
#pragma unroll
        for (int ai = 0; ai < 2; ++ai)
#pragma unroll
            for (int m = 0; m < 4; ++m) {
                const int row = u.pm * BM + ai * HALF + wr * 64 + m * 16 + fr;
                const size_t off = (size_t)row * 1024 + col0;
                float q = 0.f;
#pragma unroll
                for (int bj = 0; bj < 2; ++bj) {
                    const u32x4 r = *(const u32x4*)(xb + off + bj * HALF);
                    const f32x4 b0 = {__uint_as_float(r.x << 16), __uint_as_float(r.x & 0xffff0000u), __uint_as_float(r.y << 16), __uint_as_float(r.y & 0xffff0000u)};
                    const f32x4 b1 = {__uint_as_float(r.z << 16), __uint_as_float(r.z & 0xffff0000u), __uint_as_float(r.w << 16), __uint_as_float(r.w & 0xffff0000u)};
                    const f32x4 o0 = b0 + acc[ai][bj][m][0], o1 = b1 + acc[ai][bj][m][1];
                    q += ((o0[0] * o0[0] + o0[1] * o0[1]) + (o0[2] * o0[2] + o0[3] * o0[3])) + ((o1[0] * o1[0] + o1[1] * o1[1]) + (o1[2] * o1[2] + o1[3] * o1[3]));
                    u32x4 w; w.x = cvt_pk_bf16(o0[0], o0[1]); w.y = cvt_pk_bf16(o0[2], o0[3]); w.z = cvt_pk_bf16(o1[0], o1[1]); w.w = cvt_pk_bf16(o1[2], o1[3]);
                    *(u32x4*)(xb + off + bj * HALF) = w;
                }
                q += shflx(q, 16, lane_); q += shflx(q, 32, lane_);
                if (fq == 0) ssq[(size_t)row * 16 + u.pn * 4 + wc] = q;
            }
    }
};
struct EpiGateUp {
    static constexpr bool PERM = true, AFTER_DRAIN = false;
    bf16_t* hdn; const PG8_LAS float* rsl;
    __device__ __forceinline__ void operator()(const f32x4 (&acc)[2][2][4][2], const Unit& u, int wr, int wc, int fr, int fq) const {
        const int row0 = u.pm * BM + wr * 64 + fr, col = u.pn * HALF + wc * 32 + 8 * fq;
#pragma unroll
        for (int ai = 0; ai < 2; ++ai)
#pragma unroll
            for (int m = 0; m < 4; ++m) {
                const int row = row0 + ai * HALF + m * 16;
                const float rs = rsl[u.idx * 256 + (row & 255)];
                const f32x4 g0 = acc[ai][0][m][0] * rs, g1 = acc[ai][0][m][1] * rs, u0 = acc[ai][1][m][0] * rs, u1 = acc[ai][1][m][1] * rs;
                u32x4 w;
                w.x = cvt_pk_bf16(silu_f(g0[0]) * u0[0], silu_f(g0[1]) * u0[1]); w.y = cvt_pk_bf16(silu_f(g0[2]) * u0[2], silu_f(g0[3]) * u0[3]);
                w.z = cvt_pk_bf16(silu_f(g1[0]) * u1[0], silu_f(g1[1]) * u1[1]); w.w = cvt_pk_bf16(silu_f(g1[2]) * u1[2], silu_f(g1[3]) * u1[3]);
                *(u32x4*)(hdn + (size_t)row * 2816 + col) = w;
            }
    }
};

struct EpiAny {
    static constexpr bool PERM = true, AFTER_DRAIN = false;
    int mode; EpiInProj e0; EpiResid e1; EpiGateUp e2;
    __device__ __forceinline__ void operator()(const f32x4 (&acc)[2][2][4][2], const Unit& u, int wr, int wc, int fr, int fq) const {
        if (mode == 0) e0(acc, u, wr, wc, fr, fq); else if (mode == 1) e1(acc, u, wr, wc, fr, fq); else e2(acc, u, wr, wc, fr, fq);
    }
};
template <class Epi, class Sched, bool ALIGN_EPI = false, bool SP2 = false>
__device__ __forceinline__ void gemm_phase(PG8_LAS unsigned char* lds, const Gemm g, const Sched& S, const Epi& E, const int tid) {
    const int wid = __builtin_amdgcn_readfirstlane(tid >> 6), lane = tid & 63, wr = wid >> 2, wc = wid & 3, fr = lane & 15, fq = lane >> 4;
    const int K = g.K, nt = K / BK;
    unsigned voffA[2], voffB[2];
#pragma unroll
    for (int i = 0; i < 2; ++i) { int R, C; stage_rc(tid * 16 + i * 8192, R, C); const int Rb = Epi::PERM ? ((R & ~31) + perm32(R & 31)) : R;
        voffA[i] = (unsigned)(R * K + C) * 2u; voffB[i] = (unsigned)(Rb * K + C) * 2u; }
    const size_t kstep = (size_t)(BK * 2);
    const size_t hstep = (size_t)HALF * K * 2;
    const size_t tstep = 2 * hstep;
    const unsigned ldsw = (unsigned)wid * 1024u;
    const int aoff = lds_byte(wr * 64 + fr, fq * 8), boff = lds_byte(wc * 32 + fr, fq * 8);
#define PG8_SA(b, h) (((b) * 2 + (h)) * HTB)
#define PG8_SB(b, h) ((4 + (b) * 2 + (h)) * HTB)
#define PG8_STAGE(bufoff, gbase, voff) do { _Pragma("unroll") for (int _i = 0; _i < 2; ++_i) \
        __builtin_amdgcn_global_load_lds((const unsigned*)((const char*)(gbase) + (voff)[_i]), (PG8_LAS unsigned*)(lds + (bufoff) + ldsw + _i * 8192), 16, 0, 0); } while (0)
#define PG8_LDA(dst, b, h) do { _Pragma("unroll") for (int m = 0; m < 4; ++m) _Pragma("unroll") for (int k = 0; k < 2; ++k) dst[m][k] = *(const PG8_LAS bf16x8*)(lds + PG8_SA(b, h) + aoff + m * 2048 + k * 1024); } while (0)
#define PG8_LDB(dst, b, h) do { _Pragma("unroll") for (int n = 0; n < 2; ++n) _Pragma("unroll") for (int k = 0; k < 2; ++k) dst[n][k] = *(const PG8_LAS bf16x8*)(lds + PG8_SB(b, h) + boff + n * 2048 + k * 1024); } while (0)
#define PG8_MMA(ai, bj, At, Bt) do { __builtin_amdgcn_s_setprio(1); _Pragma("unroll") for (int m = 0; m < 4; ++m) _Pragma("unroll") for (int n = 0; n < 2; ++n) _Pragma("unroll") for (int k = 0; k < 2; ++k) \
        acc[ai][bj][m][n] = __builtin_amdgcn_mfma_f32_16x16x32_bf16(Bt[n][k], At[m][k], acc[ai][bj][m][n], 0, 0, 0); __builtin_amdgcn_s_setprio(0); } while (0)
#define PG8_WAIT_V(n) asm volatile("s_waitcnt vmcnt(" #n ")" ::: "memory")
#define PG8_WAIT_L(n) asm volatile("s_waitcnt lgkmcnt(" #n ")" ::: "memory")
#define PG8_BAR __builtin_amdgcn_s_barrier()
#define PG8_SCHED __builtin_amdgcn_sched_barrier(0)
    Unit cur, nxt; int ui = 0;
    if (!S.next(0, cur)) return;
    f32x4 acc[2][2][4][2];
#pragma unroll
    for (int a = 0; a < 2; ++a)
#pragma unroll
        for (int b = 0; b < 2; ++b)
#pragma unroll
            for (int m = 0; m < 4; ++m)
#pragma unroll
                for (int n = 0; n < 2; ++n) acc[a][b][m][n] = (f32x4){0.f, 0.f, 0.f, 0.f};
    bf16x8 At[4][2], B0[2][2], B1[2][2];
    const char* cA = (const char*)g.A + (size_t)cur.pm * tstep; const char* cB = (const char*)g.Bt + (size_t)cur.pn * tstep;
    S.a_ready(cur);
    if constexpr (SP2) {
        PG8_STAGE(PG8_SB(0, 0), cB, voffB); PG8_STAGE(PG8_SB(0, 1), cB + hstep, voffB); PG8_STAGE(PG8_SA(0, 0), cA, voffA); PG8_STAGE(PG8_SA(0, 1), cA + hstep, voffA);
        if (wr == 1) PG8_BAR;
        PG8_WAIT_V(2); PG8_BAR;
        PG8_STAGE(PG8_SB(1, 0), cB + kstep, voffB); PG8_STAGE(PG8_SA(1, 0), cA + kstep, voffA); PG8_STAGE(PG8_SB(1, 1), cB + hstep + kstep, voffB);
        PG8_WAIT_V(6); PG8_BAR;
    } else {
        PG8_STAGE(PG8_SB(0, 0), cB, voffB); PG8_STAGE(PG8_SA(0, 0), cA, voffA); PG8_STAGE(PG8_SB(0, 1), cB + hstep, voffB); PG8_STAGE(PG8_SA(0, 1), cA + hstep, voffA);
        if (wr == 1) PG8_BAR;
        PG8_WAIT_V(4); PG8_BAR;
        PG8_STAGE(PG8_SB(1, 0), cB + kstep, voffB); PG8_STAGE(PG8_SA(1, 0), cA + kstep, voffA); PG8_STAGE(PG8_SB(1, 1), cB + hstep + kstep, voffB);
        PG8_WAIT_V(6); PG8_BAR;
    }
    for (;;) {
        const bool has_next = S.next(ui + 1, nxt);
        const char* nA = has_next ? (const char*)g.A + (size_t)nxt.pm * tstep : cA; const char* nB = has_next ? (const char*)g.Bt + (size_t)nxt.pn * tstep : cB;
        for (int t = 0; t < nt; t += 2) {
            const bool last = (t == nt - 2);
            const char* a1 = cA + (size_t)(t + 1) * kstep;
            const char* a2 = last ? nA : cA + (size_t)(t + 2) * kstep; const char* b2 = last ? nB : cB + (size_t)(t + 2) * kstep;
            const char* a3 = a2 + kstep; const char* b3 = b2 + kstep;
            if (last && has_next) S.a_ready(nxt);
            if constexpr (SP2) {
            PG8_LDB(B0, 0, 0); PG8_LDB(B1, 0, 1); PG8_SCHED; PG8_LDA(At, 0, 0); PG8_STAGE(PG8_SA(1, 1), a1 + hstep, voffA);
            PG8_WAIT_V(8); PG8_WAIT_L(0); PG8_BAR; PG8_MMA(0, 0, At, B0); PG8_MMA(0, 1, At, B1); PG8_BAR; PG8_SCHED;
            PG8_LDA(At, 0, 1); PG8_STAGE(PG8_SB(0, 0), b2, voffB); PG8_STAGE(PG8_SB(0, 1), b2 + hstep, voffB); PG8_STAGE(PG8_SA(0, 0), a2, voffA);
            PG8_WAIT_V(8); PG8_WAIT_L(0); PG8_BAR; PG8_MMA(1, 0, At, B0); PG8_MMA(1, 1, At, B1); PG8_BAR; PG8_SCHED;
            PG8_LDB(B0, 1, 0); PG8_LDB(B1, 1, 1); PG8_SCHED; PG8_LDA(At, 1, 0); PG8_STAGE(PG8_SA(0, 1), a2 + hstep, voffA);
            PG8_WAIT_V(8); PG8_WAIT_L(0); PG8_BAR; PG8_MMA(0, 0, At, B0); PG8_MMA(0, 1, At, B1); PG8_BAR; PG8_SCHED;
            PG8_LDA(At, 1, 1); PG8_STAGE(PG8_SB(1, 0), b3, voffB); PG8_STAGE(PG8_SB(1, 1), b3 + hstep, voffB); PG8_STAGE(PG8_SA(1, 0), a3, voffA);
            PG8_WAIT_V(8); PG8_WAIT_L(0); PG8_BAR; PG8_MMA(1, 0, At, B0); PG8_MMA(1, 1, At, B1); PG8_BAR; PG8_SCHED;
            } else {
            PG8_LDB(B0, 0, 0); PG8_SCHED; PG8_LDA(At, 0, 0); PG8_STAGE(PG8_SA(1, 1), a1 + hstep, voffA);
            PG8_WAIT_L(8); PG8_BAR; PG8_WAIT_L(0); PG8_MMA(0, 0, At, B0); PG8_BAR; PG8_SCHED;
            PG8_LDB(B1, 0, 1); PG8_STAGE(PG8_SB(0, 0), b2, voffB);
            PG8_BAR; PG8_WAIT_L(0); PG8_MMA(0, 1, At, B1); PG8_BAR;
            PG8_LDA(At, 0, 1); PG8_STAGE(PG8_SA(0, 0), a2, voffA);
            PG8_BAR; PG8_WAIT_L(0); PG8_MMA(1, 0, At, B0); PG8_BAR; PG8_SCHED;
            PG8_STAGE(PG8_SB(0, 1), b2 + hstep, voffB);
            PG8_WAIT_V(6); PG8_BAR; PG8_MMA(1, 1, At, B1); PG8_BAR;
            PG8_LDB(B0, 1, 0); PG8_SCHED; PG8_LDA(At, 1, 0); PG8_STAGE(PG8_SA(0, 1), a2 + hstep, voffA);
            PG8_WAIT_L(8); PG8_BAR; PG8_WAIT_L(0); PG8_MMA(0, 0, At, B0); PG8_BAR; PG8_SCHED;
            PG8_LDB(B1, 1, 1); PG8_STAGE(PG8_SB(1, 0), b3, voffB);
            PG8_BAR; PG8_WAIT_L(0); PG8_MMA(0, 1, At, B1); PG8_BAR;
            PG8_LDA(At, 1, 1); PG8_STAGE(PG8_SA(1, 0), a3, voffA);
            PG8_BAR; PG8_WAIT_L(0); PG8_MMA(1, 0, At, B0); PG8_BAR; PG8_SCHED;
            PG8_STAGE(PG8_SB(1, 1), b3 + hstep, voffB);
            PG8_WAIT_V(6); PG8_BAR; PG8_MMA(1, 1, At, B1); PG8_BAR;
            }
        }
        if constexpr (ALIGN_EPI) { if (wr == 0) PG8_BAR; }
        if constexpr (!Epi::AFTER_DRAIN) { E(acc, cur, wr, wc, fr, fq); S.done(cur); }
        if (!has_next) break;
#pragma unroll
        for (int a = 0; a < 2; ++a)
#pragma unroll
            for (int b = 0; b < 2; ++b)
#pragma unroll
                for (int m = 0; m < 4; ++m)
#pragma unroll
                    for (int n = 0; n < 2; ++n) acc[a][b][m][n] = (f32x4){0.f, 0.f, 0.f, 0.f};
        cur = nxt; cA = nA; cB = nB; ++ui;
        if constexpr (ALIGN_EPI) { if (wr == 1) PG8_BAR; }
    }
    PG8_WAIT_V(0);
    if constexpr (!ALIGN_EPI) { if (wr == 0) PG8_BAR; }
    PG8_BAR;
    if constexpr (Epi::AFTER_DRAIN) { E.fused(acc, cur, wr, wc, fr, fq, lds, wid, lane); S.done(cur); }
#undef PG8_SA
#undef PG8_SB
#undef PG8_STAGE
#undef PG8_LDA
#undef PG8_LDB
#undef PG8_MMA
#undef PG8_WAIT_V
#undef PG8_WAIT_L
#undef PG8_BAR
#undef PG8_SCHED
}
}

#define LAS __attribute__((address_space(3)))
typedef unsigned short bf16;
typedef float f32x4 __attribute__((ext_vector_type(4)));
typedef float f32x2 __attribute__((ext_vector_type(2)));
typedef short bf16x8 __attribute__((ext_vector_type(8)));
typedef unsigned u32x4 __attribute__((ext_vector_type(4)));
typedef unsigned u32x2 __attribute__((ext_vector_type(2)));
typedef __bf16 bf16x2_t __attribute__((ext_vector_type(2)));
typedef short s16x4 __attribute__((ext_vector_type(4)));

constexpr int M = 16384, DM = 1024, NPROJ = 2816, NCHUNK = 256;
constexpr int PJ_Q = 0, PJ_K = 256, PJ_V = 512, PJ_Z = 768, PJ_XBC = 1280, PJ_GLU = 2304;
constexpr int MX_A = 0, MX_B = 256, MX_C = 768;
constexpr size_t MiB = 1u << 20;
constexpr size_t WS_SSQ = 1 * MiB, WS_DT = 2 * MiB, WS_CD = 2 * MiB + 512 * 1024, WS_WIN = 4 * MiB, WS_WOUT = 16 * MiB, WS_WGU = 20 * MiB, WS_WDN = 42 * MiB,
                 WS_XB = 54 * MiB, WS_MIX = 86 * MiB, WS_ST = 118 * MiB, WS_PROJ = 150 * MiB, WS_END = 238 * MiB;
constexpr int LDS_BYTES = 153600;
constexpr float LOG2E = 1.4426950408889634f;
constexpr int NPHASES = 16;

__device__ __forceinline__ float bflo(unsigned u) { return __uint_as_float(u << 16); }
__device__ __forceinline__ float bfhi(unsigned u) { return __uint_as_float(u & 0xffff0000u); }
__device__ __forceinline__ float bf2f(bf16 h) { return __uint_as_float((unsigned)h << 16); }
__device__ __forceinline__ unsigned pk2(float lo, float hi) { f32x2 v = {lo, hi}; bf16x2_t b = __builtin_convertvector(v, bf16x2_t); return __builtin_bit_cast(unsigned, b); }
__device__ __forceinline__ bf16 f2bf(float f) { return (bf16)(pk2(f, 0.f) & 0xffffu); }
__device__ __forceinline__ f32x4 mfma16(bf16x8 a, bf16x8 b, f32x4 c) { return __builtin_amdgcn_mfma_f32_16x16x32_bf16(a, b, c, 0, 0, 0); }
__device__ __forceinline__ float fsilu(float x) { return x * __builtin_amdgcn_rcpf(1.0f + __builtin_amdgcn_exp2f(-LOG2E * x)); }
__device__ __forceinline__ float fsigmoid(float x) { return __builtin_amdgcn_rcpf(1.0f + __builtin_amdgcn_exp2f(-LOG2E * x)); }
__device__ __forceinline__ float fexp(float x) { return __builtin_amdgcn_exp2f(LOG2E * x); }
using pg8::shflx;
__device__ __forceinline__ float wave_sum(float v, int lane) {
#pragma unroll
    for (int o = 1; o < 64; o <<= 1) v += shflx(v, o, lane);
    return v;
}

template <class T> __device__ __forceinline__ T* launder(T* p) { asm volatile("" : "+s"(p)); return p; }
struct Args { const float* in[20]; float* out; unsigned char* ws; int ph_lo, ph_hi, coop, pad; };
struct Ctx {
    LAS unsigned char* lds; int tid, lane, wave, bid, nblk;
    const float* in[20]; float* out;
    bf16 *Win, *Wout, *Wgu, *Wdn, *xb, *mix, *states, *proj;
    float *ssq, *dtraw, *cdecay;
};

struct P0Item { const float* W; const float* gain; bf16* WT; int nsrc, col, valid, K, drow, k0; };
__device__ __forceinline__ P0Item p0_decode(const Ctx& C, int it) {
    constexpr int I_IN = 16 * 96, I_OUT = 16 * 32, I_GU = 16 * 176, I_DN = 44 * 32, I_L = I_IN + I_OUT + I_GU + I_DN;
    P0Item P; const int l = it / I_L; int r = it % I_L;
    if (r < I_IN) {
        const int kb = r / 96, n0 = 32 * (r % 96);
        int col, valid;
        if (n0 < 2304) { col = n0; valid = 32; } else if (n0 < 2816) { col = n0 + 8; valid = 32; } else if (n0 == 2816) { col = 2304; valid = 8; } else { col = 0; valid = 0; }
        P.W = C.in[2] + (size_t)l * 1024 * 2824; P.nsrc = 2824; P.col = col; P.valid = valid; P.gain = C.in[1] + l * 1024; P.K = 1024; P.WT = C.Win + (size_t)l * 3072 * 1024; P.drow = n0; P.k0 = 64 * kb;
        return P;
    }
    r -= I_IN;
    if (r < I_OUT) { const int kb = r / 32, n0 = 32 * (r % 32);
        P.W = C.in[14] + (size_t)l * 1024 * 1024; P.nsrc = 1024; P.col = n0; P.valid = 32; P.gain = nullptr; P.K = 1024; P.WT = C.Wout + (size_t)l * 1024 * 1024; P.drow = n0; P.k0 = 64 * kb; return P; }
    r -= I_OUT;
    if (r < I_GU) { const int kb = r / 176, n0 = 32 * (r % 176); const int t = n0 >> 8, hs = (n0 >> 7) & 1, i = n0 & 127;
        P.W = (hs ? C.in[17] : C.in[16]) + (size_t)l * 1024 * 2816; P.nsrc = 2816; P.col = 128 * t + i; P.valid = 32; P.gain = C.in[15] + l * 1024; P.K = 1024; P.WT = C.Wgu + (size_t)l * 5632 * 1024; P.drow = n0; P.k0 = 64 * kb; return P; }
    r -= I_GU;
    { const int kb = r / 32, n0 = 32 * (r % 32);
        P.W = C.in[18] + (size_t)l * 2816 * 1024; P.nsrc = 1024; P.col = n0; P.valid = 32; P.gain = nullptr; P.K = 2816; P.WT = C.Wdn + (size_t)l * 1024 * 2816; P.drow = n0; P.k0 = 64 * kb; return P; }
}
__device__ __forceinline__ void p0_load(const P0Item& P, float (&wv)[32], int lane) {
    const int c31 = lane & 31;
#pragma unroll
    for (int i = 0; i < 32; ++i) { const int kk = 2 * i + (lane >> 5); wv[i] = (c31 < P.valid) ? P.W[(size_t)(P.k0 + kk) * P.nsrc + P.col + c31] : 0.f; }
}
__device__ __forceinline__ void p0_finish(const P0Item& P, float (&wv)[32], LAS float* scr, int lane) {
    const int c31 = lane & 31;
    if (P.gain) {
#pragma unroll
        for (int i = 0; i < 32; ++i) wv[i] *= P.gain[P.k0 + 2 * i + (lane >> 5)];
    }
#pragma unroll
    for (int i = 0; i < 32; ++i) scr[(2 * i + (lane >> 5)) * 33 + c31] = wv[i];
    const int c = lane & 7;
#pragma unroll
    for (int j = 0; j < 4; ++j) {
        const int n = (lane >> 3) + 8 * j; const LAS float* s = scr + (8 * c) * 33 + n;
        u32x4 o; o.x = pk2(s[0 * 33], s[1 * 33]); o.y = pk2(s[2 * 33], s[3 * 33]); o.z = pk2(s[4 * 33], s[5 * 33]); o.w = pk2(s[6 * 33], s[7 * 33]);
        *(u32x4*)(P.WT + (size_t)(P.drow + n) * P.K + P.k0 + 8 * c) = o;
    }
}
__device__ __forceinline__ void p0_convert(const Ctx& C, int it_begin, int it_end, int gw, int NGW, LAS float* scr, int lane) {
#pragma unroll 1
    for (int it = it_begin + gw; it < it_end; it += NGW) {
        float wa[32];
        const P0Item pa = p0_decode(C, it);
        p0_load(pa, wa, lane);
        p0_finish(pa, wa, scr, lane);
    }
}
constexpr int P0_FIRST = 16 * 96;
constexpr int P0_SPLIT = (16 * 96 + 16 * 32 + 16 * 176 + 44 * 32) + 16 * 96;
constexpr int P0_ALL = 2 * (16 * 96 + 16 * 32 + 16 * 176 + 44 * 32);
#ifndef M1P
#define M1P 7
#endif
__device__ __forceinline__ void ssd_dt_acs(const Ctx& C, int layer, int ck, LAS float* sDT, LAS float* sACS, LAS float* sW, bool has_w, int lane, int wave) {
    const int h = wave, t0 = ck * 64;
    const float raw = C.dtraw[(size_t)(t0 + lane) * 8 + h] + C.in[6][layer * 8 + h];
    const float dt = fmaxf(raw, 0.f) + log1pf(expf(-fabsf(raw)));
    const float av = -expf(C.in[7][layer * 8 + h]) * dt;
    float cs = av;
#pragma unroll
    for (int o = 1; o < 64; o <<= 1) { const float v = __int_as_float(__builtin_amdgcn_ds_bpermute(((lane - o) & 63) << 2, __float_as_int(cs))); if (lane >= o) cs += v; }
    const float aend = __int_as_float(__builtin_amdgcn_readlane(__float_as_int(cs), 63));
    sDT[h * 64 + lane] = dt; sACS[h * 64 + lane] = cs;
    if (has_w) { sW[h * 64 + lane] = dt * expf(aend - cs); if (lane == 63) C.cdecay[ck * 8 + h] = expf(cs); }
}

__device__ __forceinline__ void mix1_phase(const Ctx& C, int layer) {
    LAS float* sDT = (LAS float*)(C.lds); LAS float* sACS = (LAS float*)(C.lds + 2048); LAS float* sW = (LAS float*)(C.lds + 4096);
    LAS bf16* sT = (LAS bf16*)(C.lds + 8192);
    LAS float* sBias = (LAS float*)(C.lds + 122880);
    for (int i = C.tid; i < 4 * 257; i += 512) sBias[i] = C.in[3][layer * 4 * 257 + i] * LOG2E;
    for (int ck = ((C.nblk & 7) == 0 ? (C.bid & 7) * (C.nblk >> 3) + (C.bid >> 3) : C.bid); ck < NCHUNK; ck += C.nblk) {
        int tid = C.tid; asm volatile("" : "+v"(tid));
        const int lane = tid & 63, wave = __builtin_amdgcn_readfirstlane(tid >> 6), fr = lane & 15, fq = lane >> 4;
        const int cin = ck & 127, t0 = ck * 64; const bool first = (cin == 0);
        const float* cw = launder(C.in[4]) + (size_t)layer * 4 * 1024; const float* cb = launder(C.in[5]) + layer * 1024;
        ssd_dt_acs(C, layer, ck, sDT, sACS, sW, true, lane, wave);
        __syncthreads();
        if (tid < 384) {
            const int ch0 = 2 * tid;
            const f32x2 w0 = *(const f32x2*)(cw + 0 * 1024 + ch0), w1 = *(const f32x2*)(cw + 1 * 1024 + ch0), w2 = *(const f32x2*)(cw + 2 * 1024 + ch0), w3 = *(const f32x2*)(cw + 3 * 1024 + ch0);
            const f32x2 bb = *(const f32x2*)(cb + ch0);
            const unsigned* src = (const unsigned*)(C.proj + (size_t)t0 * NPROJ + PJ_XBC + ch0);
            f32x2 xm3 = {0.f, 0.f}, xm2 = {0.f, 0.f}, xm1 = {0.f, 0.f};
            if (!first) { const unsigned a = src[-3 * (NPROJ / 2)], b = src[-2 * (NPROJ / 2)], c = src[-1 * (NPROJ / 2)];
                xm3 = (f32x2){bflo(a), bfhi(a)}; xm2 = (f32x2){bflo(b), bfhi(b)}; xm1 = (f32x2){bflo(c), bfhi(c)}; }
            const int hh = ch0 >> 6; const bool isx = ch0 < 512;
#pragma unroll 1
            for (int l0 = 0; l0 < 64; l0 += 16) {
            unsigned uu[16];
#pragma unroll
            for (int i = 0; i < 16; ++i) uu[i] = src[(l0 + i) * (NPROJ / 2)];
#pragma unroll
            for (int li = 0; li < 16; li += 2) {
                const int l = l0 + li;
                const unsigned ua = uu[li], ub = uu[li + 1];
                const f32x2 xa = {bflo(ua), bfhi(ua)}, xc = {bflo(ub), bfhi(ub)};
                f32x2 ya = bb + w0 * xm3 + w1 * xm2 + w2 * xm1 + w3 * xa;
                f32x2 yb = bb + w0 * xm2 + w1 * xm1 + w2 * xa + w3 * xc;
                xm3 = xm1; xm2 = xa; xm1 = xc;
                ya.x = fsilu(ya.x); ya.y = fsilu(ya.y); yb.x = fsilu(yb.x); yb.y = fsilu(yb.y);
                if (isx) { const float wa = sW[hh * 64 + l], wb = sW[hh * 64 + l + 1]; ya = ya * wa; yb = yb * wb; }
                *(LAS unsigned*)(sT + ch0 * 72 + l) = pk2(ya.x, yb.x);
                *(LAS unsigned*)(sT + (ch0 + 1) * 72 + l) = pk2(ya.y, yb.y);
            }
            }
        }
        __syncthreads();
        if (M1P & 1) {
            const int h = wave, g = h >> 2;
            bf16x8 xf[4][2];
#pragma unroll
            for (int pt = 0; pt < 4; ++pt)
#pragma unroll
                for (int ks = 0; ks < 2; ++ks) xf[pt][ks] = *(const LAS bf16x8*)(sT + (h * 64 + 16 * pt + fr) * 72 + 32 * ks + 8 * fq);
            bf16* st = C.states + (size_t)(ck * 8 + h) * 64 * 128;
#pragma unroll 1
            for (int nt = 0; nt < 8; ++nt) {
                bf16x8 bfr[2];
#pragma unroll
                for (int ks = 0; ks < 2; ++ks) bfr[ks] = *(const LAS bf16x8*)(sT + (512 + g * 128 + 16 * nt + fr) * 72 + 32 * ks + 8 * fq);
#pragma unroll
                for (int pt = 0; pt < 4; ++pt) {
                    f32x4 acc = {0.f, 0.f, 0.f, 0.f};
#pragma unroll
                    for (int ks = 0; ks < 2; ++ks) acc = mfma16(bfr[ks], xf[pt][ks], acc);
                    u32x2 w; w.x = pk2(acc[0], acc[1]); w.y = pk2(acc[2], acc[3]);
                    *(u32x2*)(st + (16 * pt + fr) * 128 + 16 * nt + 4 * fq) = w;
                }
            }
        }
        __syncthreads();
        if (M1P & 2) {
            LAS bf16* G = (LAS bf16*)(C.lds + 8192);
            LAS float* CO = (LAS float*)(C.lds + 8192 + 48128);
            const int c = tid & 255, half = tid >> 8;
#pragma unroll
            for (int it = 0; it < 6; ++it) {
                const int u = tid + 512 * it, r = u >> 5, c8 = u & 31;
                if (u < 94 * 32) {
                    u32x4 o = {0u, 0u, 0u, 0u};
                    if (!(first && r < 30)) {
                        const bf16* p = C.proj + (size_t)(t0 - 30 + r) * NPROJ + PJ_GLU + 8 * c8;
                        const u32x4 av = *(const u32x4*)p, gv = *(const u32x4*)(p + 256);
#pragma unroll
                        for (int e = 0; e < 4; ++e) o[e] = pk2(bflo(av[e]) * fsigmoid(bflo(gv[e])), bfhi(av[e]) * fsigmoid(bfhi(gv[e])));
                    }
                    *(LAS u32x4*)(G + r * 256 + 8 * c8) = o;
                }
            }
            __syncthreads();
            {
                const float* dww = launder(C.in[10]) + (size_t)layer * 31 * 256 + c;
                float w[31];
#pragma unroll
                for (int k = 0; k < 31; ++k) w[k] = dww[k * 256];
                const float bias = launder(C.in[11])[layer * 256 + c];
#pragma unroll 1
                for (int grp = 0; grp < 4; ++grp) {
                    float o[8];
#pragma unroll
                    for (int i = 0; i < 8; ++i) o[i] = bias;
                    const LAS bf16* gp = G + (half * 32 + grp * 8) * 256 + c;
#pragma unroll
                    for (int r = 0; r < 38; ++r) {
                        const float v = bf2f(gp[r * 256]);
#pragma unroll
                        for (int i = 0; i < 8; ++i) { const int k = r - i; if (k >= 0 && k <= 30) o[i] += w[k] * v; }
                    }
#pragma unroll
                    for (int i = 0; i < 8; ++i) CO[(half * 32 + grp * 8 + i) * 256 + c] = o[i];
                }
            }
            __syncthreads();
            {
                const f32x4 lg = *((const f32x4*)(launder(C.in[12]) + layer * 256) + lane), lb = *((const f32x4*)(launder(C.in[13]) + layer * 256) + lane);
#pragma unroll 2
                for (int i = 0; i < 8; ++i) {
                    const int l = wave * 8 + i;
                    const f32x4 v = *((const LAS f32x4*)(CO + l * 256) + lane);
                    const float s = wave_sum((v[0] + v[1]) + (v[2] + v[3]), lane);
                    const float mu = s * (1.f / 256.f);
                    const f32x4 d = v - mu;
                    const float s2 = wave_sum((d[0] * d[0] + d[1] * d[1]) + (d[2] * d[2] + d[3] * d[3]), lane);
                    const float rstd = 1.0f / sqrtf(s2 * (1.f / 256.f) + 1e-6f);
                    const f32x4 y = d * rstd * lg + lb;
                    u32x2 w; w.x = pk2(fsilu(y[0]), fsilu(y[1])); w.y = pk2(fsilu(y[2]), fsilu(y[3]));
                    *((u32x2*)(C.mix + (size_t)(t0 + l) * DM + MX_C) + lane) = w;
                }
            }
        }
        __syncthreads();
        if (M1P & 4) {
            LAS bf16* sK = (LAS bf16*)(C.lds + 8192);
            LAS bf16* sV = (LAS bf16*)(C.lds + 8192 + 33792);
            const int h = wave >> 1, qh = wave & 1, q4 = (lane & 15) >> 2, p4 = lane & 3;
            bf16x8 qf[2][2];
#pragma unroll
            for (int qt = 0; qt < 2; ++qt)
#pragma unroll
                for (int ks = 0; ks < 2; ++ks) qf[qt][ks] = *(const bf16x8*)(C.proj + (size_t)(t0 + 32 * qh + 16 * qt + fr) * NPROJ + PJ_Q + h * 64 + 32 * ks + 8 * fq);
            float mrun[2] = {-1e30f, -1e30f}, lsum[2] = {0.f, 0.f};
            f32x4 oacc[4][2];
#pragma unroll
            for (int dt = 0; dt < 4; ++dt)
#pragma unroll
                for (int qt = 0; qt < 2; ++qt) oacc[dt][qt] = (f32x4){0.f, 0.f, 0.f, 0.f};
            const int jmin = cin >= 8 ? 0 : 8 - cin;
            u32x4 kreg[4], vreg[4];
#define ATT_LOAD(jj) do { const bf16* base_ = C.proj + (size_t)(t0 + ((jj) - 8) * 64) * NPROJ; _Pragma("unroll") for (int i = 0; i < 4; ++i) { const int u = tid + 512 * i, row = u >> 5, c8 = u & 31; \
                kreg[i] = *(const u32x4*)(base_ + (size_t)row * NPROJ + PJ_K + 8 * c8); vreg[i] = *(const u32x4*)(base_ + (size_t)row * NPROJ + PJ_V + 8 * c8); } } while (0)
            ATT_LOAD(jmin);
            for (int j = jmin; j <= 8; ++j) {
#pragma unroll
                for (int i = 0; i < 4; ++i) { const int u = tid + 512 * i, row = u >> 5, c8 = u & 31;
                    *(LAS u32x4*)(sK + row * 264 + 8 * c8) = kreg[i]; *(LAS u32x4*)(sV + row * 264 + 8 * c8) = vreg[i]; }
                __syncthreads();
                if (j < 8) ATT_LOAD(j + 1);
                f32x4 st[4][2];
#pragma unroll
                for (int kt = 0; kt < 4; ++kt) {
                    bf16x8 kf[2];
#pragma unroll
                    for (int ks = 0; ks < 2; ++ks) kf[ks] = *(const LAS bf16x8*)(sK + (16 * kt + fr) * 264 + h * 64 + 32 * ks + 8 * fq);
#pragma unroll
                    for (int qt = 0; qt < 2; ++qt) { f32x4 acc = {0.f, 0.f, 0.f, 0.f};
#pragma unroll
                        for (int ks = 0; ks < 2; ++ks) acc = mfma16(kf[ks], qf[qt][ks], acc);
                        st[kt][qt] = acc; }
                }
                if (j >= 6) {
#pragma unroll
                    for (int kt = 0; kt < 4; ++kt)
#pragma unroll
                        for (int qt = 0; qt < 2; ++qt)
#pragma unroll
                            for (int e = 0; e < 4; ++e) {
                                const int rel = (32 * qh + 16 * qt + fr) + 512 - 64 * j - (16 * kt + 4 * fq + e);
                                const int idx = (rel < -128 ? -128 : (rel > 128 ? 128 : rel)) + 128;
                                st[kt][qt][e] += sBias[h * 257 + idx];
                            }
                } else {
                    const float bc = sBias[h * 257 + 256];
#pragma unroll
                    for (int kt = 0; kt < 4; ++kt)
#pragma unroll
                        for (int qt = 0; qt < 2; ++qt) st[kt][qt] = st[kt][qt] + bc;
                }
#pragma unroll
                for (int qt = 0; qt < 2; ++qt) {
                    float mx = -1e30f;
#pragma unroll
                    for (int kt = 0; kt < 4; ++kt)
#pragma unroll
                        for (int e = 0; e < 4; ++e) mx = fmaxf(mx, st[kt][qt][e]);
                    mx = fmaxf(mx, shflx(mx, 16, lane)); mx = fmaxf(mx, shflx(mx, 32, lane));
                    const float mnew = fmaxf(mrun[qt], mx), alpha = __builtin_amdgcn_exp2f(mrun[qt] - mnew);
                    mrun[qt] = mnew;
                    float ps = 0.f;
#pragma unroll
                    for (int kt = 0; kt < 4; ++kt)
#pragma unroll
                        for (int e = 0; e < 4; ++e) { const float p = __builtin_amdgcn_exp2f(st[kt][qt][e] - mnew); st[kt][qt][e] = p; ps += p; }
                    lsum[qt] = lsum[qt] * alpha + ps;
#pragma unroll
                    for (int dt = 0; dt < 4; ++dt) oacc[dt][qt] = oacc[dt][qt] * alpha;
                }
                bf16x8 pf[2][2];
#pragma unroll
                for (int s2 = 0; s2 < 2; ++s2)
#pragma unroll
                    for (int qt = 0; qt < 2; ++qt) {
                        u32x4 w; w.x = pk2(st[2 * s2][qt][0], st[2 * s2][qt][1]); w.y = pk2(st[2 * s2][qt][2], st[2 * s2][qt][3]);
                        w.z = pk2(st[2 * s2 + 1][qt][0], st[2 * s2 + 1][qt][1]); w.w = pk2(st[2 * s2 + 1][qt][2], st[2 * s2 + 1][qt][3]);
                        pf[s2][qt] = __builtin_bit_cast(bf16x8, w);
                    }
#pragma unroll
                for (int dt = 0; dt < 4; ++dt)
#pragma unroll
                    for (int s2 = 0; s2 < 2; ++s2) {
                        const s16x4 lo = __builtin_amdgcn_ds_read_tr16_b64_v4i16((LAS s16x4*)(sV + (32 * s2 + 4 * fq + q4) * 264 + h * 64 + 16 * dt + 4 * p4));
                        const s16x4 hi = __builtin_amdgcn_ds_read_tr16_b64_v4i16((LAS s16x4*)(sV + (32 * s2 + 16 + 4 * fq + q4) * 264 + h * 64 + 16 * dt + 4 * p4));
                        const bf16x8 vf = __builtin_shufflevector(lo, hi, 0, 1, 2, 3, 4, 5, 6, 7);
#pragma unroll
                        for (int qt = 0; qt < 2; ++qt) oacc[dt][qt] = mfma16(vf, pf[s2][qt], oacc[dt][qt]);
                    }
                __syncthreads();
            }
#undef ATT_LOAD
#pragma unroll
            for (int qt = 0; qt < 2; ++qt) {
                float l = lsum[qt]; l += shflx(l, 16, lane); l += shflx(l, 32, lane);
                const float inv = 1.0f / l;
                bf16* op = C.mix + (size_t)(t0 + 32 * qh + 16 * qt + fr) * DM + MX_A + h * 64 + 4 * fq;
#pragma unroll
                for (int dt = 0; dt < 4; ++dt) { u32x2 w; w.x = pk2(oacc[dt][qt][0] * inv, oacc[dt][qt][1] * inv); w.y = pk2(oacc[dt][qt][2] * inv, oacc[dt][qt][3] * inv);
                    *(u32x2*)(op + 16 * dt) = w; }
            }
        }
        __syncthreads();
    }
}

__device__ __forceinline__ void aux_phase(const Ctx& C, int mode, int layer) {
    int cb = 0, ce = 0, gw = 0, ngw = 1;
    if (mode == 0) {
        const int NGW = C.nblk * 8; gw = C.bid * 8 + C.wave; const int lane = C.lane;
        const float* x = C.in[0];
    for (int row0 = gw * 2; row0 < M; row0 += NGW * 2) {
        f32x4 v[2][4];
#pragma unroll
        for (int r = 0; r < 2; ++r)
#pragma unroll
            for (int j = 0; j < 4; ++j) v[r][j] = *((const f32x4*)(x + (size_t)(row0 + r) * DM) + lane + 64 * j);
#pragma unroll
        for (int r = 0; r < 2; ++r) {
            float s = 0.f;
#pragma unroll
            for (int j = 0; j < 4; ++j) s += (v[r][j][0] * v[r][j][0] + v[r][j][1] * v[r][j][1]) + (v[r][j][2] * v[r][j][2] + v[r][j][3] * v[r][j][3]);
            s = wave_sum(s, lane);
            u32x2* o = (u32x2*)(C.xb + (size_t)(row0 + r) * DM) + lane;
#pragma unroll
            for (int j = 0; j < 4; ++j) { u32x2 w; w.x = pk2(v[r][j][0], v[r][j][1]); w.y = pk2(v[r][j][2], v[r][j][3]); o[64 * j] = w; }
            if (lane < 16) C.ssq[(size_t)(row0 + r) * 16 + lane] = (lane == 0) ? s : 0.f;
        }
    }

        cb = 0; ce = P0_FIRST; ngw = NGW;
    } else if (C.tid < 256) {
        for (int gt = C.bid * 256 + C.tid; gt < 65536; gt += C.nblk * 256) {
            const int b = gt >> 15, e2 = gt & 32767, h = __builtin_amdgcn_readfirstlane(e2 >> 12);
            const unsigned* p = (const unsigned*)C.states + (size_t)b * 128 * 32768 + e2;
            unsigned* q = (unsigned*)C.states + (size_t)b * 128 * 32768 + e2;
            const float* cd = C.cdecay + __builtin_amdgcn_readfirstlane(b) * 128 * 8 + h;
            float s0 = 0.f, s1 = 0.f;
#pragma unroll 1
            for (int c0 = 0; c0 < 128; c0 += 16) {
                unsigned u[16];
#pragma unroll
                for (int i = 0; i < 16; ++i) u[i] = p[(size_t)(c0 + i) * 32768];
#pragma unroll
                for (int i = 0; i < 16; ++i) { const float d = cd[(c0 + i) * 8]; q[(size_t)(c0 + i) * 32768] = pk2(s0, s1); s0 = s0 * d + bflo(u[i]); s1 = s1 * d + bfhi(u[i]); }
            }
        }
    } else { cb = layer == 0 ? P0_FIRST : P0_SPLIT; ce = layer == 0 ? P0_SPLIT : P0_ALL; gw = C.bid * 4 + (C.wave - 4); ngw = C.nblk * 4; }
    if (ce > cb) p0_convert(C, cb, ce, gw, ngw, (LAS float*)(C.lds + C.wave * 8448), C.lane);
}

__device__ __forceinline__ void mix3_phase(const Ctx& C, int layer) {
    LAS float* sDT = (LAS float*)(C.lds); LAS float* sACS = (LAS float*)(C.lds + 2048); LAS float* sPART = (LAS float*)(C.lds + 4096);
    LAS bf16* sC = (LAS bf16*)(C.lds + 8192);
    LAS bf16* sB = (LAS bf16*)(C.lds + 41984);
    LAS float* sCB = (LAS float*)(C.lds + 41984);
    LAS bf16* sXT = (LAS bf16*)(C.lds + 75776);
    for (int ck = ((C.nblk & 7) == 0 ? (C.bid & 7) * (C.nblk >> 3) + (C.bid >> 3) : C.bid); ck < NCHUNK; ck += C.nblk) {
        int tid = C.tid; asm volatile("" : "+v"(tid));
        const int lane = tid & 63, wave = __builtin_amdgcn_readfirstlane(tid >> 6), fr = lane & 15, fq = lane >> 4;
        const int cin = ck & 127, t0 = ck * 64; const bool first = (cin == 0);
        const float* cw = launder(C.in[4]) + (size_t)layer * 4 * 1024; const float* cb = launder(C.in[5]) + layer * 1024;
        ssd_dt_acs(C, layer, ck, sDT, sACS, sPART, false, lane, wave);
        {
            const int ch0 = 2 * tid;
            const f32x2 w0 = *(const f32x2*)(cw + 0 * 1024 + ch0), w1 = *(const f32x2*)(cw + 1 * 1024 + ch0), w2 = *(const f32x2*)(cw + 2 * 1024 + ch0), w3 = *(const f32x2*)(cw + 3 * 1024 + ch0);
            const f32x2 bb = *(const f32x2*)(cb + ch0);
            const unsigned* src = (const unsigned*)(C.proj + (size_t)t0 * NPROJ + PJ_XBC + ch0);
            f32x2 xm3 = {0.f, 0.f}, xm2 = {0.f, 0.f}, xm1 = {0.f, 0.f};
            if (!first) { const unsigned a = src[-3 * (NPROJ / 2)], b = src[-2 * (NPROJ / 2)], c = src[-1 * (NPROJ / 2)];
                xm3 = (f32x2){bflo(a), bfhi(a)}; xm2 = (f32x2){bflo(b), bfhi(b)}; xm1 = (f32x2){bflo(c), bfhi(c)}; }
            LAS bf16* nat = (ch0 < 768) ? (sB + (ch0 - 512)) : (sC + (ch0 - 768));
#pragma unroll 1
            for (int l0 = 0; l0 < 64; l0 += 16) {
            unsigned uu[16];
#pragma unroll
            for (int i = 0; i < 16; ++i) uu[i] = src[(l0 + i) * (NPROJ / 2)];
#pragma unroll
            for (int li = 0; li < 16; li += 2) {
                const int l = l0 + li;
                const unsigned ua = uu[li], ub = uu[li + 1];
                const f32x2 xa = {bflo(ua), bfhi(ua)}, xc = {bflo(ub), bfhi(ub)};
                f32x2 ya = bb + w0 * xm3 + w1 * xm2 + w2 * xm1 + w3 * xa;
                f32x2 yb = bb + w0 * xm2 + w1 * xm1 + w2 * xa + w3 * xc;
                xm3 = xm1; xm2 = xa; xm1 = xc;
                ya.x = fsilu(ya.x); ya.y = fsilu(ya.y); yb.x = fsilu(yb.x); yb.y = fsilu(yb.y);
                if (ch0 < 512) {
                    *(LAS unsigned*)(sXT + ch0 * 72 + l) = pk2(ya.x, yb.x);
                    *(LAS unsigned*)(sXT + (ch0 + 1) * 72 + l) = pk2(ya.y, yb.y);
                } else {
                    *(LAS unsigned*)(nat + l * 264) = pk2(ya.x, ya.y);
                    *(LAS unsigned*)(nat + (l + 1) * 264) = pk2(yb.x, yb.y);
                }
            }
            }
        }
        __syncthreads();
        {
            const int g = wave >> 2, lt = wave & 3;
            f32x4 acc[4];
#pragma unroll
            for (int st = 0; st < 4; ++st) acc[st] = (f32x4){0.f, 0.f, 0.f, 0.f};
#pragma unroll
            for (int ks = 0; ks < 4; ++ks) {
                const bf16x8 af = *(const LAS bf16x8*)(sC + (16 * lt + fr) * 264 + g * 128 + 32 * ks + 8 * fq);
#pragma unroll
                for (int st = 0; st < 4; ++st) { const bf16x8 bfr = *(const LAS bf16x8*)(sB + (16 * st + fr) * 264 + g * 128 + 32 * ks + 8 * fq); acc[st] = mfma16(af, bfr, acc[st]); }
            }
            __syncthreads();
#pragma unroll
            for (int st = 0; st < 4; ++st)
#pragma unroll
                for (int e = 0; e < 4; ++e) sCB[(g * 64 + 16 * lt + 4 * fq + e) * 66 + 16 * st + fr] = acc[st][e];
        }
        __syncthreads();
        {
            const int h = wave, g = h >> 2;
            f32x4 acc[4][4];
#pragma unroll
            for (int lt = 0; lt < 4; ++lt)
#pragma unroll
                for (int pt = 0; pt < 4; ++pt) acc[lt][pt] = (f32x4){0.f, 0.f, 0.f, 0.f};
            const bf16* prev = C.states + (size_t)(ck * 8 + h) * 64 * 128;
#pragma unroll
            for (int ks = 0; ks < 4; ++ks) {
                bf16x8 cf[4];
#pragma unroll
                for (int lt = 0; lt < 4; ++lt) cf[lt] = *(const LAS bf16x8*)(sC + (16 * lt + fr) * 264 + g * 128 + 32 * ks + 8 * fq);
#pragma unroll
                for (int pt = 0; pt < 4; ++pt) {
                    const bf16x8 pfr = *(const bf16x8*)(prev + (16 * pt + fr) * 128 + 32 * ks + 8 * fq);
#pragma unroll
                    for (int lt = 0; lt < 4; ++lt) acc[lt][pt] = mfma16(pfr, cf[lt], acc[lt][pt]);
                }
                __builtin_amdgcn_sched_barrier(0);
            }
#pragma unroll
            for (int lt = 0; lt < 4; ++lt) {
                const float ea = fexp(sACS[h * 64 + 16 * lt + fr]);
#pragma unroll
                for (int pt = 0; pt < 4; ++pt) acc[lt][pt] = acc[lt][pt] * ea;
            }
#pragma unroll
            for (int ks2 = 0; ks2 < 2; ++ks2) {
                bf16x8 xf[4];
#pragma unroll
                for (int pt = 0; pt < 4; ++pt) xf[pt] = *(const LAS bf16x8*)(sXT + (h * 64 + 16 * pt + fr) * 72 + 32 * ks2 + 8 * fq);
                const f32x4 as0 = *(const LAS f32x4*)(sACS + h * 64 + 32 * ks2 + 8 * fq), as1 = *(const LAS f32x4*)(sACS + h * 64 + 32 * ks2 + 8 * fq + 4);
                const f32x4 dt0 = *(const LAS f32x4*)(sDT + h * 64 + 32 * ks2 + 8 * fq), dt1 = *(const LAS f32x4*)(sDT + h * 64 + 32 * ks2 + 8 * fq + 4);
#pragma unroll
                for (int lt = 0; lt < 4; ++lt) {
                    if (ks2 == 1 && lt < 2) continue;
                    const int l = 16 * lt + fr; const float al = sACS[h * 64 + l];
                    const LAS f32x2* cbp = (const LAS f32x2*)(sCB + (g * 64 + l) * 66 + 32 * ks2 + 8 * fq);
                    const f32x2 c01 = cbp[0], c23 = cbp[1], c45 = cbp[2], c67 = cbp[3];
                    const float cbv[8] = {c01.x, c01.y, c23.x, c23.y, c45.x, c45.y, c67.x, c67.y};
                    const float asv[8] = {as0[0], as0[1], as0[2], as0[3], as1[0], as1[1], as1[2], as1[3]};
                    const float dtv[8] = {dt0[0], dt0[1], dt0[2], dt0[3], dt1[0], dt1[1], dt1[2], dt1[3]};
                    float v[8];
#pragma unroll
                    for (int jj = 0; jj < 8; ++jj) { const int sidx = 32 * ks2 + 8 * fq + jj; const float t = cbv[jj] * fexp(al - asv[jj]) * dtv[jj]; v[jj] = (sidx <= l) ? t : 0.f; }
                    u32x4 w; w.x = pk2(v[0], v[1]); w.y = pk2(v[2], v[3]); w.z = pk2(v[4], v[5]); w.w = pk2(v[6], v[7]);
                    const bf16x8 af = __builtin_bit_cast(bf16x8, w);
#pragma unroll
                    for (int pt = 0; pt < 4; ++pt) acc[lt][pt] = mfma16(xf[pt], af, acc[lt][pt]);
                }
            }
            const float Dh = launder(C.in[8])[layer * 8 + h];
#pragma unroll
            for (int lt = 0; lt < 4; ++lt) {
                const int l = 16 * lt + fr; float q = 0.f;
#pragma unroll
                for (int pt = 0; pt < 4; ++pt) {
                    const int p0 = 16 * pt + 4 * fq;
                    const u32x2 zz = *(const u32x2*)(C.proj + (size_t)(t0 + l) * NPROJ + PJ_Z + h * 64 + p0);
                    const float zv[4] = {bflo(zz.x), bfhi(zz.x), bflo(zz.y), bfhi(zz.y)};
#pragma unroll
                    for (int e = 0; e < 4; ++e) {
                        const float xv = bf2f(sXT[(h * 64 + p0 + e) * 72 + l]);
                        const float y = (acc[lt][pt][e] + xv * Dh) * fsilu(zv[e]);
                        acc[lt][pt][e] = y; q += y * y;
                    }
                }
                q += shflx(q, 16, lane); q += shflx(q, 32, lane);
                if (fq == 0) sPART[h * 64 + l] = q;
            }
            __syncthreads();
            const float* ng = launder(C.in[9]) + layer * 512 + h * 64;
#pragma unroll
            for (int lt = 0; lt < 4; ++lt) {
                const int l = 16 * lt + fr;
                const float tot = (sPART[(4 * g) * 64 + l] + sPART[(4 * g + 1) * 64 + l]) + (sPART[(4 * g + 2) * 64 + l] + sPART[(4 * g + 3) * 64 + l]);
                const float rs = 1.0f / sqrtf(tot * (1.f / 256.f) + 1e-6f);
#pragma unroll
                for (int pt = 0; pt < 4; ++pt) {
                    const int p0 = 16 * pt + 4 * fq;
                    const f32x4 gg = *(const f32x4*)(ng + p0);
                    u32x2 w; w.x = pk2(acc[lt][pt][0] * rs * gg[0], acc[lt][pt][1] * rs * gg[1]); w.y = pk2(acc[lt][pt][2] * rs * gg[2], acc[lt][pt][3] * rs * gg[3]);
                    *(u32x2*)(C.mix + (size_t)(t0 + l) * DM + MX_B + h * 64 + p0) = w;
                }
            }
        }
        __syncthreads();
    }
}

__device__ __forceinline__ void final_phase(const Ctx& C) {
    const int gw = C.bid * 8 + C.wave, NGW = C.nblk * 8, lane = C.lane;
    f32x4 gg[2][2];
#pragma unroll
    for (int j = 0; j < 2; ++j) { gg[j][0] = *(const f32x4*)(C.in[19] + 512 * j + 8 * lane); gg[j][1] = *(const f32x4*)(C.in[19] + 512 * j + 8 * lane + 4); }
    for (int row0 = gw * 2; row0 < M; row0 += NGW * 2) {
        u32x4 v[2][2]; float rs[2];
#pragma unroll
        for (int r = 0; r < 2; ++r) {
            rs[r] = pg8::rstd_of(C.ssq, row0 + r);
#pragma unroll
            for (int j = 0; j < 2; ++j) v[r][j] = *(const u32x4*)(C.xb + (size_t)(row0 + r) * DM + 512 * j + 8 * lane);
        }
#pragma unroll
        for (int r = 0; r < 2; ++r)
#pragma unroll
            for (int j = 0; j < 2; ++j) {
                const u32x4 w = v[r][j];
                const f32x4 a = {bflo(w.x), bfhi(w.x), bflo(w.y), bfhi(w.y)}, b = {bflo(w.z), bfhi(w.z), bflo(w.w), bfhi(w.w)};
                float* o = C.out + (size_t)(row0 + r) * DM + 512 * j + 8 * lane;
                *(f32x4*)o = a * rs[r] * gg[j][0]; *(f32x4*)(o + 4) = b * rs[r] * gg[j][1];
            }
    }
}

#define XB_TMO      128
#define XB_XCNT(j)  (256  + 64 * (j))
#define XB_XSUB(j)  (1280 + 64 * (j))
#define XB_XGEN(j)  (2304 + 64 * (j))
#define XB_TOP      3328
#define XB_TOPGEN   3392
#define XCD_BAR_WORDS 3456
#define XB_SPIN_CAP (1u << 18)

__device__ __forceinline__ unsigned xb_ld(unsigned* p)              { return __hip_atomic_load(p, __ATOMIC_RELAXED, __HIP_MEMORY_SCOPE_AGENT); }
__device__ __forceinline__ unsigned xb_add(unsigned* p, unsigned v) { return __hip_atomic_fetch_add(p, v, __ATOMIC_RELAXED, __HIP_MEMORY_SCOPE_AGENT); }
__device__ __forceinline__ unsigned xb_xcc_id() { return (unsigned)__builtin_amdgcn_s_getreg((3 << 11) | 20) & 0xFu; }
#define XB_SPIN(cond, bar) do { unsigned _sp = 0; while (cond) { __builtin_amdgcn_s_sleep(1); \
    if ((++_sp & 255u) == 0u) { if (xb_ld(&(bar)[XB_TMO])) break; if (_sp > XB_SPIN_CAP) { atomicAdd(&(bar)[XB_TMO], 1u); break; } } } } while (0)

struct XcdBarrier {
    unsigned* bar; unsigned x;
    volatile LAS unsigned* st;
};

__device__ __forceinline__ XcdBarrier xcd_barrier_post(unsigned* bar, volatile LAS unsigned* st) {
    XcdBarrier b; b.bar = bar; b.x = xb_xcc_id(); b.st = st;
    if (threadIdx.x == 0) (void)xb_add(&bar[XB_XCNT(b.x)], 1u);
    return b;
}
__device__ __forceinline__ void xcd_barrier_complete(unsigned* bar, unsigned x, unsigned& nloc, unsigned& nx) {
    const unsigned G = gridDim.x * gridDim.y * gridDim.z;
    unsigned sum, cnt, mine, sp = 0u;
    for (;;) {
        sum = 0u; cnt = 0u; mine = 0u;
#pragma unroll
        for (unsigned j = 0; j < 16; ++j) { const unsigned c = xb_ld(&bar[XB_XCNT(j)]); sum += c; cnt += (c > 0u) ? 1u : 0u; mine = (j == x) ? c : mine; }
        if (sum == G) break;
        __builtin_amdgcn_s_sleep(1);
        if ((++sp & 255u) == 0u) { if (xb_ld(&bar[XB_TMO])) break; if (sp > XB_SPIN_CAP) { atomicAdd(&bar[XB_TMO], 1u); break; } }
    }
    nloc = mine > 0u ? mine : 1u; nx = cnt > 0u ? cnt : 1u;
}

__device__ __forceinline__ void xcd_barrier(const XcdBarrier& b) {
    asm volatile("s_waitcnt vmcnt(0)" ::: "memory");
    __syncthreads();
    if (threadIdx.x == 0) {
        unsigned* bar = b.bar;
        __builtin_amdgcn_s_waitcnt(0);
        unsigned nloc = b.st[0], nx = b.st[1];
        if (nloc == 0u) { xcd_barrier_complete(bar, b.x, nloc, nx); b.st[0] = nloc; b.st[1] = nx; }
        const unsigned old = xb_add(&bar[XB_XSUB(b.x)], 1u);
        const unsigned gen = old / nloc;
        if (old + 1u == (gen + 1u) * nloc) {
            __builtin_amdgcn_fence(__ATOMIC_RELEASE, "agent");
            asm volatile("s_waitcnt vmcnt(0)" ::: "memory");
            const unsigned og = xb_add(&bar[XB_TOP], 1u);
            const unsigned tg = og / nx;
            if (og + 1u == (tg + 1u) * nx) xb_add(&bar[XB_TOPGEN], 1u);
            else XB_SPIN(xb_ld(&bar[XB_TOPGEN]) == tg, bar);
            __builtin_amdgcn_fence(__ATOMIC_ACQUIRE, "agent");
            xb_add(&bar[XB_XGEN(b.x)], 1u);
            asm volatile("s_waitcnt vmcnt(0)" ::: "memory");
        } else {
            XB_SPIN(xb_ld(&bar[XB_XGEN(b.x)]) == gen, bar);
            __builtin_amdgcn_fence(__ATOMIC_ACQUIRE, "agent");
            asm volatile("s_waitcnt vmcnt(0)" ::: "memory");
        }
    }
    __syncthreads();
}

#ifndef PHMASK
#define PHMASK 0x1ff
#endif
#define PHEN(x) (((PHMASK) >> (x)) & 1)
#define CAS __attribute__((address_space(4)))
__device__ __forceinline__ Ctx make_ctx(const CAS Args* ap, LAS unsigned char* lds, int tidv, int bid, int nblk) {
    Ctx C; C.bid = bid; C.nblk = nblk;
    C.lds = lds; C.tid = tidv; C.lane = tidv & 63; C.wave = __builtin_amdgcn_readfirstlane(tidv >> 6);
#pragma unroll
    for (int i = 0; i < 20; ++i) C.in[i] = ap->in[i];
    C.out = ap->out;
    unsigned char* ws = ap->ws;
    C.Win = (bf16*)(ws + WS_WIN); C.Wout = (bf16*)(ws + WS_WOUT); C.Wgu = (bf16*)(ws + WS_WGU); C.Wdn = (bf16*)(ws + WS_WDN);
    C.xb = (bf16*)(ws + WS_XB); C.mix = (bf16*)(ws + WS_MIX); C.states = (bf16*)(ws + WS_ST); C.proj = (bf16*)(ws + WS_PROJ);
    C.ssq = (float*)(ws + WS_SSQ); C.dtraw = (float*)(ws + WS_DT); C.cdecay = (float*)(ws + WS_CD);
    return C;
}
__global__ void __launch_bounds__(512, 2) fwd_kernel(Args a_unused) {
    extern __shared__ __attribute__((aligned(16))) unsigned char lds_raw[];
    cg::grid_group grid = cg::this_grid();
    LAS unsigned char* lds = (LAS unsigned char*)lds_raw;
    const CAS Args* ap0 = (const CAS Args*)__builtin_amdgcn_kernarg_segment_ptr();
    const int ph_lo = ap0->ph_lo, ph_hi = ap0->ph_hi, coop = ap0->coop;
    volatile LAS unsigned* MISC = (volatile LAS unsigned*)(lds + LDS_BYTES - 64);
    if (threadIdx.x < 16) MISC[threadIdx.x] = 0u;
    __syncthreads();
    unsigned* barw = (unsigned*)(ap0->ws);
    XcdBarrier bar; bar.bar = barw; bar.x = 0; bar.st = MISC;
    if (coop) bar = xcd_barrier_post(barw, MISC);
    for (int ph = ph_lo; ph < ph_hi; ++ph) {
        const CAS Args* ap = ap0; asm volatile("" : "+s"(ap));
        int tidv = threadIdx.x; asm volatile("" : "+v"(tidv));
        int bid = blockIdx.x, nblk = gridDim.x; asm volatile("" : "+s"(bid), "+s"(nblk));
        if (ph == NPHASES - 1) { if (PHEN(8)) { const Ctx C = make_ctx(ap, lds, tidv, bid, nblk); final_phase(C); } }
        else {
            const int l = (ph == 0) ? 0 : (ph - 1) / 7, t = (ph == 0) ? 2 : (ph - 1) % 7;
            if (t == 0 || t >= 4) { if (PHEN(1)) {
                const Ctx C = make_ctx(ap, lds, tidv, bid, nblk);
                pg8::Gemm g; int N;
                pg8::EpiAny E; E.e0 = pg8::EpiInProj{C.proj, C.dtraw, (const LAS float*)(lds + 131072)}; E.e1 = pg8::EpiResid{(l == 0 && t == 4) ? C.in[0] : (const float*)nullptr, C.xb, C.ssq}; E.e2 = pg8::EpiGateUp{C.proj, (const LAS float*)(lds + 131072)};
                if (t == 0)      { g = pg8::Gemm{C.xb, C.Win + (size_t)l * 3072 * 1024, M, 3072, 1024}; N = 3072; E.mode = 0; }
                else if (t == 4) { g = pg8::Gemm{C.mix, C.Wout + (size_t)l * 1024 * 1024, M, 1024, 1024}; N = 1024; E.mode = 1; }
                else if (t == 5) { g = pg8::Gemm{C.xb, C.Wgu + (size_t)l * 5632 * 1024, M, 5632, 1024}; N = 5632; E.mode = 2; }
                else             { g = pg8::Gemm{C.proj, C.Wdn + (size_t)l * 1024 * 2816, M, 1024, 2816}; N = 1024; E.mode = 1; }
                pg8::StaticOrder S; S.init(M, N, nblk, bid);
                LAS float* rsl = (LAS float*)(lds + 131072);
                if (E.mode != 1) {
                    pg8::Unit uu;
                    for (int i = 0; i < 16 && S.next(i, uu); ++i) if (tidv < 256) rsl[i * 256 + tidv] = pg8::rstd_of(C.ssq, uu.pm * 256 + tidv);
                    __syncthreads();
                }
                pg8::gemm_phase<pg8::EpiAny, pg8::StaticOrder, true, true>(lds, g, S, E, tidv); }
            } else if (t == 1) { if (PHEN(2)) { const Ctx C = make_ctx(ap, lds, tidv, bid, nblk); mix1_phase(C, l); } }
            else if (t == 2) { if (PHEN(3)) { const Ctx C = make_ctx(ap, lds, tidv, bid, nblk); aux_phase(C, ph == 0 ? 0 : 1, l); } }
            else { if (PHEN(4)) { const Ctx C = make_ctx(ap, lds, tidv, bid, nblk); mix3_phase(C, l); } }
        }
        if (ph + 1 < ph_hi && coop) {
            if (coop == 2) grid.sync();
            xcd_barrier(bar);
        }
    }
}

#ifndef MK_MULTI
#define MK_MULTI 0
#endif
extern "C" void kernel_launch(void* const* d_in, const int* in_sizes, int n_in, void* d_out, int out_size, void* d_ws, size_t ws_size, hipStream_t stream) {
    static int grid = 0;
    if (grid == 0) {
        if (n_in != 20 || out_size != M * DM || ws_size < WS_END) { fprintf(stderr, "kernel_launch: unexpected shapes (n_in %d out %d ws %zu)\n", n_in, out_size, ws_size); grid = -1; return; }
        int dev = 0, cus = 0, per_cu = 0;
        hipGetDevice(&dev); hipDeviceGetAttribute(&cus, hipDeviceAttributeMultiprocessorCount, dev);
        if (hipFuncSetAttribute((const void*)fwd_kernel, hipFuncAttributeMaxDynamicSharedMemorySize, LDS_BYTES) != hipSuccess) { fprintf(stderr, "kernel_launch: hipFuncSetAttribute failed\n"); grid = -1; return; }
        if (hipOccupancyMaxActiveBlocksPerMultiprocessor(&per_cu, (const void*)fwd_kernel, 512, LDS_BYTES) != hipSuccess || per_cu < 1) { fprintf(stderr, "kernel_launch: occupancy query gave %d\n", per_cu); per_cu = 1; (void)hipGetLastError(); }
        grid = cus * per_cu; if (grid > 256) grid = 256;
    }
    if (grid < 0) return;
    Args a{};
    for (int i = 0; i < 20; ++i) a.in[i] = (const float*)d_in[i];
    a.out = (float*)d_out; a.ws = (unsigned char*)d_ws;
#if MK_MULTI
    a.coop = 0;
    for (int ph = 0; ph < NPHASES; ++ph) { a.ph_lo = ph; a.ph_hi = ph + 1; hipLaunchKernelGGL(fwd_kernel, dim3(grid), dim3(512), LDS_BYTES, stream, a); }
#else
    a.coop = 1; a.ph_lo = 0; a.ph_hi = NPHASES;
    if (hipMemsetAsync(d_ws, 0, 32768, stream) != hipSuccess) { fprintf(stderr, "kernel_launch: hipMemsetAsync failed\n"); return; }
    void* args[] = {&a};
    hipError_t e = hipLaunchCooperativeKernel((const void*)fwd_kernel, dim3(grid), dim3(512), args, LDS_BYTES, stream);
    if (e != hipSuccess) fprintf(stderr, "kernel_launch: cooperative launch failed: %s (grid %d)\n", hipGetErrorString(e), grid);
#endif
}
```

```cpp
#include <hip/hip_runtime.h>
#include <hip/hip_cooperative_groups.h>
#include <cstdio>
#include <cstdint>
namespace cg = cooperative_groups;
namespace pg8 {
#define PG8_LAS __attribute__((address_space(3)))
typedef unsigned short bf16_t;
typedef short bf16x8 __attribute__((ext_vector_type(8)));
typedef float f32x4 __attribute__((ext_vector_type(4)));
typedef unsigned u32x4 __attribute__((ext_vector_type(4)));
constexpr int BM = 256, BK = 64, HALF = 128, HTB = HALF * BK * 2  , STAGE_BYTES = 8 * HTB, NXCD = 8, WGM = 8;

__host__ __device__ __forceinline__ int lds_byte(int r, int c) { const int st = (r >> 4) * 2 + (c >> 5), rr = r & 15, cc = c & 31, ob = rr * 64 + cc * 2; return st * 1024 + (ob ^ (((ob >> 9) & 1) << 5)); }
__host__ __device__ __forceinline__ void stage_rc(int b, int& R, int& C) { const int st = b / 1024, sb = b % 1024, swz = sb ^ (((sb >> 9) & 1) << 5); R = (st >> 1) * 16 + swz / 64; C = (st & 1) * 32 + (swz % 64) / 2; }
__host__ __device__ __forceinline__ int perm32(int rho) { const int n = rho >> 4, i = rho & 15; return 8 * (i >> 2) + 4 * n + (i & 3); }

struct Unit { int pm, pn, idx; };
struct Gemm { const bf16_t* A; const bf16_t* Bt; int M, N, K; };

struct StaticOrder {
    int nM, nN, nwg, G, c;
    __host__ __device__ void init(int M, int N, int G_, int c_) { nM = M / BM; nN = N / BM; nwg = nM * nN; G = G_; c = c_; }
    __host__ __device__ bool next(int i, Unit& u) const {
        const long L = (long)i * G + c; if (L >= nwg) return false; u.idx = i;
        int wgid = (int)L; { const int q = nwg / NXCD, r = nwg % NXCD, xcd = wgid % NXCD, off = wgid / NXCD; wgid = (xcd < r ? xcd * (q + 1) : r * (q + 1) + (xcd - r) * q) + off; }
        const int nig = WGM * nN, gid = wgid / nig, fm = gid * WGM, gsz = (nM - fm) < WGM ? (nM - fm) : WGM;
        u.pm = fm + ((wgid % nig) % gsz); u.pn = (wgid % nig) / gsz; return true;
    }
    __device__ __forceinline__ void a_ready(const Unit&) const {}
    __device__ __forceinline__ void done(const Unit&) const {}
};

__device__ __forceinline__ unsigned cvt_pk_bf16(float lo, float hi) { unsigned r; asm volatile("v_cvt_pk_bf16_f32 %0, %1, %2" : "=v"(r) : "v"(lo), "v"(hi)); return r; }
__device__ __forceinline__ float shflx(float v, int mask, int lane) { return __int_as_float(__builtin_amdgcn_ds_bpermute((lane ^ mask) << 2, __float_as_int(v))); }
__device__ __forceinline__ float rstd_of(const float* ssq, int row) {
    const f32x4* p = (const f32x4*)(ssq + (size_t)row * 16);
    const f32x4 a = p[0], b = p[1], c = p[2], d = p[3];
    const float s = (((a[0] + a[1]) + (a[2] + a[3])) + ((b[0] + b[1]) + (b[2] + b[3]))) + (((c[0] + c[1]) + (c[2] + c[3])) + ((d[0] + d[1]) + (d[2] + d[3])));
    return __builtin_amdgcn_rsqf(s * (1.0f / 1024.0f) + 1e-6f);
}
__device__ __forceinline__ float silu_f(float x) { return x * __builtin_amdgcn_rcpf(1.0f + __builtin_amdgcn_exp2f(-1.4426950408889634f * x)); }
constexpr float QSCALE = 0.125f * 1.4426950408889634f;
struct EpiInProj {
    static constexpr bool PERM = true, AFTER_DRAIN = false;
    bf16_t* proj; float* dtraw; const PG8_LAS float* rsl;
    __device__ __forceinline__ void operator()(const f32x4 (&acc)[2][2][4][2], const Unit& u, int wr, int wc, int fr, int fq) const {
        const int row0 = u.pm * BM + wr * 64 + fr;
        const float sc = (u.pn == 0) ? QSCALE : 1.0f;
#pragma unroll
        for (int ai = 0; ai < 2; ++ai)
#pragma unroll
            for (int m = 0; m < 4; ++m) {
                const int row = row0 + ai * HALF + m * 16;
                const float rs = rsl[u.idx * 256 + (row & 255)] * sc;
                if (u.pn < 11) {
                    bf16_t* rowp = proj + (size_t)row * 2816 + u.pn * BM + wc * 32 + 8 * fq;
#pragma unroll
                    for (int bj = 0; bj < 2; ++bj) {
                        const f32x4 v0 = acc[ai][bj][m][0] * rs, v1 = acc[ai][bj][m][1] * rs;
                        u32x4 w; w.x = cvt_pk_bf16(v0[0], v0[1]); w.y = cvt_pk_bf16(v0[2], v0[3]); w.z = cvt_pk_bf16(v1[0], v1[1]); w.w = cvt_pk_bf16(v1[2], v1[3]);
                        *(u32x4*)(rowp + bj * HALF) = w;
                    }
                } else if (wc == 0 && fq == 0) {
                    *(f32x4*)(dtraw + (size_t)row * 8) = acc[ai][0][m][0] * rs;
                    *(f32x4*)(dtraw + (size_t)row * 8 + 4) = acc[ai][0][m][1] * rs;
                }
            }
    }
};
struct EpiResid {
    static constexpr bool PERM = true, AFTER_DRAIN = false;
    const float* base32; bf16_t* xb; float* ssq;
    __device__ __forceinline__ void operator()(const f32x4 (&acc)[2][2][4][2], const Unit& u, int wr, int wc, int fr, int fq) const {
        const int col0 = u.pn * BM + wc * 32 + 8 * fq, lane_ = fr + 16 * fq;
#pragma unroll
        for (int ai = 0; ai < 2; ++ai)
#pragma unroll
            for (int m = 0; m < 4; ++m) {
                const int row = u.pm * BM + ai * HALF + wr * 64 + m * 16 + fr;
                const size_t off = (size_t)row * 1024 + col0;
                float q = 0.f;
#pragma unroll
                for (int bj = 0; bj < 2; ++bj) {
                    const u32x4 r = *(const u32x4*)(xb + off + bj * HALF);
                    const f32x4 b0 = {__uint_as_float(r.x << 16), __uint_as_float(r.x & 0xffff0000u), __uint_as_float(r.y << 16), __uint_as_float(r.y & 0xffff0000u)};
                    const f32x4 b1 = {__uint_as_float(r.z << 16), __uint_as_float(r.z & 0xffff0000u), __uint_as_float(r.w << 16), __uint_as_float(r.w & 0xffff0000u)};
                    const f32x4 o0 = b0 + acc[ai][bj][m][0], o1 = b1 + acc[ai][bj][m][1];
                    q += ((o0[0] * o0[0] + o0[1] * o0[1]) + (o0[2] * o0[2] + o0[3] * o0[3])) + ((o1[0] * o1[0] + o1[1] * o1[1]) + (o1[2] * o1[2] + o1[3] * o1[3]));
                    u32x4 w; w.x = cvt_pk_bf16(o0[0], o0[1]); w.y = cvt_pk_bf16(o0[2], o0[3]); w.z = cvt_pk_bf16(o1[0], o1[1]); w.w = cvt_pk_bf16(o1[2], o1[3]);
                    *(u32x4*)(xb + off + bj * HALF) = w;
                }
                q += shflx(q, 16, lane_); q += shflx(q, 32, lane_);
                if (fq == 0) ssq[(size_t)row * 16 + u.pn * 4 + wc] = q;
            }
    }
};
typedef float f32x2v __attribute__((ext_vector_type(2)));
struct EpiGateUp {
    static constexpr bool PERM = true, AFTER_DRAIN = false;
    bf16_t* hdn; const PG8_LAS float* rsl;
    __device__ __forceinline__ void operator()(const f32x4 (&acc)[2][2][4][2], const Unit& u, int wr, int wc, int fr, int fq) const {
        const int row0 = u.pm * BM + wr * 64 + fr, col = u.pn * HALF + wc * 32 + 8 * fq;
#pragma unroll
        for (int ai = 0; ai < 2; ++ai)
#pragma unroll
            for (int m = 0; m < 4; ++m) {
                const int row = row0 + ai * HALF + m * 16;
                const float rs = rsl[u.idx * 256 + (row & 255)];
                const float rs2 = rs * rs, nrs = rs * -1.4426950408889634f;
                u32x4 w;
#pragma unroll
                for (int n = 0; n < 2; ++n)
#pragma unroll
                    for (int hh = 0; hh < 2; ++hh) {
                        const f32x2v g = {acc[ai][0][m][n][2 * hh], acc[ai][0][m][n][2 * hh + 1]}, uu = {acc[ai][1][m][n][2 * hh], acc[ai][1][m][n][2 * hh + 1]};
                        const f32x2v t = g * nrs; f32x2v e; e.x = __builtin_amdgcn_exp2f(t.x); e.y = __builtin_amdgcn_exp2f(t.y);
                        const f32x2v d = e + 1.0f; f32x2v r; r.x = __builtin_amdgcn_rcpf(d.x); r.y = __builtin_amdgcn_rcpf(d.y);
                        const f32x2v o = (g * uu) * (r * rs2);
                        w[2 * n + hh] = cvt_pk_bf16(o.x, o.y);
                    }
                *(u32x4*)(hdn + (size_t)row * 2816 + col) = w;
            }
    }
};

struct EpiAny {
    static constexpr bool PERM = true, AFTER_DRAIN = false;
    int mode; EpiInProj e0; EpiResid e1; EpiGateUp e2;
    __device__ __forceinline__ void operator()(const f32x4 (&acc)[2][2][4][2], const Unit& u, int wr, int wc, int fr, int fq) const {
        if (mode == 0) e0(acc, u, wr, wc, fr, fq); else if (mode == 1) e1(acc, u, wr, wc, fr, fq); else e2(acc, u, wr, wc, fr, fq);
    }
};
template <class Epi, class Sched, bool ALIGN_EPI = false, bool SP2 = false>
__device__ __forceinline__ void gemm_phase(PG8_LAS unsigned char* lds, const Gemm g, const Sched& S, const Epi& E, const int tid) {
    const int wid = __builtin_amdgcn_readfirstlane(tid >> 6), lane = tid & 63, wr = wid >> 2, wc = wid & 3, fr = lane & 15, fq = lane >> 4;
    const int K = g.K, nt = K / BK;
    unsigned voffA[2], voffB[2];
#pragma unroll
    for (int i = 0; i < 2; ++i) { int R, C; stage_rc(tid * 16 + i * 8192, R, C); const int Rb = Epi::PERM ? ((R & ~31) + perm32(R & 31)) : R;
        voffA[i] = (unsigned)(R * K + C) * 2u; voffB[i] = (unsigned)(Rb * K + C) * 2u; }
    const size_t kstep = (size_t)(BK * 2);
    const size_t hstep = (size_t)HALF * K * 2;
    const size_t tstep = 2 * hstep;
    const unsigned ldsw = (unsigned)wid * 1024u;
    const int aoff = lds_byte(wr * 64 + fr, fq * 8), boff = lds_byte(wc * 32 + fr, fq * 8);
#define PG8_SA(b, h) (((b) * 2 + (h)) * HTB)
#define PG8_SB(b, h) ((4 + (b) * 2 + (h)) * HTB)
#define PG8_STAGE(bufoff, gbase, voff) do { _Pragma("unroll") for (int _i = 0; _i < 2; ++_i) \
        __builtin_amdgcn_global_load_lds((const unsigned*)((const char*)(gbase) + (voff)[_i]), (PG8_LAS unsigned*)(lds + (bufoff) + ldsw + _i * 8192), 16, 0, 0); } while (0)
#define PG8_LDA(dst, b, h) do { _Pragma("unroll") for (int m = 0; m < 4; ++m) _Pragma("unroll") for (int k = 0; k < 2; ++k) dst[m][k] = *(const PG8_LAS bf16x8*)(lds + PG8_SA(b, h) + aoff + m * 2048 + k * 1024); } while (0)
#define PG8_LDB(dst, b, h) do { _Pragma("unroll") for (int n = 0; n < 2; ++n) _Pragma("unroll") for (int k = 0; k < 2; ++k) dst[n][k] = *(const PG8_LAS bf16x8*)(lds + PG8_SB(b, h) + boff + n * 2048 + k * 1024); } while (0)
#define PG8_MMA(ai, bj, At, Bt) do { __builtin_amdgcn_s_setprio(1); _Pragma("unroll") for (int m = 0; m < 4; ++m) _Pragma("unroll") for (int n = 0; n < 2; ++n) _Pragma("unroll") for (int k = 0; k < 2; ++k) \
        acc[ai][bj][m][n] = __builtin_amdgcn_mfma_f32_16x16x32_bf16(Bt[n][k], At[m][k], acc[ai][bj][m][n], 0, 0, 0); __builtin_amdgcn_s_setprio(0); } while (0)
#define PG8_WAIT_V(n) asm volatile("s_waitcnt vmcnt(" #n ")" ::: "memory")
#define PG8_WAIT_L(n) asm volatile("s_waitcnt lgkmcnt(" #n ")" ::: "memory")
#define PG8_BAR __builtin_amdgcn_s_barrier()
#define PG8_SCHED __builtin_amdgcn_sched_barrier(0)
    Unit cur, nxt; int ui = 0;
    if (!S.next(0, cur)) return;
    f32x4 acc[2][2][4][2];
#pragma unroll
    for (int a = 0; a < 2; ++a)
#pragma unroll
        for (int b = 0; b < 2; ++b)
#pragma unroll
            for (int m = 0; m < 4; ++m)
#pragma unroll
                for (int n = 0; n < 2; ++n) acc[a][b][m][n] = (f32x4){0.f, 0.f, 0.f, 0.f};
    bf16x8 At[4][2], B0[2][2], B1[2][2];
    const char* cA = (const char*)g.A + (size_t)cur.pm * tstep; const char* cB = (const char*)g.Bt + (size_t)cur.pn * tstep;
    S.a_ready(cur);
    if constexpr (SP2) {
        PG8_STAGE(PG8_SB(0, 0), cB, voffB); PG8_STAGE(PG8_SB(0, 1), cB + hstep, voffB); PG8_STAGE(PG8_SA(0, 0), cA, voffA); PG8_STAGE(PG8_SA(0, 1), cA + hstep, voffA);
        if (wr == 1) PG8_BAR;
        PG8_WAIT_V(2); PG8_BAR;
        PG8_STAGE(PG8_SB(1, 0), cB + kstep, voffB); PG8_STAGE(PG8_SA(1, 0), cA + kstep, voffA); PG8_STAGE(PG8_SB(1, 1), cB + hstep + kstep, voffB);
        PG8_WAIT_V(6); PG8_BAR;
    } else {
        PG8_STAGE(PG8_SB(0, 0), cB, voffB); PG8_STAGE(PG8_SA(0, 0), cA, voffA); PG8_STAGE(PG8_SB(0, 1), cB + hstep, voffB); PG8_STAGE(PG8_SA(0, 1), cA + hstep, voffA);
        if (wr == 1) PG8_BAR;
        PG8_WAIT_V(4); PG8_BAR;
        PG8_STAGE(PG8_SB(1, 0), cB + kstep, voffB); PG8_STAGE(PG8_SA(1, 0), cA + kstep, voffA); PG8_STAGE(PG8_SB(1, 1), cB + hstep + kstep, voffB);
        PG8_WAIT_V(6); PG8_BAR;
    }
    for (;;) {
        const bool has_next = S.next(ui + 1, nxt);
        const char* nA = has_next ? (const char*)g.A + (size_t)nxt.pm * tstep : cA; const char* nB = has_next ? (const char*)g.Bt + (size_t)nxt.pn * tstep : cB;
        for (int t = 0; t < nt; t += 2) {
            const bool last = (t == nt - 2);
            const char* a1 = cA + (size_t)(t + 1) * kstep;
            const char* a2 = last ? nA : cA + (size_t)(t + 2) * kstep; const char* b2 = last ? nB : cB + (size_t)(t + 2) * kstep;
            const char* a3 = a2 + kstep; const char* b3 = b2 + kstep;
            if (last && has_next) S.a_ready(nxt);
            if constexpr (SP2) {
            PG8_LDB(B0, 0, 0); PG8_LDB(B1, 0, 1); PG8_SCHED; PG8_LDA(At, 0, 0); PG8_STAGE(PG8_SA(1, 1), a1 + hstep, voffA);
            PG8_WAIT_V(8); PG8_WAIT_L(0); PG8_BAR; PG8_MMA(0, 0, At, B0); PG8_MMA(0, 1, At, B1); PG8_BAR; PG8_SCHED;
            PG8_LDA(At, 0, 1); PG8_STAGE(PG8_SB(0, 0), b2, voffB); PG8_STAGE(PG8_SB(0, 1), b2 + hstep, voffB); PG8_STAGE(PG8_SA(0, 0), a2, voffA);
            PG8_WAIT_V(8); PG8_WAIT_L(0); PG8_BAR; PG8_MMA(1, 0, At, B0); PG8_MMA(1, 1, At, B1); PG8_BAR; PG8_SCHED;
            PG8_LDB(B0, 1, 0); PG8_LDB(B1, 1, 1); PG8_SCHED; PG8_LDA(At, 1, 0); PG8_STAGE(PG8_SA(0, 1), a2 + hstep, voffA);
            PG8_WAIT_V(8); PG8_WAIT_L(0); PG8_BAR; PG8_MMA(0, 0, At, B0); PG8_MMA(0, 1, At, B1); PG8_BAR; PG8_SCHED;
            PG8_LDA(At, 1, 1); PG8_STAGE(PG8_SB(1, 0), b3, voffB); PG8_STAGE(PG8_SB(1, 1), b3 + hstep, voffB); PG8_STAGE(PG8_SA(1, 0), a3, voffA);
            PG8_WAIT_V(8); PG8_WAIT_L(0); PG8_BAR; PG8_MMA(1, 0, At, B0); PG8_MMA(1, 1, At, B1); PG8_BAR; PG8_SCHED;
            } else {
            PG8_LDB(B0, 0, 0); PG8_SCHED; PG8_LDA(At, 0, 0); PG8_STAGE(PG8_SA(1, 1), a1 + hstep, voffA);
            PG8_WAIT_L(8); PG8_BAR; PG8_WAIT_L(0); PG8_MMA(0, 0, At, B0); PG8_BAR; PG8_SCHED;
            PG8_LDB(B1, 0, 1); PG8_STAGE(PG8_SB(0, 0), b2, voffB);
            PG8_BAR; PG8_WAIT_L(0); PG8_MMA(0, 1, At, B1); PG8_BAR;
            PG8_LDA(At, 0, 1); PG8_STAGE(PG8_SA(0, 0), a2, voffA);
            PG8_BAR; PG8_WAIT_L(0); PG8_MMA(1, 0, At, B0); PG8_BAR; PG8_SCHED;
            PG8_STAGE(PG8_SB(0, 1), b2 + hstep, voffB);
            PG8_WAIT_V(6); PG8_BAR; PG8_MMA(1, 1, At, B1); PG8_BAR;
            PG8_LDB(B0, 1, 0); PG8_SCHED; PG8_LDA(At, 1, 0); PG8_STAGE(PG8_SA(0, 1), a2 + hstep, voffA);
            PG8_WAIT_L(8); PG8_BAR; PG8_WAIT_L(0); PG8_MMA(0, 0, At, B0); PG8_BAR; PG8_SCHED;
            PG8_LDB(B1, 1, 1); PG8_STAGE(PG8_SB(1, 0), b3, voffB);
            PG8_BAR; PG8_WAIT_L(0); PG8_MMA(0, 1, At, B1); PG8_BAR;
            PG8_LDA(At, 1, 1); PG8_STAGE(PG8_SA(1, 0), a3, voffA);
            PG8_BAR; PG8_WAIT_L(0); PG8_MMA(1, 0, At, B0); PG8_BAR; PG8_SCHED;
            PG8_STAGE(PG8_SB(1, 1), b3 + hstep, voffB);
            PG8_WAIT_V(6); PG8_BAR; PG8_MMA(1, 1, At, B1); PG8_BAR;
            }
        }
        if constexpr (ALIGN_EPI) { if (wr == 0) PG8_BAR; }
        if constexpr (!Epi::AFTER_DRAIN) { E(acc, cur, wr, wc, fr, fq); S.done(cur); }
        if (!has_next) break;
#pragma unroll
        for (int a = 0; a < 2; ++a)
#pragma unroll
            for (int b = 0; b < 2; ++b)
#pragma unroll
                for (int m = 0; m < 4; ++m)
#pragma unroll
                    for (int n = 0; n < 2; ++n) acc[a][b][m][n] = (f32x4){0.f, 0.f, 0.f, 0.f};
        cur = nxt; cA = nA; cB = nB; ++ui;
        if constexpr (ALIGN_EPI) { if (wr == 1) PG8_BAR; }
    }
    PG8_WAIT_V(0);
    if constexpr (!ALIGN_EPI) { if (wr == 0) PG8_BAR; }
    PG8_BAR;
    if constexpr (Epi::AFTER_DRAIN) { E.fused(acc, cur, wr, wc, fr, fq, lds, wid, lane); S.done(cur); }
#undef PG8_SA
#undef PG8_SB
#undef PG8_STAGE
#undef PG8_LDA
#undef PG8_LDB
#undef PG8_MMA
#undef PG8_WAIT_V
#undef PG8_WAIT_L
#undef PG8_BAR
#undef PG8_SCHED
}
}

#define LAS __attribute__((address_space(3)))
typedef unsigned short bf16;
typedef float f32x4 __attribute__((ext_vector_type(4)));
typedef float f32x2 __attribute__((ext_vector_type(2)));
typedef short bf16x8 __attribute__((ext_vector_type(8)));
typedef unsigned u32x4 __attribute__((ext_vector_type(4)));
typedef unsigned u32x2 __attribute__((ext_vector_type(2)));
typedef __bf16 bf16x2_t __attribute__((ext_vector_type(2)));
typedef short s16x4 __attribute__((ext_vector_type(4)));

constexpr int M = 16384, DM = 1024, NPROJ = 2816, NCHUNK = 256;
constexpr int PJ_Q = 0, PJ_K = 256, PJ_V = 512, PJ_Z = 768, PJ_XBC = 1280, PJ_GLU = 2304;
constexpr int MX_A = 0, MX_B = 256, MX_C = 768;
constexpr size_t MiB = 1u << 20;
constexpr size_t WS_SSQ = 1 * MiB, WS_DT = 2 * MiB, WS_CD = 2 * MiB + 512 * 1024, WS_WIN = 4 * MiB, WS_WOUT = 16 * MiB, WS_WGU = 20 * MiB, WS_WDN = 42 * MiB,
                 WS_XB = 54 * MiB, WS_MIX = 86 * MiB, WS_ST = 118 * MiB, WS_PROJ = 150 * MiB, WS_END = 238 * MiB;
constexpr int LDS_BYTES = 153600;
constexpr float LOG2E = 1.4426950408889634f;
constexpr int NPHASES = 16;

__device__ __forceinline__ float bflo(unsigned u) { return __uint_as_float(u << 16); }
__device__ __forceinline__ float bfhi(unsigned u) { return __uint_as_float(u & 0xffff0000u); }
__device__ __forceinline__ float bf2f(bf16 h) { return __uint_as_float((unsigned)h << 16); }
__device__ __forceinline__ unsigned pk2(float lo, float hi) { f32x2 v = {lo, hi}; bf16x2_t b = __builtin_convertvector(v, bf16x2_t); return __builtin_bit_cast(unsigned, b); }
__device__ __forceinline__ bf16 f2bf(float f) { return (bf16)(pk2(f, 0.f) & 0xffffu); }
__device__ __forceinline__ f32x4 mfma16(bf16x8 a, bf16x8 b, f32x4 c) { return __builtin_amdgcn_mfma_f32_16x16x32_bf16(a, b, c, 0, 0, 0); }
__device__ __forceinline__ float fsilu(float x) { return x * __builtin_amdgcn_rcpf(1.0f + __builtin_amdgcn_exp2f(-LOG2E * x)); }
__device__ __forceinline__ float fsigmoid(float x) { return __builtin_amdgcn_rcpf(1.0f + __builtin_amdgcn_exp2f(-LOG2E * x)); }
__device__ __forceinline__ float fexp(float x) { return __builtin_amdgcn_exp2f(LOG2E * x); }
using pg8::shflx;
__device__ __forceinline__ float wave_sum(float v, int lane) {
#pragma unroll
    for (int o = 1; o < 64; o <<= 1) v += shflx(v, o, lane);
    return v;
}

template <class T> __device__ __forceinline__ T* launder(T* p) { asm volatile("" : "+s"(p)); return p; }
struct Args { const float* in[20]; float* out; unsigned char* ws; int ph_lo, ph_hi, coop, pad; };
struct Ctx {
    LAS unsigned char* lds; int tid, lane, wave, bid, nblk;
    const float* in[20]; float* out;
    bf16 *Win, *Wout, *Wgu, *Wdn, *xb, *mix, *states, *proj;
    float *ssq, *dtraw, *cdecay;
};

struct P0Item { const float* W; const float* gain; bf16* WT; int nsrc, col, valid, K, drow, k0; };
__device__ __forceinline__ P0Item p0_decode(const Ctx& C, int it) {
    constexpr int I_IN = 16 * 96, I_OUT = 16 * 32, I_GU = 16 * 176, I_DN = 44 * 32, I_L = I_IN + I_OUT + I_GU + I_DN;
    P0Item P; const int l = it / I_L; int r = it % I_L;
    if (r < I_IN) {
        const int kb = r / 96, n0 = 32 * (r % 96);
        int col, valid;
        if (n0 < 2304) { col = n0; valid = 32; } else if (n0 < 2816) { col = n0 + 8; valid = 32; } else if (n0 == 2816) { col = 2304; valid = 8; } else { col = 0; valid = 0; }
        P.W = C.in[2] + (size_t)l * 1024 * 2824; P.nsrc = 2824; P.col = col; P.valid = valid; P.gain = C.in[1] + l * 1024; P.K = 1024; P.WT = C.Win + (size_t)l * 3072 * 1024; P.drow = n0; P.k0 = 64 * kb;
        return P;
    }
    r -= I_IN;
    if (r < I_OUT) { const int kb = r / 32, n0 = 32 * (r % 32);
        P.W = C.in[14] + (size_t)l * 1024 * 1024; P.nsrc = 1024; P.col = n0; P.valid = 32; P.gain = nullptr; P.K = 1024; P.WT = C.Wout + (size_t)l * 1024 * 1024; P.drow = n0; P.k0 = 64 * kb; return P; }
    r -= I_OUT;
    if (r < I_GU) { const int kb = r / 176, n0 = 32 * (r % 176); const int t = n0 >> 8, hs = (n0 >> 7) & 1, i = n0 & 127;
        P.W = (hs ? C.in[17] : C.in[16]) + (size_t)l * 1024 * 2816; P.nsrc = 2816; P.col = 128 * t + i; P.valid = 32; P.gain = C.in[15] + l * 1024; P.K = 1024; P.WT = C.Wgu + (size_t)l * 5632 * 1024; P.drow = n0; P.k0 = 64 * kb; return P; }
    r -= I_GU;
    { const int kb = r / 32, n0 = 32 * (r % 32);
        P.W = C.in[18] + (size_t)l * 2816 * 1024; P.nsrc = 1024; P.col = n0; P.valid = 32; P.gain = nullptr; P.K = 2816; P.WT = C.Wdn + (size_t)l * 1024 * 2816; P.drow = n0; P.k0 = 64 * kb; return P; }
}
__device__ __forceinline__ void p0_load(const P0Item& P, float (&wv)[32], int lane) {
    const int c31 = lane & 31;
#pragma unroll
    for (int i = 0; i < 32; ++i) { const int kk = 2 * i + (lane >> 5); wv[i] = (c31 < P.valid) ? P.W[(size_t)(P.k0 + kk) * P.nsrc + P.col + c31] : 0.f; }
}
__device__ __forceinline__ void p0_finish(const P0Item& P, float (&wv)[32], LAS float* scr, int lane) {
    const int c31 = lane & 31;
    if (P.gain) {
#pragma unroll
        for (int i = 0; i < 32; ++i) wv[i] *= P.gain[P.k0 + 2 * i + (lane >> 5)];
    }
#pragma unroll
    for (int i = 0; i < 32; ++i) scr[(2 * i + (lane >> 5)) * 33 + c31] = wv[i];
    const int c = lane & 7;
#pragma unroll
    for (int j = 0; j < 4; ++j) {
        const int n = (lane >> 3) + 8 * j; const LAS float* s = scr + (8 * c) * 33 + n;
        u32x4 o; o.x = pk2(s[0 * 33], s[1 * 33]); o.y = pk2(s[2 * 33], s[3 * 33]); o.z = pk2(s[4 * 33], s[5 * 33]); o.w = pk2(s[6 * 33], s[7 * 33]);
        *(u32x4*)(P.WT + (size_t)(P.drow + n) * P.K + P.k0 + 8 * c) = o;
    }
}
__device__ __forceinline__ void p0_convert(const Ctx& C, int it_begin, int it_end, int gw, int NGW, LAS float* scr, int lane) {
#pragma unroll 1
    for (int it = it_begin + gw; it < it_end; it += NGW) {
        float wa[32];
        const P0Item pa = p0_decode(C, it);
        p0_load(pa, wa, lane);
        p0_finish(pa, wa, scr, lane);
    }
}
constexpr int P0_FIRST = 16 * 96;
constexpr int P0_SPLIT = (16 * 96 + 16 * 32 + 16 * 176 + 44 * 32) + 16 * 96;
constexpr int P0_ALL = 2 * (16 * 96 + 16 * 32 + 16 * 176 + 44 * 32);
#ifndef M1P
#define M1P 7
#endif
__device__ __forceinline__ void ssd_dt_acs(const Ctx& C, int layer, int ck, LAS float* sDT, LAS float* sACS, LAS float* sW, bool has_w, int lane, int wave) {
    const int h = wave, t0 = ck * 64;
    const float raw = C.dtraw[(size_t)(t0 + lane) * 8 + h] + C.in[6][layer * 8 + h];
    const float dt = fmaxf(raw, 0.f) + log1pf(expf(-fabsf(raw)));
    const float av = -expf(C.in[7][layer * 8 + h]) * dt;
    float cs = av;
#pragma unroll
    for (int o = 1; o < 64; o <<= 1) { const float v = __int_as_float(__builtin_amdgcn_ds_bpermute(((lane - o) & 63) << 2, __float_as_int(cs))); if (lane >= o) cs += v; }
    const float aend = __int_as_float(__builtin_amdgcn_readlane(__float_as_int(cs), 63));
    sDT[h * 64 + lane] = dt; sACS[h * 64 + lane] = cs;
    if (has_w) { sW[h * 64 + lane] = dt * expf(aend - cs); if (lane == 63) C.cdecay[ck * 8 + h] = expf(cs); }
}

__device__ __forceinline__ void mix1_phase(const Ctx& C, int layer) {
    LAS float* sDT = (LAS float*)(C.lds); LAS float* sACS = (LAS float*)(C.lds + 2048); LAS float* sW = (LAS float*)(C.lds + 4096);
    LAS bf16* sT = (LAS bf16*)(C.lds + 8192);
    LAS float* sBias = (LAS float*)(C.lds + 122880);
    for (int i = C.tid; i < 4 * 257; i += 512) sBias[i] = C.in[3][layer * 4 * 257 + i] * LOG2E;
    for (int ck = ((C.nblk & 7) == 0 ? (C.bid & 7) * (C.nblk >> 3) + (C.bid >> 3) : C.bid); ck < NCHUNK; ck += C.nblk) {
        int tid = C.tid; asm volatile("" : "+v"(tid));
        const int lane = tid & 63, wave = __builtin_amdgcn_readfirstlane(tid >> 6), fr = lane & 15, fq = lane >> 4;
        const int cin = ck & 127, t0 = ck * 64; const bool first = (cin == 0);
        const float* cw = launder(C.in[4]) + (size_t)layer * 4 * 1024; const float* cb = launder(C.in[5]) + layer * 1024;
        ssd_dt_acs(C, layer, ck, sDT, sACS, sW, true, lane, wave);
        __syncthreads();
        if (tid < 384) {
            const int ch0 = 2 * tid;
            const f32x2 w0 = *(const f32x2*)(cw + 0 * 1024 + ch0), w1 = *(const f32x2*)(cw + 1 * 1024 + ch0), w2 = *(const f32x2*)(cw + 2 * 1024 + ch0), w3 = *(const f32x2*)(cw + 3 * 1024 + ch0);
            const f32x2 bb = *(const f32x2*)(cb + ch0);
            const unsigned* src = (const unsigned*)(C.proj + (size_t)t0 * NPROJ + PJ_XBC + ch0);
            f32x2 xm3 = {0.f, 0.f}, xm2 = {0.f, 0.f}, xm1 = {0.f, 0.f};
            if (!first) { const unsigned a = src[-3 * (NPROJ / 2)], b = src[-2 * (NPROJ / 2)], c = src[-1 * (NPROJ / 2)];
                xm3 = (f32x2){bflo(a), bfhi(a)}; xm2 = (f32x2){bflo(b), bfhi(b)}; xm1 = (f32x2){bflo(c), bfhi(c)}; }
            const int hh = ch0 >> 6; const bool isx = ch0 < 512;
#pragma unroll 1
            for (int l0 = 0; l0 < 64; l0 += 16) {
            unsigned uu[16];
#pragma unroll
            for (int i = 0; i < 16; ++i) uu[i] = src[(l0 + i) * (NPROJ / 2)];
#pragma unroll
            for (int li = 0; li < 16; li += 2) {
                const int l = l0 + li;
                const unsigned ua = uu[li], ub = uu[li + 1];
                const f32x2 xa = {bflo(ua), bfhi(ua)}, xc = {bflo(ub), bfhi(ub)};
                f32x2 ya = bb + w0 * xm3 + w1 * xm2 + w2 * xm1 + w3 * xa;
                f32x2 yb = bb + w0 * xm2 + w1 * xm1 + w2 * xa + w3 * xc;
                xm3 = xm1; xm2 = xa; xm1 = xc;
                ya.x = fsilu(ya.x); ya.y = fsilu(ya.y); yb.x = fsilu(yb.x); yb.y = fsilu(yb.y);
                if (isx) { const float wa = sW[hh * 64 + l], wb = sW[hh * 64 + l + 1]; ya = ya * wa; yb = yb * wb; }
                *(LAS unsigned*)(sT + ch0 * 72 + l) = pk2(ya.x, yb.x);
                *(LAS unsigned*)(sT + (ch0 + 1) * 72 + l) = pk2(ya.y, yb.y);
            }
            }
        }
        __syncthreads();
        if (M1P & 1) {
            const int h = wave, g = h >> 2;
            bf16x8 xf[4][2];
#pragma unroll
            for (int pt = 0; pt < 4; ++pt)
#pragma unroll
                for (int ks = 0; ks < 2; ++ks) xf[pt][ks] = *(const LAS bf16x8*)(sT + (h * 64 + 16 * pt + fr) * 72 + 32 * ks + 8 * fq);
            bf16* st = C.states + (size_t)(ck * 8 + h) * 64 * 128;
#pragma unroll 1
            for (int nt = 0; nt < 8; ++nt) {
                bf16x8 bfr[2];
#pragma unroll
                for (int ks = 0; ks < 2; ++ks) bfr[ks] = *(const LAS bf16x8*)(sT + (512 + g * 128 + 16 * nt + fr) * 72 + 32 * ks + 8 * fq);
#pragma unroll
                for (int pt = 0; pt < 4; ++pt) {
                    f32x4 acc = {0.f, 0.f, 0.f, 0.f};
#pragma unroll
                    for (int ks = 0; ks < 2; ++ks) acc = mfma16(bfr[ks], xf[pt][ks], acc);
                    u32x2 w; w.x = pk2(acc[0], acc[1]); w.y = pk2(acc[2], acc[3]);
                    *(u32x2*)(st + (16 * pt + fr) * 128 + 16 * nt + 4 * fq) = w;
                }
            }
        }
        __syncthreads();
        if (M1P & 2) {
            LAS bf16* G = (LAS bf16*)(C.lds + 8192);
            LAS float* CO = (LAS float*)(C.lds + 8192 + 48128);
            const int c = tid & 255, half = tid >> 8;
#pragma unroll
            for (int it = 0; it < 6; ++it) {
                const int u = tid + 512 * it, r = u >> 5, c8 = u & 31;
                if (u < 94 * 32) {
                    u32x4 o = {0u, 0u, 0u, 0u};
                    if (!(first && r < 30)) {
                        const bf16* p = C.proj + (size_t)(t0 - 30 + r) * NPROJ + PJ_GLU + 8 * c8;
                        const u32x4 av = *(const u32x4*)p, gv = *(const u32x4*)(p + 256);
#pragma unroll
                        for (int e = 0; e < 4; ++e) o[e] = pk2(bflo(av[e]) * fsigmoid(bflo(gv[e])), bfhi(av[e]) * fsigmoid(bfhi(gv[e])));
                    }
                    *(LAS u32x4*)(G + r * 256 + 8 * c8) = o;
                }
            }
            __syncthreads();
            {
                const float* dww = launder(C.in[10]) + (size_t)layer * 31 * 256 + c;
                float w[31];
#pragma unroll
                for (int k = 0; k < 31; ++k) w[k] = dww[k * 256];
                const float bias = launder(C.in[11])[layer * 256 + c];
#pragma unroll 1
                for (int grp = 0; grp < 4; ++grp) {
                    float o[8];
#pragma unroll
                    for (int i = 0; i < 8; ++i) o[i] = bias;
                    const LAS bf16* gp = G + (half * 32 + grp * 8) * 256 + c;
#pragma unroll
                    for (int r = 0; r < 38; ++r) {
                        const float v = bf2f(gp[r * 256]);
#pragma unroll
                        for (int i = 0; i < 8; ++i) { const int k = r - i; if (k >= 0 && k <= 30) o[i] += w[k] * v; }
                    }
#pragma unroll
                    for (int i = 0; i < 8; ++i) CO[(half * 32 + grp * 8 + i) * 256 + c] = o[i];
                }
            }
            __syncthreads();
            {
                const f32x4 lg = *((const f32x4*)(launder(C.in[12]) + layer * 256) + lane), lb = *((const f32x4*)(launder(C.in[13]) + layer * 256) + lane);
#pragma unroll 2
                for (int i = 0; i < 8; ++i) {
                    const int l = wave * 8 + i;
                    const f32x4 v = *((const LAS f32x4*)(CO + l * 256) + lane);
                    const float s = wave_sum((v[0] + v[1]) + (v[2] + v[3]), lane);
                    const float mu = s * (1.f / 256.f);
                    const f32x4 d = v - mu;
                    const float s2 = wave_sum((d[0] * d[0] + d[1] * d[1]) + (d[2] * d[2] + d[3] * d[3]), lane);
                    const float rstd = 1.0f / sqrtf(s2 * (1.f / 256.f) + 1e-6f);
                    const f32x4 y = d * rstd * lg + lb;
                    u32x2 w; w.x = pk2(fsilu(y[0]), fsilu(y[1])); w.y = pk2(fsilu(y[2]), fsilu(y[3]));
                    *((u32x2*)(C.mix + (size_t)(t0 + l) * DM + MX_C) + lane) = w;
                }
            }
        }
        __syncthreads();
        if (M1P & 4) {
            LAS bf16* sK = (LAS bf16*)(C.lds + 8192);
            LAS bf16* sV = (LAS bf16*)(C.lds + 8192 + 33792);
            const int h = wave >> 1, qh = wave & 1, q4 = (lane & 15) >> 2, p4 = lane & 3;
            bf16x8 qf[2][2];
#pragma unroll
            for (int qt = 0; qt < 2; ++qt)
#pragma unroll
                for (int ks = 0; ks < 2; ++ks) qf[qt][ks] = *(const bf16x8*)(C.proj + (size_t)(t0 + 32 * qh + 16 * qt + fr) * NPROJ + PJ_Q + h * 64 + 32 * ks + 8 * fq);
            float mrun[2] = {-1e30f, -1e30f}, lsum[2] = {0.f, 0.f};
            f32x4 oacc[4][2];
#pragma unroll
            for (int dt = 0; dt < 4; ++dt)
#pragma unroll
                for (int qt = 0; qt < 2; ++qt) oacc[dt][qt] = (f32x4){0.f, 0.f, 0.f, 0.f};
            const int jmin = cin >= 8 ? 0 : 8 - cin;
            u32x4 kreg[4], vreg[4];
#define ATT_LOAD(jj) do { const bf16* base_ = C.proj + (size_t)(t0 + ((jj) - 8) * 64) * NPROJ; _Pragma("unroll") for (int i = 0; i < 4; ++i) { const int u = tid + 512 * i, row = u >> 5, c8 = u & 31; \
                kreg[i] = *(const u32x4*)(base_ + (size_t)row * NPROJ + PJ_K + 8 * c8); vreg[i] = *(const u32x4*)(base_ + (size_t)row * NPROJ + PJ_V + 8 * c8); } } while (0)
            ATT_LOAD(jmin);
            for (int j = jmin; j <= 8; ++j) {
#pragma unroll
                for (int i = 0; i < 4; ++i) { const int u = tid + 512 * i, row = u >> 5, c8 = u & 31;
                    *(LAS u32x4*)(sK + row * 264 + 8 * c8) = kreg[i]; *(LAS u32x4*)(sV + row * 264 + 8 * c8) = vreg[i]; }
                __syncthreads();
                if (j < 8) ATT_LOAD(j + 1);
                f32x4 st[4][2];
#pragma unroll
                for (int kt = 0; kt < 4; ++kt) {
                    bf16x8 kf[2];
#pragma unroll
                    for (int ks = 0; ks < 2; ++ks) kf[ks] = *(const LAS bf16x8*)(sK + (16 * kt + fr) * 264 + h * 64 + 32 * ks + 8 * fq);
#pragma unroll
                    for (int qt = 0; qt < 2; ++qt) { f32x4 acc = {0.f, 0.f, 0.f, 0.f};
#pragma unroll
                        for (int ks = 0; ks < 2; ++ks) acc = mfma16(kf[ks], qf[qt][ks], acc);
                        st[kt][qt] = acc; }
                }
                if (j >= 6) {
#pragma unroll
                    for (int kt = 0; kt < 4; ++kt)
#pragma unroll
                        for (int qt = 0; qt < 2; ++qt)
#pragma unroll
                            for (int e = 0; e < 4; ++e) {
                                const int rel = (32 * qh + 16 * qt + fr) + 512 - 64 * j - (16 * kt + 4 * fq + e);
                                const int idx = (rel < -128 ? -128 : (rel > 128 ? 128 : rel)) + 128;
                                st[kt][qt][e] += sBias[h * 257 + idx];
                            }
                } else {
                    const float bc = sBias[h * 257 + 256];
#pragma unroll
                    for (int kt = 0; kt < 4; ++kt)
#pragma unroll
                        for (int qt = 0; qt < 2; ++qt) st[kt][qt] = st[kt][qt] + bc;
                }
#pragma unroll
                for (int qt = 0; qt < 2; ++qt) {
                    float mx = -1e30f;
#pragma unroll
                    for (int kt = 0; kt < 4; ++kt)
#pragma unroll
                        for (int e = 0; e < 4; ++e) mx = fmaxf(mx, st[kt][qt][e]);
                    mx = fmaxf(mx, shflx(mx, 16, lane)); mx = fmaxf(mx, shflx(mx, 32, lane));
                    const float mnew = fmaxf(mrun[qt], mx), alpha = __builtin_amdgcn_exp2f(mrun[qt] - mnew);
                    mrun[qt] = mnew;
                    float ps = 0.f;
#pragma unroll
                    for (int kt = 0; kt < 4; ++kt)
#pragma unroll
                        for (int e = 0; e < 4; ++e) { const float p = __builtin_amdgcn_exp2f(st[kt][qt][e] - mnew); st[kt][qt][e] = p; ps += p; }
                    lsum[qt] = lsum[qt] * alpha + ps;
#pragma unroll
                    for (int dt = 0; dt < 4; ++dt) oacc[dt][qt] = oacc[dt][qt] * alpha;
                }
                bf16x8 pf[2][2];
#pragma unroll
                for (int s2 = 0; s2 < 2; ++s2)
#pragma unroll
                    for (int qt = 0; qt < 2; ++qt) {
                        u32x4 w; w.x = pk2(st[2 * s2][qt][0], st[2 * s2][qt][1]); w.y = pk2(st[2 * s2][qt][2], st[2 * s2][qt][3]);
                        w.z = pk2(st[2 * s2 + 1][qt][0], st[2 * s2 + 1][qt][1]); w.w = pk2(st[2 * s2 + 1][qt][2], st[2 * s2 + 1][qt][3]);
                        pf[s2][qt] = __builtin_bit_cast(bf16x8, w);
                    }
#pragma unroll
                for (int dt = 0; dt < 4; ++dt)
#pragma unroll
                    for (int s2 = 0; s2 < 2; ++s2) {
                        const s16x4 lo = __builtin_amdgcn_ds_read_tr16_b64_v4i16((LAS s16x4*)(sV + (32 * s2 + 4 * fq + q4) * 264 + h * 64 + 16 * dt + 4 * p4));
                        const s16x4 hi = __builtin_amdgcn_ds_read_tr16_b64_v4i16((LAS s16x4*)(sV + (32 * s2 + 16 + 4 * fq + q4) * 264 + h * 64 + 16 * dt + 4 * p4));
                        const bf16x8 vf = __builtin_shufflevector(lo, hi, 0, 1, 2, 3, 4, 5, 6, 7);
#pragma unroll
                        for (int qt = 0; qt < 2; ++qt) oacc[dt][qt] = mfma16(vf, pf[s2][qt], oacc[dt][qt]);
                    }
                __syncthreads();
            }
#undef ATT_LOAD
#pragma unroll
            for (int qt = 0; qt < 2; ++qt) {
                float l = lsum[qt]; l += shflx(l, 16, lane); l += shflx(l, 32, lane);
                const float inv = 1.0f / l;
                bf16* op = C.mix + (size_t)(t0 + 32 * qh + 16 * qt + fr) * DM + MX_A + h * 64 + 4 * fq;
#pragma unroll
                for (int dt = 0; dt < 4; ++dt) { u32x2 w; w.x = pk2(oacc[dt][qt][0] * inv, oacc[dt][qt][1] * inv); w.y = pk2(oacc[dt][qt][2] * inv, oacc[dt][qt][3] * inv);
                    *(u32x2*)(op + 16 * dt) = w; }
            }
        }
        __syncthreads();
    }
}

__device__ __forceinline__ void aux_phase(const Ctx& C, int mode, int layer) {
    int cb = 0, ce = 0, gw = 0, ngw = 1;
    if (mode == 0) {
        const int NGW = C.nblk * 8; gw = C.bid * 8 + C.wave; const int lane = C.lane;
        const float* x = C.in[0];
    for (int row0 = gw * 2; row0 < M; row0 += NGW * 2) {
        f32x4 v[2][4];
#pragma unroll
        for (int r = 0; r < 2; ++r)
#pragma unroll
            for (int j = 0; j < 4; ++j) v[r][j] = *((const f32x4*)(x + (size_t)(row0 + r) * DM) + lane + 64 * j);
#pragma unroll
        for (int r = 0; r < 2; ++r) {
            float s = 0.f;
#pragma unroll
            for (int j = 0; j < 4; ++j) s += (v[r][j][0] * v[r][j][0] + v[r][j][1] * v[r][j][1]) + (v[r][j][2] * v[r][j][2] + v[r][j][3] * v[r][j][3]);
            s = wave_sum(s, lane);
            u32x2* o = (u32x2*)(C.xb + (size_t)(row0 + r) * DM) + lane;
#pragma unroll
            for (int j = 0; j < 4; ++j) { u32x2 w; w.x = pk2(v[r][j][0], v[r][j][1]); w.y = pk2(v[r][j][2], v[r][j][3]); o[64 * j] = w; }
            if (lane < 16) C.ssq[(size_t)(row0 + r) * 16 + lane] = (lane == 0) ? s : 0.f;
        }
    }

        cb = 0; ce = P0_FIRST; ngw = NGW;
    } else if (C.tid < 256) {
        for (int gt = C.bid * 256 + C.tid; gt < 65536; gt += C.nblk * 256) {
            const int b = gt >> 15, e2 = gt & 32767, h = __builtin_amdgcn_readfirstlane(e2 >> 12);
            const unsigned* p = (const unsigned*)C.states + (size_t)b * 128 * 32768 + e2;
            unsigned* q = (unsigned*)C.states + (size_t)b * 128 * 32768 + e2;
            const float* cd = C.cdecay + __builtin_amdgcn_readfirstlane(b) * 128 * 8 + h;
            float s0 = 0.f, s1 = 0.f;
#pragma unroll 1
            for (int c0 = 0; c0 < 128; c0 += 16) {
                unsigned u[16];
#pragma unroll
                for (int i = 0; i < 16; ++i) u[i] = p[(size_t)(c0 + i) * 32768];
#pragma unroll
                for (int i = 0; i < 16; ++i) { const float d = cd[(c0 + i) * 8]; q[(size_t)(c0 + i) * 32768] = pk2(s0, s1); s0 = s0 * d + bflo(u[i]); s1 = s1 * d + bfhi(u[i]); }
            }
        }
    } else { cb = layer == 0 ? P0_FIRST : P0_SPLIT; ce = layer == 0 ? P0_SPLIT : P0_ALL; gw = C.bid * 4 + (C.wave - 4); ngw = C.nblk * 4; }
    if (ce > cb) p0_convert(C, cb, ce, gw, ngw, (LAS float*)(C.lds + C.wave * 8448), C.lane);
}

__device__ __forceinline__ void mix3_phase(const Ctx& C, int layer) {
    LAS float* sDT = (LAS float*)(C.lds); LAS float* sACS = (LAS float*)(C.lds + 2048); LAS float* sPART = (LAS float*)(C.lds + 4096);
    LAS bf16* sC = (LAS bf16*)(C.lds + 8192);
    LAS bf16* sB = (LAS bf16*)(C.lds + 41984);
    LAS float* sCB = (LAS float*)(C.lds + 41984);
    LAS bf16* sXT = (LAS bf16*)(C.lds + 75776);
    for (int ck = ((C.nblk & 7) == 0 ? (C.bid & 7) * (C.nblk >> 3) + (C.bid >> 3) : C.bid); ck < NCHUNK; ck += C.nblk) {
        int tid = C.tid; asm volatile("" : "+v"(tid));
        const int lane = tid & 63, wave = __builtin_amdgcn_readfirstlane(tid >> 6), fr = lane & 15, fq = lane >> 4;
        const int cin = ck & 127, t0 = ck * 64; const bool first = (cin == 0);
        const float* cw = launder(C.in[4]) + (size_t)layer * 4 * 1024; const float* cb = launder(C.in[5]) + layer * 1024;
        ssd_dt_acs(C, layer, ck, sDT, sACS, sPART, false, lane, wave);
        {
            const int ch0 = 2 * tid;
            const f32x2 w0 = *(const f32x2*)(cw + 0 * 1024 + ch0), w1 = *(const f32x2*)(cw + 1 * 1024 + ch0), w2 = *(const f32x2*)(cw + 2 * 1024 + ch0), w3 = *(const f32x2*)(cw + 3 * 1024 + ch0);
            const f32x2 bb = *(const f32x2*)(cb + ch0);
            const unsigned* src = (const unsigned*)(C.proj + (size_t)t0 * NPROJ + PJ_XBC + ch0);
            f32x2 xm3 = {0.f, 0.f}, xm2 = {0.f, 0.f}, xm1 = {0.f, 0.f};
            if (!first) { const unsigned a = src[-3 * (NPROJ / 2)], b = src[-2 * (NPROJ / 2)], c = src[-1 * (NPROJ / 2)];
                xm3 = (f32x2){bflo(a), bfhi(a)}; xm2 = (f32x2){bflo(b), bfhi(b)}; xm1 = (f32x2){bflo(c), bfhi(c)}; }
            LAS bf16* nat = (ch0 < 768) ? (sB + (ch0 - 512)) : (sC + (ch0 - 768));
#pragma unroll 1
            for (int l0 = 0; l0 < 64; l0 += 16) {
            unsigned uu[16];
#pragma unroll
            for (int i = 0; i < 16; ++i) uu[i] = src[(l0 + i) * (NPROJ / 2)];
#pragma unroll
            for (int li = 0; li < 16; li += 2) {
                const int l = l0 + li;
                const unsigned ua = uu[li], ub = uu[li + 1];
                const f32x2 xa = {bflo(ua), bfhi(ua)}, xc = {bflo(ub), bfhi(ub)};
                f32x2 ya = bb + w0 * xm3 + w1 * xm2 + w2 * xm1 + w3 * xa;
                f32x2 yb = bb + w0 * xm2 + w1 * xm1 + w2 * xa + w3 * xc;
                xm3 = xm1; xm2 = xa; xm1 = xc;
                ya.x = fsilu(ya.x); ya.y = fsilu(ya.y); yb.x = fsilu(yb.x); yb.y = fsilu(yb.y);
                if (ch0 < 512) {
                    *(LAS unsigned*)(sXT + ch0 * 72 + l) = pk2(ya.x, yb.x);
                    *(LAS unsigned*)(sXT + (ch0 + 1) * 72 + l) = pk2(ya.y, yb.y);
                } else {
                    *(LAS unsigned*)(nat + l * 264) = pk2(ya.x, ya.y);
                    *(LAS unsigned*)(nat + (l + 1) * 264) = pk2(yb.x, yb.y);
                }
            }
            }
        }
        __syncthreads();
        {
            const int g = wave >> 2, lt = wave & 3;
            f32x4 acc[4];
#pragma unroll
            for (int st = 0; st < 4; ++st) acc[st] = (f32x4){0.f, 0.f, 0.f, 0.f};
#pragma unroll
            for (int ks = 0; ks < 4; ++ks) {
                const bf16x8 af = *(const LAS bf16x8*)(sC + (16 * lt + fr) * 264 + g * 128 + 32 * ks + 8 * fq);
#pragma unroll
                for (int st = 0; st < 4; ++st) { const bf16x8 bfr = *(const LAS bf16x8*)(sB + (16 * st + fr) * 264 + g * 128 + 32 * ks + 8 * fq); acc[st] = mfma16(af, bfr, acc[st]); }
            }
            __syncthreads();
#pragma unroll
            for (int st = 0; st < 4; ++st)
#pragma unroll
                for (int e = 0; e < 4; ++e) sCB[(g * 64 + 16 * lt + 4 * fq + e) * 66 + 16 * st + fr] = acc[st][e];
        }
        __syncthreads();
        {
            const int h = wave, g = h >> 2;
            f32x4 acc[4][4];
#pragma unroll
            for (int lt = 0; lt < 4; ++lt)
#pragma unroll
                for (int pt = 0; pt < 4; ++pt) acc[lt][pt] = (f32x4){0.f, 0.f, 0.f, 0.f};
            const bf16* prev = C.states + (size_t)(ck * 8 + h) * 64 * 128;
#pragma unroll
            for (int ks = 0; ks < 4; ++ks) {
                bf16x8 cf[4];
#pragma unroll
                for (int lt = 0; lt < 4; ++lt) cf[lt] = *(const LAS bf16x8*)(sC + (16 * lt + fr) * 264 + g * 128 + 32 * ks + 8 * fq);
#pragma unroll
                for (int pt = 0; pt < 4; ++pt) {
                    const bf16x8 pfr = *(const bf16x8*)(prev + (16 * pt + fr) * 128 + 32 * ks + 8 * fq);
#pragma unroll
                    for (int lt = 0; lt < 4; ++lt) acc[lt][pt] = mfma16(pfr, cf[lt], acc[lt][pt]);
                }
                __builtin_amdgcn_sched_barrier(0);
            }
#pragma unroll
            for (int lt = 0; lt < 4; ++lt) {
                const float ea = fexp(sACS[h * 64 + 16 * lt + fr]);
#pragma unroll
                for (int pt = 0; pt < 4; ++pt) acc[lt][pt] = acc[lt][pt] * ea;
            }
#pragma unroll
            for (int ks2 = 0; ks2 < 2; ++ks2) {
                bf16x8 xf[4];
#pragma unroll
                for (int pt = 0; pt < 4; ++pt) xf[pt] = *(const LAS bf16x8*)(sXT + (h * 64 + 16 * pt + fr) * 72 + 32 * ks2 + 8 * fq);
                const f32x4 as0 = *(const LAS f32x4*)(sACS + h * 64 + 32 * ks2 + 8 * fq), as1 = *(const LAS f32x4*)(sACS + h * 64 + 32 * ks2 + 8 * fq + 4);
                const f32x4 dt0 = *(const LAS f32x4*)(sDT + h * 64 + 32 * ks2 + 8 * fq), dt1 = *(const LAS f32x4*)(sDT + h * 64 + 32 * ks2 + 8 * fq + 4);
#pragma unroll
                for (int lt = 0; lt < 4; ++lt) {
                    if (ks2 == 1 && lt < 2) continue;
                    const int l = 16 * lt + fr; const float al = sACS[h * 64 + l];
                    const LAS f32x2* cbp = (const LAS f32x2*)(sCB + (g * 64 + l) * 66 + 32 * ks2 + 8 * fq);
                    const f32x2 c01 = cbp[0], c23 = cbp[1], c45 = cbp[2], c67 = cbp[3];
                    const float cbv[8] = {c01.x, c01.y, c23.x, c23.y, c45.x, c45.y, c67.x, c67.y};
                    const float asv[8] = {as0[0], as0[1], as0[2], as0[3], as1[0], as1[1], as1[2], as1[3]};
                    const float dtv[8] = {dt0[0], dt0[1], dt0[2], dt0[3], dt1[0], dt1[1], dt1[2], dt1[3]};
                    float v[8];
#pragma unroll
                    for (int jj = 0; jj < 8; ++jj) { const int sidx = 32 * ks2 + 8 * fq + jj; const float t = cbv[jj] * fexp(al - asv[jj]) * dtv[jj]; v[jj] = (sidx <= l) ? t : 0.f; }
                    u32x4 w; w.x = pk2(v[0], v[1]); w.y = pk2(v[2], v[3]); w.z = pk2(v[4], v[5]); w.w = pk2(v[6], v[7]);
                    const bf16x8 af = __builtin_bit_cast(bf16x8, w);
#pragma unroll
                    for (int pt = 0; pt < 4; ++pt) acc[lt][pt] = mfma16(xf[pt], af, acc[lt][pt]);
                }
            }
            const float Dh = launder(C.in[8])[layer * 8 + h];
#pragma unroll
            for (int lt = 0; lt < 4; ++lt) {
                const int l = 16 * lt + fr; float q = 0.f;
#pragma unroll
                for (int pt = 0; pt < 4; ++pt) {
                    const int p0 = 16 * pt + 4 * fq;
                    const u32x2 zz = *(const u32x2*)(C.proj + (size_t)(t0 + l) * NPROJ + PJ_Z + h * 64 + p0);
                    const float zv[4] = {bflo(zz.x), bfhi(zz.x), bflo(zz.y), bfhi(zz.y)};
#pragma unroll
                    for (int e = 0; e < 4; ++e) {
                        const float xv = bf2f(sXT[(h * 64 + p0 + e) * 72 + l]);
                        const float y = (acc[lt][pt][e] + xv * Dh) * fsilu(zv[e]);
                        acc[lt][pt][e] = y; q += y * y;
                    }
                }
                q += shflx(q, 16, lane); q += shflx(q, 32, lane);
                if (fq == 0) sPART[h * 64 + l] = q;
            }
            __syncthreads();
            const float* ng = launder(C.in[9]) + layer * 512 + h * 64;
#pragma unroll
            for (int lt = 0; lt < 4; ++lt) {
                const int l = 16 * lt + fr;
                const float tot = (sPART[(4 * g) * 64 + l] + sPART[(4 * g + 1) * 64 + l]) + (sPART[(4 * g + 2) * 64 + l] + sPART[(4 * g + 3) * 64 + l]);
                const float rs = 1.0f / sqrtf(tot * (1.f / 256.f) + 1e-6f);
#pragma unroll
                for (int pt = 0; pt < 4; ++pt) {
                    const int p0 = 16 * pt + 4 * fq;
                    const f32x4 gg = *(const f32x4*)(ng + p0);
                    u32x2 w; w.x = pk2(acc[lt][pt][0] * rs * gg[0], acc[lt][pt][1] * rs * gg[1]); w.y = pk2(acc[lt][pt][2] * rs * gg[2], acc[lt][pt][3] * rs * gg[3]);
                    *(u32x2*)(C.mix + (size_t)(t0 + l) * DM + MX_B + h * 64 + p0) = w;
                }
            }
        }
        __syncthreads();
    }
}

__device__ __forceinline__ void final_phase(const Ctx& C) {
    const int gw = C.bid * 8 + C.wave, NGW = C.nblk * 8, lane = C.lane;
    f32x4 gg[2][2];
#pragma unroll
    for (int j = 0; j < 2; ++j) { gg[j][0] = *(const f32x4*)(C.in[19] + 512 * j + 8 * lane); gg[j][1] = *(const f32x4*)(C.in[19] + 512 * j + 8 * lane + 4); }
    for (int row0 = gw * 2; row0 < M; row0 += NGW * 2) {
        u32x4 v[2][2]; float rs[2];
#pragma unroll
        for (int r = 0; r < 2; ++r) {
            rs[r] = pg8::rstd_of(C.ssq, row0 + r);
#pragma unroll
            for (int j = 0; j < 2; ++j) v[r][j] = *(const u32x4*)(C.xb + (size_t)(row0 + r) * DM + 512 * j + 8 * lane);
        }
#pragma unroll
        for (int r = 0; r < 2; ++r)
#pragma unroll
            for (int j = 0; j < 2; ++j) {
                const u32x4 w = v[r][j];
                const f32x4 a = {bflo(w.x), bfhi(w.x), bflo(w.y), bfhi(w.y)}, b = {bflo(w.z), bfhi(w.z), bflo(w.w), bfhi(w.w)};
                float* o = C.out + (size_t)(row0 + r) * DM + 512 * j + 8 * lane;
                *(f32x4*)o = a * rs[r] * gg[j][0]; *(f32x4*)(o + 4) = b * rs[r] * gg[j][1];
            }
    }
}

#define XB_TMO      128
#define XB_XCNT(j)  (256  + 64 * (j))
#define XB_XSUB(j)  (1280 + 64 * (j))
#define XB_XGEN(j)  (2304 + 64 * (j))
#define XB_TOP      3328
#define XB_TOPGEN   3392
#define XCD_BAR_WORDS 3456
#define XB_SPIN_CAP (1u << 18)

__device__ __forceinline__ unsigned xb_ld(unsigned* p)              { return __hip_atomic_load(p, __ATOMIC_RELAXED, __HIP_MEMORY_SCOPE_AGENT); }
__device__ __forceinline__ unsigned xb_add(unsigned* p, unsigned v) { return __hip_atomic_fetch_add(p, v, __ATOMIC_RELAXED, __HIP_MEMORY_SCOPE_AGENT); }
__device__ __forceinline__ unsigned xb_xcc_id() { return (unsigned)__builtin_amdgcn_s_getreg((3 << 11) | 20) & 0xFu; }
#define XB_SPIN(cond, bar) do { unsigned _sp = 0; while (cond) { __builtin_amdgcn_s_sleep(1); \
    if ((++_sp & 255u) == 0u) { if (xb_ld(&(bar)[XB_TMO])) break; if (_sp > XB_SPIN_CAP) { atomicAdd(&(bar)[XB_TMO], 1u); break; } } } } while (0)

struct XcdBarrier {
    unsigned* bar; unsigned x;
    volatile LAS unsigned* st;
};

__device__ __forceinline__ XcdBarrier xcd_barrier_post(unsigned* bar, volatile LAS unsigned* st) {
    XcdBarrier b; b.bar = bar; b.x = xb_xcc_id(); b.st = st;
    if (threadIdx.x == 0) (void)xb_add(&bar[XB_XCNT(b.x)], 1u);
    return b;
}
__device__ __forceinline__ void xcd_barrier_complete(unsigned* bar, unsigned x, unsigned& nloc, unsigned& nx) {
    const unsigned G = gridDim.x * gridDim.y * gridDim.z;
    unsigned sum, cnt, mine, sp = 0u;
    for (;;) {
        sum = 0u; cnt = 0u; mine = 0u;
#pragma unroll
        for (unsigned j = 0; j < 16; ++j) { const unsigned c = xb_ld(&bar[XB_XCNT(j)]); sum += c; cnt += (c > 0u) ? 1u : 0u; mine = (j == x) ? c : mine; }
        if (sum == G) break;
        __builtin_amdgcn_s_sleep(1);
        if ((++sp & 255u) == 0u) { if (xb_ld(&bar[XB_TMO])) break; if (sp > XB_SPIN_CAP) { atomicAdd(&bar[XB_TMO], 1u); break; } }
    }
    nloc = mine > 0u ? mine : 1u; nx = cnt > 0u ? cnt : 1u;
}

__device__ __forceinline__ void xcd_barrier(const XcdBarrier& b) {
    asm volatile("s_waitcnt vmcnt(0)" ::: "memory");
    __syncthreads();
    if (threadIdx.x == 0) {
        unsigned* bar = b.bar;
        __builtin_amdgcn_s_waitcnt(0);
        unsigned nloc = b.st[0], nx = b.st[1];
        if (nloc == 0u) { xcd_barrier_complete(bar, b.x, nloc, nx); b.st[0] = nloc; b.st[1] = nx; }
        const unsigned old = xb_add(&bar[XB_XSUB(b.x)], 1u);
        const unsigned gen = old / nloc;
        if (old + 1u == (gen + 1u) * nloc) {
            __builtin_amdgcn_fence(__ATOMIC_RELEASE, "agent");
            asm volatile("s_waitcnt vmcnt(0)" ::: "memory");
            const unsigned og = xb_add(&bar[XB_TOP], 1u);
            const unsigned tg = og / nx;
            if (og + 1u == (tg + 1u) * nx) xb_add(&bar[XB_TOPGEN], 1u);
            else XB_SPIN(xb_ld(&bar[XB_TOPGEN]) == tg, bar);
            __builtin_amdgcn_fence(__ATOMIC_ACQUIRE, "agent");
            xb_add(&bar[XB_XGEN(b.x)], 1u);
            asm volatile("s_waitcnt vmcnt(0)" ::: "memory");
        } else {
            XB_SPIN(xb_ld(&bar[XB_XGEN(b.x)]) == gen, bar);
            __builtin_amdgcn_fence(__ATOMIC_ACQUIRE, "agent");
            asm volatile("s_waitcnt vmcnt(0)" ::: "memory");
        }
    }
    __syncthreads();
}

#ifndef PHMASK
#define PHMASK 0x1ff
#endif
#define PHEN(x) (((PHMASK) >> (x)) & 1)
#define CAS __attribute__((address_space(4)))
__device__ __forceinline__ Ctx make_ctx(const CAS Args* ap, LAS unsigned char* lds, int tidv, int bid, int nblk) {
    Ctx C; C.bid = bid; C.nblk = nblk;
    C.lds = lds; C.tid = tidv; C.lane = tidv & 63; C.wave = __builtin_amdgcn_readfirstlane(tidv >> 6);
#pragma unroll
    for (int i = 0; i < 20; ++i) C.in[i] = ap->in[i];
    C.out = ap->out;
    unsigned char* ws = ap->ws;
    C.Win = (bf16*)(ws + WS_WIN); C.Wout = (bf16*)(ws + WS_WOUT); C.Wgu = (bf16*)(ws + WS_WGU); C.Wdn = (bf16*)(ws + WS_WDN);
    C.xb = (bf16*)(ws + WS_XB); C.mix = (bf16*)(ws + WS_MIX); C.states = (bf16*)(ws + WS_ST); C.proj = (bf16*)(ws + WS_PROJ);
    C.ssq = (float*)(ws + WS_SSQ); C.dtraw = (float*)(ws + WS_DT); C.cdecay = (float*)(ws + WS_CD);
    return C;
}
__global__ void __launch_bounds__(512, 2) fwd_kernel(Args a_unused) {
    extern __shared__ __attribute__((aligned(16))) unsigned char lds_raw[];
    cg::grid_group grid = cg::this_grid();
    LAS unsigned char* lds = (LAS unsigned char*)lds_raw;
    const CAS Args* ap0 = (const CAS Args*)__builtin_amdgcn_kernarg_segment_ptr();
    const int ph_lo = ap0->ph_lo, ph_hi = ap0->ph_hi, coop = ap0->coop;
    volatile LAS unsigned* MISC = (volatile LAS unsigned*)(lds + LDS_BYTES - 64);
    if (threadIdx.x < 16) MISC[threadIdx.x] = 0u;
    __syncthreads();
    unsigned* barw = (unsigned*)(ap0->ws);
    XcdBarrier bar; bar.bar = barw; bar.x = 0; bar.st = MISC;
    if (coop) bar = xcd_barrier_post(barw, MISC);
    for (int ph = ph_lo; ph < ph_hi; ++ph) {
        const CAS Args* ap = ap0; asm volatile("" : "+s"(ap));
        int tidv = threadIdx.x; asm volatile("" : "+v"(tidv));
        int bid = blockIdx.x, nblk = gridDim.x; asm volatile("" : "+s"(bid), "+s"(nblk));
        if (ph == NPHASES - 1) { if (PHEN(8)) { const Ctx C = make_ctx(ap, lds, tidv, bid, nblk); final_phase(C); } }
        else {
            const int l = (ph == 0) ? 0 : (ph - 1) / 7, t = (ph == 0) ? 2 : (ph - 1) % 7;
            if (t == 0 || t >= 4) { if (PHEN(1)) {
                const Ctx C = make_ctx(ap, lds, tidv, bid, nblk);
                pg8::Gemm g; int N;
                pg8::EpiAny E; E.e0 = pg8::EpiInProj{C.proj, C.dtraw, (const LAS float*)(lds + 131072)}; E.e1 = pg8::EpiResid{(l == 0 && t == 4) ? C.in[0] : (const float*)nullptr, C.xb, C.ssq}; E.e2 = pg8::EpiGateUp{C.proj, (const LAS float*)(lds + 131072)};
                if (t == 0)      { g = pg8::Gemm{C.xb, C.Win + (size_t)l * 3072 * 1024, M, 3072, 1024}; N = 3072; E.mode = 0; }
                else if (t == 4) { g = pg8::Gemm{C.mix, C.Wout + (size_t)l * 1024 * 1024, M, 1024, 1024}; N = 1024; E.mode = 1; }
                else if (t == 5) { g = pg8::Gemm{C.xb, C.Wgu + (size_t)l * 5632 * 1024, M, 5632, 1024}; N = 5632; E.mode = 2; }
                else             { g = pg8::Gemm{C.proj, C.Wdn + (size_t)l * 1024 * 2816, M, 1024, 2816}; N = 1024; E.mode = 1; }
                pg8::StaticOrder S; S.init(M, N, nblk, bid);
                LAS float* rsl = (LAS float*)(lds + 131072);
                if (E.mode != 1) {
                    pg8::Unit uu;
                    for (int i = 0; i < 16 && S.next(i, uu); ++i) if (tidv < 256) rsl[i * 256 + tidv] = pg8::rstd_of(C.ssq, uu.pm * 256 + tidv);
                    __syncthreads();
                }
                pg8::gemm_phase<pg8::EpiAny, pg8::StaticOrder, true, true>(lds, g, S, E, tidv); }
            } else if (t == 1) { if (PHEN(2)) { const Ctx C = make_ctx(ap, lds, tidv, bid, nblk); mix1_phase(C, l); } }
            else if (t == 2) { if (PHEN(3)) { const Ctx C = make_ctx(ap, lds, tidv, bid, nblk); aux_phase(C, ph == 0 ? 0 : 1, l); } }
            else { if (PHEN(4)) { const Ctx C = make_ctx(ap, lds, tidv, bid, nblk); mix3_phase(C, l); } }
        }
        if (ph + 1 < ph_hi && coop) {
            if (coop == 2) grid.sync();
            xcd_barrier(bar);
        }
    }
}

#ifndef MK_MULTI
#define MK_MULTI 0
#endif
extern "C" void kernel_launch(void* const* d_in, const int* in_sizes, int n_in, void* d_out, int out_size, void* d_ws, size_t ws_size, hipStream_t stream) {
    static int grid = 0;
    if (grid == 0) {
        if (n_in != 20 || out_size != M * DM || ws_size < WS_END) { fprintf(stderr, "kernel_launch: unexpected shapes (n_in %d out %d ws %zu)\n", n_in, out_size, ws_size); grid = -1; return; }
        int dev = 0, cus = 0, per_cu = 0;
        hipGetDevice(&dev); hipDeviceGetAttribute(&cus, hipDeviceAttributeMultiprocessorCount, dev);
        if (hipFuncSetAttribute((const void*)fwd_kernel, hipFuncAttributeMaxDynamicSharedMemorySize, LDS_BYTES) != hipSuccess) { fprintf(stderr, "kernel_launch: hipFuncSetAttribute failed\n"); grid = -1; return; }
        if (hipOccupancyMaxActiveBlocksPerMultiprocessor(&per_cu, (const void*)fwd_kernel, 512, LDS_BYTES) != hipSuccess || per_cu < 1) { fprintf(stderr, "kernel_launch: occupancy query gave %d\n", per_cu); per_cu = 1; (void)hipGetLastError(); }
        grid = cus * per_cu; if (grid > 256) grid = 256;
    }
    if (grid < 0) return;
    Args a{};
    for (int i = 0; i < 20; ++i) a.in[i] = (const float*)d_in[i];
    a.out = (float*)d_out; a.ws = (unsigned char*)d_ws;
#if MK_MULTI
    a.coop = 0;
    for (int ph = 0; ph < NPHASES; ++ph) { a.ph_lo = ph; a.ph_hi = ph + 1; hipLaunchKernelGGL(fwd_kernel, dim3(grid), dim3(512), LDS_BYTES, stream, a); }
#else
    a.coop = 1; a.ph_lo = 0; a.ph_hi = NPHASES;
    if (hipMemsetAsync(d_ws, 0, 32768, stream) != hipSuccess) { fprintf(stderr, "kernel_launch: hipMemsetAsync failed\n"); return; }
    void* args[] = {&a};
    hipError_t e = hipLaunchCooperativeKernel((const void*)fwd_kernel, dim3(grid), dim3(512), args, LDS_BYTES, stream);
    if (e != hipSuccess) fprintf(stderr, "kernel_launch: cooperative launch failed: %s (grid %d)\n", hipGetErrorString(e), grid);
#endif
}
```

```cpp
#include <hip/hip_runtime.h>
#include <hip/hip_cooperative_groups.h>
#include <cstdio>
#include <cstdint>
namespace cg = cooperative_groups;
namespace pg8 {
#define PG8_LAS __attribute__((address_space(3)))
typedef unsigned short bf16_t;
typedef short bf16x8 __attribute__((ext_vector_type(8)));
typedef float f32x4 __attribute__((ext_vector_type(4)));
typedef unsigned u32x4 __attribute__((ext_vector_type(4)));
constexpr int BM = 256, BK = 64, HALF = 128, HTB = HALF * BK * 2  , STAGE_BYTES = 8 * HTB, NXCD = 8, WGM = 8;

__host__ __device__ __forceinline__ int lds_byte(int r, int c) { const int st = (r >> 4) * 2 + (c >> 5), rr = r & 15, cc = c & 31, ob = rr * 64 + cc * 2; return st * 1024 + (ob ^ (((ob >> 9) & 1) << 5)); }
__host__ __device__ __forceinline__ void stage_rc(int b, int& R, int& C) { const int st = b / 1024, sb = b % 1024, swz = sb ^ (((sb >> 9) & 1) << 5); R = (st >> 1) * 16 + swz / 64; C = (st & 1) * 32 + (swz % 64) / 2; }
__host__ __device__ __forceinline__ int perm32(int rho) { const int n = rho >> 4, i = rho & 15; return 8 * (i >> 2) + 4 * n + (i & 3); }

struct Unit { int pm, pn, idx; };
struct Gemm { const bf16_t* A; const bf16_t* Bt; int M, N, K; };

struct StaticOrder {
    int nM, nN, nwg, G, c;
    __host__ __device__ void init(int M, int N, int G_, int c_) { nM = M / BM; nN = N / BM; nwg = nM * nN; G = G_; c = c_; }
    __host__ __device__ bool next(int i, Unit& u) const {
        const long L = (long)i * G + c; if (L >= nwg) return false; u.idx = i;
        int wgid = (int)L; { const int q = nwg / NXCD, r = nwg % NXCD, xcd = wgid % NXCD, off = wgid / NXCD; wgid = (xcd < r ? xcd * (q + 1) : r * (q + 1) + (xcd - r) * q) + off; }
        const int nig = WGM * nN, gid = wgid / nig, fm = gid * WGM, gsz = (nM - fm) < WGM ? (nM - fm) : WGM;
        u.pm = fm + ((wgid % nig) % gsz); u.pn = (wgid % nig) / gsz; return true;
    }
    __device__ __forceinline__ void a_ready(const Unit&) const {}
    __device__ __forceinline__ void done(const Unit&) const {}
};

__device__ __forceinline__ unsigned cvt_pk_bf16(float lo, float hi) { unsigned r; asm volatile("v_cvt_pk_bf16_f32 %0, %1, %2" : "=v"(r) : "v"(lo), "v"(hi)); return r; }
__device__ __forceinline__ float shflx(float v, int mask, int lane) { return __int_as_float(__builtin_amdgcn_ds_bpermute((lane ^ mask) << 2, __float_as_int(v))); }
__device__ __forceinline__ float rstd_of(const float* ssq, int row) {
    const f32x4* p = (const f32x4*)(ssq + (size_t)row * 16);
    const f32x4 a = p[0], b = p[1], c = p[2], d = p[3];
    const float s = (((a[0] + a[1]) + (a[2] + a[3])) + ((b[0] + b[1]) + (b[2] + b[3]))) + (((c[0] + c[1]) + (c[2] + c[3])) + ((d[0] + d[1]) + (d[2] + d[3])));
    return __builtin_amdgcn_rsqf(s * (1.0f / 1024.0f) + 1e-6f);
}
__device__ __forceinline__ float silu_f(float x) { return x * __builtin_amdgcn_rcpf(1.0f + __builtin_amdgcn_exp2f(-1.4426950408889634f * x)); }
constexpr float QSCALE = 0.125f * 1.4426950408889634f;
struct EpiInProj {
    static constexpr bool PERM = true, AFTER_DRAIN = false;
    bf16_t* proj; float* dtraw; const PG8_LAS float* rsl;
    __device__ __forceinline__ void operator()(const f32x4 (&acc)[2][2][4][2], const Unit& u, int wr, int wc, int fr, int fq) const {
        const int row0 = u.pm * BM + wr * 64 + fr;
        const float sc = (u.pn == 0) ? QSCALE : 1.0f;
#pragma unroll
        for (int ai = 0; ai < 2; ++ai)
#pragma unroll
            for (int m = 0; m < 4; ++m) {
                const int row = row0 + ai * HALF + m * 16;
                const float rs = rsl[u.idx * 256 + (row & 255)] * sc;
                if (u.pn < 11) {
                    bf16_t* rowp = proj + (size_t)row * 2816 + u.pn * BM + wc * 32 + 8 * fq;
#pragma unroll
                    for (int bj = 0; bj < 2; ++bj) {
                        const f32x4 v0 = acc[ai][bj][m][0] * rs, v1 = acc[ai][bj][m][1] * rs;
                        u32x4 w; w.x = cvt_pk_bf16(v0[0], v0[1]); w.y = cvt_pk_bf16(v0[2], v0[3]); w.z = cvt_pk_bf16(v1[0], v1[1]); w.w = cvt_pk_bf16(v1[2], v1[3]);
                        *(u32x4*)(rowp + bj * HALF) = w;
                    }
                } else if (wc == 0 && fq == 0) {
                    *(f32x4*)(dtraw + (size_t)row * 8) = acc[ai][0][m][0] * rs;
                    *(f32x4*)(dtraw + (size_t)row * 8 + 4) = acc[ai][0][m][1] * rs;
                }
            }
    }
};
struct EpiResid {
    static constexpr bool PERM = true, AFTER_DRAIN = false;
    const float* base32; bf16_t* xb; float* ssq;
    __device__ __forceinline__ void operator()(const f32x4 (&acc)[2][2][4][2], const Unit& u, int wr, int wc, int fr, int fq) const {
        const int col0 = u.pn * BM + wc * 32 + 8 * fq, lane_ = fr + 16 * fq;
#pragma unroll
        for (int ai = 0; ai < 2; ++ai)
#pragma unroll
            for (int m = 0; m < 4; ++m) {
                const int row = u.pm * BM + ai * HALF + wr * 64 + m * 16 + fr;
                const size_t off = (size_t)row * 1024 + col0;
                float q = 0.f;
#pragma unroll
                for (int bj = 0; bj < 2; ++bj) {
                    const u32x4 r = *(const u32x4*)(xb + off + bj * HALF);
                    const f32x4 b0 = {__uint_as_float(r.x << 16), __uint_as_float(r.x & 0xffff0000u), __uint_as_float(r.y << 16), __uint_as_float(r.y & 0xffff0000u)};
                    const f32x4 b1 = {__uint_as_float(r.z << 16), __uint_as_float(r.z & 0xffff0000u), __uint_as_float(r.w << 16), __uint_as_float(r.w & 0xffff0000u)};
                    const f32x4 o0 = b0 + acc[ai][bj][m][0], o1 = b1 + acc[ai][bj][m][1];
                    q += ((o0[0] * o0[0] + o0[1] * o0[1]) + (o0[2] * o0[2] + o0[3] * o0[3])) + ((o1[0] * o1[0] + o1[1] * o1[1]) + (o1[2] * o1[2] + o1[3] * o1[3]));
                    u32x4 w; w.x = cvt_pk_bf16(o0[0], o0[1]); w.y = cvt_pk_bf16(o0[2], o0[3]); w.z = cvt_pk_bf16(o1[0], o1[1]); w.w = cvt_pk_bf16(o1[2], o1[3]);
                    *(u32x4*)(xb + off + bj * HALF) = w;
                }
                q += shflx(q, 16, lane_); q += shflx(q, 32, lane_);
                if (fq == 0) ssq[(size_t)row * 16 + u.pn * 4 + wc] = q;
            }
    }
};
typedef float f32x2v __attribute__((ext_vector_type(2)));
struct EpiGateUp {
    static constexpr bool PERM = true, AFTER_DRAIN = false;
    bf16_t* hdn; const PG8_LAS float* rsl;
    __device__ __forceinline__ void operator()(const f32x4 (&acc)[2][2][4][2], const Unit& u, int wr, int wc, int fr, int fq) const {
        const int row0 = u.pm * BM + wr * 64 + fr, col = u.pn * HALF + wc * 32 + 8 * fq;
#pragma unroll
        for (int ai = 0; ai < 2; ++ai)
#pragma unroll
            for (int m = 0; m < 4; ++m) {
                const int row = row0 + ai * HALF + m * 16;
                const float rs = rsl[u.idx * 256 + (row & 255)];
                const float rs2 = rs * rs, nrs = rs * -1.4426950408889634f;
                u32x4 w;
#pragma unroll
                for (int n = 0; n < 2; ++n)
#pragma unroll
                    for (int hh = 0; hh < 2; ++hh) {
                        const f32x2v g = {acc[ai][0][m][n][2 * hh], acc[ai][0][m][n][2 * hh + 1]}, uu = {acc[ai][1][m][n][2 * hh], acc[ai][1][m][n][2 * hh + 1]};
                        const f32x2v t = g * nrs; f32x2v e; e.x = __builtin_amdgcn_exp2f(t.x); e.y = __builtin_amdgcn_exp2f(t.y);
                        const f32x2v d = e + 1.0f; f32x2v r; r.x = __builtin_amdgcn_rcpf(d.x); r.y = __builtin_amdgcn_rcpf(d.y);
                        const f32x2v o = (g * uu) * (r * rs2);
                        w[2 * n + hh] = cvt_pk_bf16(o.x, o.y);
                    }
                *(u32x4*)(hdn + (size_t)row * 2816 + col) = w;
            }
    }
};

struct EpiAny {
    static constexpr bool PERM = true, AFTER_DRAIN = false;
    int mode; EpiInProj e0; EpiResid e1; EpiGateUp e2;
    __device__ __forceinline__ void operator()(const f32x4 (&acc)[2][2][4][2], const Unit& u, int wr, int wc, int fr, int fq) const {
        if (mode == 0) e0(acc, u, wr, wc, fr, fq); else if (mode == 1) e1(acc, u, wr, wc, fr, fq); else e2(acc, u, wr, wc, fr, fq);
    }
};
template <class Epi, class Sched, bool ALIGN_EPI = false, bool SP2 = false>
__device__ __forceinline__ void gemm_phase(PG8_LAS unsigned char* lds, const Gemm g, const Sched& S, const Epi& E, const int tid) {
    const int wid = __builtin_amdgcn_readfirstlane(tid >> 6), lane = tid & 63, wr = wid >> 2, wc = wid & 3, fr = lane & 15, fq = lane >> 4;
    const int K = g.K, nt = K / BK;
    unsigned voffA[2], voffB[2];
#pragma unroll
    for (int i = 0; i < 2; ++i) { int R, C; stage_rc(tid * 16 + i * 8192, R, C); const int Rb = Epi::PERM ? ((R & ~31) + perm32(R & 31)) : R;
        voffA[i] = (unsigned)(R * K + C) * 2u; voffB[i] = (unsigned)(Rb * K + C) * 2u; }
    const size_t kstep = (size_t)(BK * 2);
    const size_t hstep = (size_t)HALF * K * 2;
    const size_t tstep = 2 * hstep;
    const unsigned ldsw = (unsigned)wid * 1024u;
    const int aoff = lds_byte(wr * 64 + fr, fq * 8), boff = lds_byte(wc * 32 + fr, fq * 8);
#define PG8_SA(b, h) (((b) * 2 + (h)) * HTB)
#define PG8_SB(b, h) ((4 + (b) * 2 + (h)) * HTB)
#define PG8_STAGE(bufoff, gbase, voff) do { _Pragma("unroll") for (int _i = 0; _i < 2; ++_i) \
        __builtin_amdgcn_global_load_lds((const unsigned*)((const char*)(gbase) + (voff)[_i]), (PG8_LAS unsigned*)(lds + (bufoff) + ldsw + _i * 8192), 16, 0, 0); } while (0)
#define PG8_LDA(dst, b, h) do { _Pragma("unroll") for (int m = 0; m < 4; ++m) _Pragma("unroll") for (int k = 0; k < 2; ++k) dst[m][k] = *(const PG8_LAS bf16x8*)(lds + PG8_SA(b, h) + aoff + m * 2048 + k * 1024); } while (0)
#define PG8_LDB(dst, b, h) do { _Pragma("unroll") for (int n = 0; n < 2; ++n) _Pragma("unroll") for (int k = 0; k < 2; ++k) dst[n][k] = *(const PG8_LAS bf16x8*)(lds + PG8_SB(b, h) + boff + n * 2048 + k * 1024); } while (0)
#define PG8_MMA(ai, bj, At, Bt) do { __builtin_amdgcn_s_setprio(1); _Pragma("unroll") for (int m = 0; m < 4; ++m) _Pragma("unroll") for (int n = 0; n < 2; ++n) _Pragma("unroll") for (int k = 0; k < 2; ++k) \
        acc[ai][bj][m][n] = __builtin_amdgcn_mfma_f32_16x16x32_bf16(Bt[n][k], At[m][k], acc[ai][bj][m][n], 0, 0, 0); __builtin_amdgcn_s_setprio(0); } while (0)
#define PG8_WAIT_V(n) asm volatile("s_waitcnt vmcnt(" #n ")" ::: "memory")
#define PG8_WAIT_L(n) asm volatile("s_waitcnt lgkmcnt(" #n ")" ::: "memory")
#define PG8_BAR __builtin_amdgcn_s_barrier()
#define PG8_SCHED __builtin_amdgcn_sched_barrier(0)
    Unit cur, nxt; int ui = 0;
    if (!S.next(0, cur)) return;
    f32x4 acc[2][2][4][2];
#pragma unroll
    for (int a = 0; a < 2; ++a)
#pragma unroll
        for (int b = 0; b < 2; ++b)
#pragma unroll
            for (int m = 0; m < 4; ++m)
#pragma unroll
                for (int n = 0; n < 2; ++n) acc[a][b][m][n] = (f32x4){0.f, 0.f, 0.f, 0.f};
    bf16x8 At[4][2], B0[2][2], B1[2][2];
    const char* cA = (const char*)g.A + (size_t)cur.pm * tstep; const char* cB = (const char*)g.Bt + (size_t)cur.pn * tstep;
    S.a_ready(cur);
    if constexpr (SP2) {
        PG8_STAGE(PG8_SB(0, 0), cB, voffB); PG8_STAGE(PG8_SB(0, 1), cB + hstep, voffB); PG8_STAGE(PG8_SA(0, 0), cA, voffA); PG8_STAGE(PG8_SA(0, 1), cA + hstep, voffA);
        if (wr == 1) PG8_BAR;
        PG8_WAIT_V(2); PG8_BAR;
        PG8_STAGE(PG8_SB(1, 0), cB + kstep, voffB); PG8_STAGE(PG8_SA(1, 0), cA + kstep, voffA); PG8_STAGE(PG8_SB(1, 1), cB + hstep + kstep, voffB);
        PG8_WAIT_V(6); PG8_BAR;
    } else {
        PG8_STAGE(PG8_SB(0, 0), cB, voffB); PG8_STAGE(PG8_SA(0, 0), cA, voffA); PG8_STAGE(PG8_SB(0, 1), cB + hstep, voffB); PG8_STAGE(PG8_SA(0, 1), cA + hstep, voffA);
        if (wr == 1) PG8_BAR;
        PG8_WAIT_V(4); PG8_BAR;
        PG8_STAGE(PG8_SB(1, 0), cB + kstep, voffB); PG8_STAGE(PG8_SA(1, 0), cA + kstep, voffA); PG8_STAGE(PG8_SB(1, 1), cB + hstep + kstep, voffB);
        PG8_WAIT_V(6); PG8_BAR;
    }
    for (;;) {
        const bool has_next = S.next(ui + 1, nxt);
        const char* nA = has_next ? (const char*)g.A + (size_t)nxt.pm * tstep : cA; const char* nB = has_next ? (const char*)g.Bt + (size_t)nxt.pn * tstep : cB;
        for (int t = 0; t < nt; t += 2) {
            const bool last = (t == nt - 2);
            const char* a1 = cA + (size_t)(t + 1) * kstep;
            const char* a2 = last ? nA : cA + (size_t)(t + 2) * kstep; const char* b2 = last ? nB : cB + (size_t)(t + 2) * kstep;
            const char* a3 = a2 + kstep; const char* b3 = b2 + kstep;
            if (last && has_next) S.a_ready(nxt);
            if constexpr (SP2) {
            PG8_LDB(B0, 0, 0); PG8_LDB(B1, 0, 1); PG8_SCHED; PG8_LDA(At, 0, 0); PG8_STAGE(PG8_SA(1, 1), a1 + hstep, voffA);
            PG8_WAIT_V(8); PG8_WAIT_L(0); PG8_BAR; PG8_MMA(0, 0, At, B0); PG8_MMA(0, 1, At, B1); PG8_BAR; PG8_SCHED;
            PG8_LDA(At, 0, 1); PG8_STAGE(PG8_SB(0, 0), b2, voffB); PG8_STAGE(PG8_SB(0, 1), b2 + hstep, voffB); PG8_STAGE(PG8_SA(0, 0), a2, voffA);
            PG8_WAIT_V(8); PG8_WAIT_L(0); PG8_BAR; PG8_MMA(1, 0, At, B0); PG8_MMA(1, 1, At, B1); PG8_BAR; PG8_SCHED;
            PG8_LDB(B0, 1, 0); PG8_LDB(B1, 1, 1); PG8_SCHED; PG8_LDA(At, 1, 0); PG8_STAGE(PG8_SA(0, 1), a2 + hstep, voffA);
            PG8_WAIT_V(8); PG8_WAIT_L(0); PG8_BAR; PG8_MMA(0, 0, At, B0); PG8_MMA(0, 1, At, B1); PG8_BAR; PG8_SCHED;
            PG8_LDA(At, 1, 1); PG8_STAGE(PG8_SB(1, 0), b3, voffB); PG8_STAGE(PG8_SB(1, 1), b3 + hstep, voffB); PG8_STAGE(PG8_SA(1, 0), a3, voffA);
            PG8_WAIT_V(8); PG8_WAIT_L(0); PG8_BAR; PG8_MMA(1, 0, At, B0); PG8_MMA(1, 1, At, B1); PG8_BAR; PG8_SCHED;
            } else {
            PG8_LDB(B0, 0, 0); PG8_SCHED; PG8_LDA(At, 0, 0); PG8_STAGE(PG8_SA(1, 1), a1 + hstep, voffA);
            PG8_WAIT_L(8); PG8_BAR; PG8_WAIT_L(0); PG8_MMA(0, 0, At, B0); PG8_BAR; PG8_SCHED;
            PG8_LDB(B1, 0, 1); PG8_STAGE(PG8_SB(0, 0), b2, voffB);
            PG8_BAR; PG8_WAIT_L(0); PG8_MMA(0, 1, At, B1); PG8_BAR;
            PG8_LDA(At, 0, 1); PG8_STAGE(PG8_SA(0, 0), a2, voffA);
            PG8_BAR; PG8_WAIT_L(0); PG8_MMA(1, 0, At, B0); PG8_BAR; PG8_SCHED;
            PG8_STAGE(PG8_SB(0, 1), b2 + hstep, voffB);
            PG8_WAIT_V(6); PG8_BAR; PG8_MMA(1, 1, At, B1); PG8_BAR;
            PG8_LDB(B0, 1, 0); PG8_SCHED; PG8_LDA(At, 1, 0); PG8_STAGE(PG8_SA(0, 1), a2 + hstep, voffA);
            PG8_WAIT_L(8); PG8_BAR; PG8_WAIT_L(0); PG8_MMA(0, 0, At, B0); PG8_BAR; PG8_SCHED;
            PG8_LDB(B1, 1, 1); PG8_STAGE(PG8_SB(1, 0), b3, voffB);
            PG8_BAR; PG8_WAIT_L(0); PG8_MMA(0, 1, At, B1); PG8_BAR;
            PG8_LDA(At, 1, 1); PG8_STAGE(PG8_SA(1, 0), a3, voffA);
            PG8_BAR; PG8_WAIT_L(0); PG8_MMA(1, 0, At, B0); PG8_BAR; PG8_SCHED;
            PG8_STAGE(PG8_SB(1, 1), b3 + hstep, voffB);
            PG8_WAIT_V(6); PG8_BAR; PG8_MMA(1, 1, At, B1); PG8_BAR;
            }
        }
        if constexpr (ALIGN_EPI) { if (wr == 0) PG8_BAR; }
        if constexpr (!Epi::AFTER_DRAIN) { E(acc, cur, wr, wc, fr, fq); S.done(cur); }
        if (!has_next) break;
#pragma unroll
        for (int a = 0; a < 2; ++a)
#pragma unroll
            for (int b = 0; b < 2; ++b)
#pragma unroll
                for (int m = 0; m < 4; ++m)
#pragma unroll
                    for (int n = 0; n < 2; ++n) acc[a][b][m][n] = (f32x4){0.f, 0.f, 0.f, 0.f};
        cur = nxt; cA = nA; cB = nB; ++ui;
        if constexpr (ALIGN_EPI) { if (wr == 1) PG8_BAR; }
    }
    PG8_WAIT_V(0);
    if constexpr (!ALIGN_EPI) { if (wr == 0) PG8_BAR; }
    PG8_BAR;
    if constexpr (Epi::AFTER_DRAIN) { E.fused(acc, cur, wr, wc, fr, fq, lds, wid, lane); S.done(cur); }
#undef PG8_SA
#undef PG8_SB
#undef PG8_STAGE
#undef PG8_LDA
#undef PG8_LDB
#undef PG8_MMA
#undef PG8_WAIT_V
#undef PG8_WAIT_L
#undef PG8_BAR
#undef PG8_SCHED
}
}

#define LAS __attribute__((address_space(3)))
typedef unsigned short bf16;
typedef float f32x4 __attribute__((ext_vector_type(4)));
typedef float f32x2 __attribute__((ext_vector_type(2)));
typedef short bf16x8 __attribute__((ext_vector_type(8)));
typedef unsigned u32x4 __attribute__((ext_vector_type(4)));
typedef unsigned u32x2 __attribute__((ext_vector_type(2)));
typedef __bf16 bf16x2_t __attribute__((ext_vector_type(2)));
typedef short s16x4 __attribute__((ext_vector_type(4)));

constexpr int M = 16384, DM = 1024, NPROJ = 2816, NCHUNK = 256;
constexpr int PJ_Q = 0, PJ_K = 256, PJ_V = 512, PJ_Z = 768, PJ_XBC = 1280, PJ_GLU = 2304;
constexpr int MX_A = 0, MX_B = 256, MX_C = 768;
constexpr size_t MiB = 1u << 20;
constexpr size_t WS_SSQ = 1 * MiB, WS_DT = 2 * MiB, WS_CD = 2 * MiB + 512 * 1024, WS_WIN = 4 * MiB, WS_WOUT = 16 * MiB, WS_WGU = 20 * MiB, WS_WDN = 42 * MiB,
                 WS_XB = 54 * MiB, WS_MIX = 86 * MiB, WS_ST = 118 * MiB, WS_PROJ = 150 * MiB, WS_END = 238 * MiB;
constexpr int LDS_BYTES = 153600;
constexpr float LOG2E = 1.4426950408889634f;
constexpr int NPHASES = 16;

__device__ __forceinline__ float bflo(unsigned u) { return __uint_as_float(u << 16); }
__device__ __forceinline__ float bfhi(unsigned u) { return __uint_as_float(u & 0xffff0000u); }
__device__ __forceinline__ float bf2f(bf16 h) { return __uint_as_float((unsigned)h << 16); }
__device__ __forceinline__ unsigned pk2(float lo, float hi) { f32x2 v = {lo, hi}; bf16x2_t b = __builtin_convertvector(v, bf16x2_t); return __builtin_bit_cast(unsigned, b); }
__device__ __forceinline__ bf16 f2bf(float f) { return (bf16)(pk2(f, 0.f) & 0xffffu); }
__device__ __forceinline__ f32x4 mfma16(bf16x8 a, bf16x8 b, f32x4 c) { return __builtin_amdgcn_mfma_f32_16x16x32_bf16(a, b, c, 0, 0, 0); }
__device__ __forceinline__ float fsilu(float x) { return x * __builtin_amdgcn_rcpf(1.0f + __builtin_amdgcn_exp2f(-LOG2E * x)); }
__device__ __forceinline__ float fsigmoid(float x) { return __builtin_amdgcn_rcpf(1.0f + __builtin_amdgcn_exp2f(-LOG2E * x)); }
__device__ __forceinline__ float fexp(float x) { return __builtin_amdgcn_exp2f(LOG2E * x); }
using pg8::shflx;
__device__ __forceinline__ float wave_sum(float v, int lane) {
#pragma unroll
    for (int o = 1; o < 64; o <<= 1) v += shflx(v, o, lane);
    return v;
}

template <class T> __device__ __forceinline__ T* launder(T* p) { asm volatile("" : "+s"(p)); return p; }
struct Args { const float* in[20]; float* out; unsigned char* ws; int ph_lo, ph_hi, coop, pad; };
struct Ctx {
    LAS unsigned char* lds; int tid, lane, wave, bid, nblk;
    const float* in[20]; float* out;
    bf16 *Win, *Wout, *Wgu, *Wdn, *xb, *mix, *states, *proj;
    float *ssq, *dtraw, *cdecay;
};

struct P0Item { const float* W; const float* gain; bf16* WT; int nsrc, col, valid, K, drow, k0; };
__device__ __forceinline__ P0Item p0_decode(const Ctx& C, int it) {
    constexpr int I_IN = 16 * 96, I_OUT = 16 * 32, I_GU = 16 * 176, I_DN = 44 * 32, I_L = I_IN + I_OUT + I_GU + I_DN;
    P0Item P; const int l = it / I_L; int r = it % I_L;
    if (r < I_IN) {
        const int kb = r / 96, n0 = 32 * (r % 96);
        int col, valid;
        if (n0 < 2304) { col = n0; valid = 32; } else if (n0 < 2816) { col = n0 + 8; valid = 32; } else if (n0 == 2816) { col = 2304; valid = 8; } else { col = 0; valid = 0; }
        P.W = C.in[2] + (size_t)l * 1024 * 2824; P.nsrc = 2824; P.col = col; P.valid = valid; P.gain = C.in[1] + l * 1024; P.K = 1024; P.WT = C.Win + (size_t)l * 3072 * 1024; P.drow = n0; P.k0 = 64 * kb;
        return P;
    }
    r -= I_IN;
    if (r < I_OUT) { const int kb = r / 32, n0 = 32 * (r % 32);
        P.W = C.in[14] + (size_t)l * 1024 * 1024; P.nsrc = 1024; P.col = n0; P.valid = 32; P.gain = nullptr; P.K = 1024; P.WT = C.Wout + (size_t)l * 1024 * 1024; P.drow = n0; P.k0 = 64 * kb; return P; }
    r -= I_OUT;
    if (r < I_GU) { const int kb = r / 176, n0 = 32 * (r % 176); const int t = n0 >> 8, hs = (n0 >> 7) & 1, i = n0 & 127;
        P.W = (hs ? C.in[17] : C.in[16]) + (size_t)l * 1024 * 2816; P.nsrc = 2816; P.col = 128 * t + i; P.valid = 32; P.gain = C.in[15] + l * 1024; P.K = 1024; P.WT = C.Wgu + (size_t)l * 5632 * 1024; P.drow = n0; P.k0 = 64 * kb; return P; }
    r -= I_GU;
    { const int kb = r / 32, n0 = 32 * (r % 32);
        P.W = C.in[18] + (size_t)l * 2816 * 1024; P.nsrc = 1024; P.col = n0; P.valid = 32; P.gain = nullptr; P.K = 2816; P.WT = C.Wdn + (size_t)l * 1024 * 2816; P.drow = n0; P.k0 = 64 * kb; return P; }
}
__device__ __forceinline__ void p0_load(const P0Item& P, float (&wv)[32], int lane) {
    const int c31 = lane & 31;
#pragma unroll
    for (int i = 0; i < 32; ++i) { const int kk = 2 * i + (lane >> 5); wv[i] = (c31 < P.valid) ? __builtin_nontemporal_load(P.W + (size_t)(P.k0 + kk) * P.nsrc + P.col + c31) : 0.f; }
}
__device__ __forceinline__ void p0_finish(const P0Item& P, float (&wv)[32], LAS float* scr, int lane) {
    const int c31 = lane & 31;
    if (P.gain) {
#pragma unroll
        for (int i = 0; i < 32; ++i) wv[i] *= P.gain[P.k0 + 2 * i + (lane >> 5)];
    }
#pragma unroll
    for (int i = 0; i < 32; ++i) scr[(2 * i + (lane >> 5)) * 33 + c31] = wv[i];
    const int c = lane & 7;
#pragma unroll
    for (int j = 0; j < 4; ++j) {
        const int n = (lane >> 3) + 8 * j; const LAS float* s = scr + (8 * c) * 33 + n;
        u32x4 o; o.x = pk2(s[0 * 33], s[1 * 33]); o.y = pk2(s[2 * 33], s[3 * 33]); o.z = pk2(s[4 * 33], s[5 * 33]); o.w = pk2(s[6 * 33], s[7 * 33]);
        *(u32x4*)(P.WT + (size_t)(P.drow + n) * P.K + P.k0 + 8 * c) = o;
    }
}
__device__ __forceinline__ void p0_convert(const Ctx& C, int it_begin, int it_end, int gw, int NGW, LAS float* scr, int lane) {
#pragma unroll 1
    for (int it = it_begin + gw; it < it_end; it += NGW) {
        float wa[32];
        const P0Item pa = p0_decode(C, it);
        p0_load(pa, wa, lane);
        p0_finish(pa, wa, scr, lane);
    }
}
constexpr int P0_FIRST = 16 * 96;
constexpr int P0_SPLIT = (16 * 96 + 16 * 32 + 16 * 176 + 44 * 32) + 16 * 96;
constexpr int P0_ALL = 2 * (16 * 96 + 16 * 32 + 16 * 176 + 44 * 32);
#ifndef M1P
#define M1P 7
#endif
__device__ __forceinline__ void ssd_dt_acs(const Ctx& C, int layer, int ck, LAS float* sDT, LAS float* sACS, LAS float* sW, bool has_w, int lane, int wave) {
    const int h = wave, t0 = ck * 64;
    const float raw = C.dtraw[(size_t)(t0 + lane) * 8 + h] + C.in[6][layer * 8 + h];
    const float dt = fmaxf(raw, 0.f) + log1pf(expf(-fabsf(raw)));
    const float av = -expf(C.in[7][layer * 8 + h]) * dt;
    float cs = av;
#pragma unroll
    for (int o = 1; o < 64; o <<= 1) { const float v = __int_as_float(__builtin_amdgcn_ds_bpermute(((lane - o) & 63) << 2, __float_as_int(cs))); if (lane >= o) cs += v; }
    const float aend = __int_as_float(__builtin_amdgcn_readlane(__float_as_int(cs), 63));
    sDT[h * 64 + lane] = dt; sACS[h * 64 + lane] = cs;
    if (has_w) { sW[h * 64 + lane] = dt * expf(aend - cs); if (lane == 63) C.cdecay[ck * 8 + h] = expf(cs); }
}

__device__ __forceinline__ void mix1_phase(const Ctx& C, int layer) {
    LAS float* sDT = (LAS float*)(C.lds); LAS float* sACS = (LAS float*)(C.lds + 2048); LAS float* sW = (LAS float*)(C.lds + 4096);
    LAS bf16* sT = (LAS bf16*)(C.lds + 8192);
    LAS float* sBias = (LAS float*)(C.lds + 122880);
    for (int i = C.tid; i < 4 * 257; i += 512) sBias[i] = C.in[3][layer * 4 * 257 + i] * LOG2E;
    for (int ck = ((C.nblk & 7) == 0 ? (C.bid & 7) * (C.nblk >> 3) + (C.bid >> 3) : C.bid); ck < NCHUNK; ck += C.nblk) {
        int tid = C.tid; asm volatile("" : "+v"(tid));
        const int lane = tid & 63, wave = __builtin_amdgcn_readfirstlane(tid >> 6), fr = lane & 15, fq = lane >> 4;
        const int cin = ck & 127, t0 = ck * 64; const bool first = (cin == 0);
        const float* cw = launder(C.in[4]) + (size_t)layer * 4 * 1024; const float* cb = launder(C.in[5]) + layer * 1024;
        ssd_dt_acs(C, layer, ck, sDT, sACS, sW, true, lane, wave);
        __syncthreads();
        if (tid < 384) {
            const int ch0 = 2 * tid;
            const f32x2 w0 = *(const f32x2*)(cw + 0 * 1024 + ch0), w1 = *(const f32x2*)(cw + 1 * 1024 + ch0), w2 = *(const f32x2*)(cw + 2 * 1024 + ch0), w3 = *(const f32x2*)(cw + 3 * 1024 + ch0);
            const f32x2 bb = *(const f32x2*)(cb + ch0);
            const unsigned* src = (const unsigned*)(C.proj + (size_t)t0 * NPROJ + PJ_XBC + ch0);
            f32x2 xm3 = {0.f, 0.f}, xm2 = {0.f, 0.f}, xm1 = {0.f, 0.f};
            if (!first) { const unsigned a = src[-3 * (NPROJ / 2)], b = src[-2 * (NPROJ / 2)], c = src[-1 * (NPROJ / 2)];
                xm3 = (f32x2){bflo(a), bfhi(a)}; xm2 = (f32x2){bflo(b), bfhi(b)}; xm1 = (f32x2){bflo(c), bfhi(c)}; }
            const int hh = ch0 >> 6; const bool isx = ch0 < 512;
#pragma unroll 1
            for (int l0 = 0; l0 < 64; l0 += 16) {
            unsigned uu[16];
#pragma unroll
            for (int i = 0; i < 16; ++i) uu[i] = src[(l0 + i) * (NPROJ / 2)];
#pragma unroll
            for (int li = 0; li < 16; li += 2) {
                const int l = l0 + li;
                const unsigned ua = uu[li], ub = uu[li + 1];
                const f32x2 xa = {bflo(ua), bfhi(ua)}, xc = {bflo(ub), bfhi(ub)};
                f32x2 ya = bb + w0 * xm3 + w1 * xm2 + w2 * xm1 + w3 * xa;
                f32x2 yb = bb + w0 * xm2 + w1 * xm1 + w2 * xa + w3 * xc;
                xm3 = xm1; xm2 = xa; xm1 = xc;
                ya.x = fsilu(ya.x); ya.y = fsilu(ya.y); yb.x = fsilu(yb.x); yb.y = fsilu(yb.y);
                if (isx) { const float wa = sW[hh * 64 + l], wb = sW[hh * 64 + l + 1]; ya = ya * wa; yb = yb * wb; }
                *(LAS unsigned*)(sT + ch0 * 72 + l) = pk2(ya.x, yb.x);
                *(LAS unsigned*)(sT + (ch0 + 1) * 72 + l) = pk2(ya.y, yb.y);
            }
            }
        }
        __syncthreads();
        if (M1P & 1) {
            const int h = wave, g = h >> 2;
            bf16x8 xf[4][2];
#pragma unroll
            for (int pt = 0; pt < 4; ++pt)
#pragma unroll
                for (int ks = 0; ks < 2; ++ks) xf[pt][ks] = *(const LAS bf16x8*)(sT + (h * 64 + 16 * pt + fr) * 72 + 32 * ks + 8 * fq);
            bf16* st = C.states + (size_t)(ck * 8 + h) * 64 * 128;
#pragma unroll 1
            for (int nt = 0; nt < 8; ++nt) {
                bf16x8 bfr[2];
#pragma unroll
                for (int ks = 0; ks < 2; ++ks) bfr[ks] = *(const LAS bf16x8*)(sT + (512 + g * 128 + 16 * nt + fr) * 72 + 32 * ks + 8 * fq);
#pragma unroll
                for (int pt = 0; pt < 4; ++pt) {
                    f32x4 acc = {0.f, 0.f, 0.f, 0.f};
#pragma unroll
                    for (int ks = 0; ks < 2; ++ks) acc = mfma16(bfr[ks], xf[pt][ks], acc);
                    u32x2 w; w.x = pk2(acc[0], acc[1]); w.y = pk2(acc[2], acc[3]);
                    *(u32x2*)(st + (16 * pt + fr) * 128 + 16 * nt + 4 * fq) = w;
                }
            }
        }
        __syncthreads();
        if (M1P & 2) {
            LAS bf16* G = (LAS bf16*)(C.lds + 8192);
            LAS float* CO = (LAS float*)(C.lds + 8192 + 48128);
            const int c = tid & 255, half = tid >> 8;
#pragma unroll
            for (int it = 0; it < 6; ++it) {
                const int u = tid + 512 * it, r = u >> 5, c8 = u & 31;
                if (u < 94 * 32) {
                    u32x4 o = {0u, 0u, 0u, 0u};
                    if (!(first && r < 30)) {
                        const bf16* p = C.proj + (size_t)(t0 - 30 + r) * NPROJ + PJ_GLU + 8 * c8;
                        const u32x4 av = *(const u32x4*)p, gv = *(const u32x4*)(p + 256);
#pragma unroll
                        for (int e = 0; e < 4; ++e) o[e] = pk2(bflo(av[e]) * fsigmoid(bflo(gv[e])), bfhi(av[e]) * fsigmoid(bfhi(gv[e])));
                    }
                    *(LAS u32x4*)(G + r * 256 + 8 * c8) = o;
                }
            }
            __syncthreads();
            {
                const float* dww = launder(C.in[10]) + (size_t)layer * 31 * 256 + c;
                float w[31];
#pragma unroll
                for (int k = 0; k < 31; ++k) w[k] = dww[k * 256];
                const float bias = launder(C.in[11])[layer * 256 + c];
#pragma unroll 1
                for (int grp = 0; grp < 4; ++grp) {
                    float o[8];
#pragma unroll
                    for (int i = 0; i < 8; ++i) o[i] = bias;
                    const LAS bf16* gp = G + (half * 32 + grp * 8) * 256 + c;
#pragma unroll
                    for (int r = 0; r < 38; ++r) {
                        const float v = bf2f(gp[r * 256]);
#pragma unroll
                        for (int i = 0; i < 8; ++i) { const int k = r - i; if (k >= 0 && k <= 30) o[i] += w[k] * v; }
                    }
#pragma unroll
                    for (int i = 0; i < 8; ++i) CO[(half * 32 + grp * 8 + i) * 256 + c] = o[i];
                }
            }
            __syncthreads();
            {
                const f32x4 lg = *((const f32x4*)(launder(C.in[12]) + layer * 256) + lane), lb = *((const f32x4*)(launder(C.in[13]) + layer * 256) + lane);
#pragma unroll 2
                for (int i = 0; i < 8; ++i) {
                    const int l = wave * 8 + i;
                    const f32x4 v = *((const LAS f32x4*)(CO + l * 256) + lane);
                    const float s = wave_sum((v[0] + v[1]) + (v[2] + v[3]), lane);
                    const float mu = s * (1.f / 256.f);
                    const f32x4 d = v - mu;
                    const float s2 = wave_sum((d[0] * d[0] + d[1] * d[1]) + (d[2] * d[2] + d[3] * d[3]), lane);
                    const float rstd = 1.0f / sqrtf(s2 * (1.f / 256.f) + 1e-6f);
                    const f32x4 y = d * rstd * lg + lb;
                    u32x2 w; w.x = pk2(fsilu(y[0]), fsilu(y[1])); w.y = pk2(fsilu(y[2]), fsilu(y[3]));
                    *((u32x2*)(C.mix + (size_t)(t0 + l) * DM + MX_C) + lane) = w;
                }
            }
        }
        __syncthreads();
        if (M1P & 4) {
            LAS bf16* sK = (LAS bf16*)(C.lds + 8192);
            LAS bf16* sV = (LAS bf16*)(C.lds + 8192 + 33792);
            const int h = wave >> 1, qh = wave & 1, q4 = (lane & 15) >> 2, p4 = lane & 3;
            bf16x8 qf[2][2];
#pragma unroll
            for (int qt = 0; qt < 2; ++qt)
#pragma unroll
                for (int ks = 0; ks < 2; ++ks) qf[qt][ks] = *(const bf16x8*)(C.proj + (size_t)(t0 + 32 * qh + 16 * qt + fr) * NPROJ + PJ_Q + h * 64 + 32 * ks + 8 * fq);
            float mrun[2] = {-1e30f, -1e30f}, lsum[2] = {0.f, 0.f};
            f32x4 oacc[4][2];
#pragma unroll
            for (int dt = 0; dt < 4; ++dt)
#pragma unroll
                for (int qt = 0; qt < 2; ++qt) oacc[dt][qt] = (f32x4){0.f, 0.f, 0.f, 0.f};
            const int jmin = cin >= 8 ? 0 : 8 - cin;
            u32x4 kreg[4], vreg[4];
#define ATT_LOAD(jj) do { const bf16* base_ = C.proj + (size_t)(t0 + ((jj) - 8) * 64) * NPROJ; _Pragma("unroll") for (int i = 0; i < 4; ++i) { const int u = tid + 512 * i, row = u >> 5, c8 = u & 31; \
                kreg[i] = *(const u32x4*)(base_ + (size_t)row * NPROJ + PJ_K + 8 * c8); vreg[i] = *(const u32x4*)(base_ + (size_t)row * NPROJ + PJ_V + 8 * c8); } } while (0)
            ATT_LOAD(jmin);
            for (int j = jmin; j <= 8; ++j) {
#pragma unroll
                for (int i = 0; i < 4; ++i) { const int u = tid + 512 * i, row = u >> 5, c8 = u & 31;
                    *(LAS u32x4*)(sK + row * 264 + 8 * c8) = kreg[i]; *(LAS u32x4*)(sV + row * 264 + 8 * c8) = vreg[i]; }
                __syncthreads();
                if (j < 8) ATT_LOAD(j + 1);
                f32x4 st[4][2];
#pragma unroll
                for (int kt = 0; kt < 4; ++kt) {
                    bf16x8 kf[2];
#pragma unroll
                    for (int ks = 0; ks < 2; ++ks) kf[ks] = *(const LAS bf16x8*)(sK + (16 * kt + fr) * 264 + h * 64 + 32 * ks + 8 * fq);
#pragma unroll
                    for (int qt = 0; qt < 2; ++qt) { f32x4 acc = {0.f, 0.f, 0.f, 0.f};
#pragma unroll
                        for (int ks = 0; ks < 2; ++ks) acc = mfma16(kf[ks], qf[qt][ks], acc);
                        st[kt][qt] = acc; }
                }
                if (j >= 6) {
#pragma unroll
                    for (int kt = 0; kt < 4; ++kt)
#pragma unroll
                        for (int qt = 0; qt < 2; ++qt)
#pragma unroll
                            for (int e = 0; e < 4; ++e) {
                                const int rel = (32 * qh + 16 * qt + fr) + 512 - 64 * j - (16 * kt + 4 * fq + e);
                                const int idx = (rel < -128 ? -128 : (rel > 128 ? 128 : rel)) + 128;
                                st[kt][qt][e] += sBias[h * 257 + idx];
                            }
                } else {
                    const float bc = sBias[h * 257 + 256];
#pragma unroll
                    for (int kt = 0; kt < 4; ++kt)
#pragma unroll
                        for (int qt = 0; qt < 2; ++qt) st[kt][qt] = st[kt][qt] + bc;
                }
#pragma unroll
                for (int qt = 0; qt < 2; ++qt) {
                    float mx = -1e30f;
#pragma unroll
                    for (int kt = 0; kt < 4; ++kt)
#pragma unroll
                        for (int e = 0; e < 4; ++e) mx = fmaxf(mx, st[kt][qt][e]);
                    mx = fmaxf(mx, shflx(mx, 16, lane)); mx = fmaxf(mx, shflx(mx, 32, lane));
                    const float mnew = fmaxf(mrun[qt], mx), alpha = __builtin_amdgcn_exp2f(mrun[qt] - mnew);
                    mrun[qt] = mnew;
                    float ps = 0.f;
#pragma unroll
                    for (int kt = 0; kt < 4; ++kt)
#pragma unroll
                        for (int e = 0; e < 4; ++e) { const float p = __builtin_amdgcn_exp2f(st[kt][qt][e] - mnew); st[kt][qt][e] = p; ps += p; }
                    lsum[qt] = lsum[qt] * alpha + ps;
#pragma unroll
                    for (int dt = 0; dt < 4; ++dt) oacc[dt][qt] = oacc[dt][qt] * alpha;
                }
                bf16x8 pf[2][2];
#pragma unroll
                for (int s2 = 0; s2 < 2; ++s2)
#pragma unroll
                    for (int qt = 0; qt < 2; ++qt) {
                        u32x4 w; w.x = pk2(st[2 * s2][qt][0], st[2 * s2][qt][1]); w.y = pk2(st[2 * s2][qt][2], st[2 * s2][qt][3]);
                        w.z = pk2(st[2 * s2 + 1][qt][0], st[2 * s2 + 1][qt][1]); w.w = pk2(st[2 * s2 + 1][qt][2], st[2 * s2 + 1][qt][3]);
                        pf[s2][qt] = __builtin_bit_cast(bf16x8, w);
                    }
#pragma unroll
                for (int dt = 0; dt < 4; ++dt)
#pragma unroll
                    for (int s2 = 0; s2 < 2; ++s2) {
                        const s16x4 lo = __builtin_amdgcn_ds_read_tr16_b64_v4i16((LAS s16x4*)(sV + (32 * s2 + 4 * fq + q4) * 264 + h * 64 + 16 * dt + 4 * p4));
                        const s16x4 hi = __builtin_amdgcn_ds_read_tr16_b64_v4i16((LAS s16x4*)(sV + (32 * s2 + 16 + 4 * fq + q4) * 264 + h * 64 + 16 * dt + 4 * p4));
                        const bf16x8 vf = __builtin_shufflevector(lo, hi, 0, 1, 2, 3, 4, 5, 6, 7);
#pragma unroll
                        for (int qt = 0; qt < 2; ++qt) oacc[dt][qt] = mfma16(vf, pf[s2][qt], oacc[dt][qt]);
                    }
                __syncthreads();
            }
#undef ATT_LOAD
#pragma unroll
            for (int qt = 0; qt < 2; ++qt) {
                float l = lsum[qt]; l += shflx(l, 16, lane); l += shflx(l, 32, lane);
                const float inv = 1.0f / l;
                bf16* op = C.mix + (size_t)(t0 + 32 * qh + 16 * qt + fr) * DM + MX_A + h * 64 + 4 * fq;
#pragma unroll
                for (int dt = 0; dt < 4; ++dt) { u32x2 w; w.x = pk2(oacc[dt][qt][0] * inv, oacc[dt][qt][1] * inv); w.y = pk2(oacc[dt][qt][2] * inv, oacc[dt][qt][3] * inv);
                    *(u32x2*)(op + 16 * dt) = w; }
            }
        }
        __syncthreads();
    }
}

__device__ __forceinline__ void aux_phase(const Ctx& C, int mode, int layer) {
    int cb = 0, ce = 0, gw = 0, ngw = 1;
    if (mode == 0) {
        const int NGW = C.nblk * 8; gw = C.bid * 8 + C.wave; const int lane = C.lane;
        const float* x = C.in[0];
    for (int row0 = gw * 2; row0 < M; row0 += NGW * 2) {
        f32x4 v[2][4];
#pragma unroll
        for (int r = 0; r < 2; ++r)
#pragma unroll
            for (int j = 0; j < 4; ++j) v[r][j] = __builtin_nontemporal_load((const f32x4*)(x + (size_t)(row0 + r) * DM) + lane + 64 * j);
#pragma unroll
        for (int r = 0; r < 2; ++r) {
            float s = 0.f;
#pragma unroll
            for (int j = 0; j < 4; ++j) s += (v[r][j][0] * v[r][j][0] + v[r][j][1] * v[r][j][1]) + (v[r][j][2] * v[r][j][2] + v[r][j][3] * v[r][j][3]);
            s = wave_sum(s, lane);
            u32x2* o = (u32x2*)(C.xb + (size_t)(row0 + r) * DM) + lane;
#pragma unroll
            for (int j = 0; j < 4; ++j) { u32x2 w; w.x = pk2(v[r][j][0], v[r][j][1]); w.y = pk2(v[r][j][2], v[r][j][3]); o[64 * j] = w; }
            if (lane < 16) C.ssq[(size_t)(row0 + r) * 16 + lane] = (lane == 0) ? s : 0.f;
        }
    }

        cb = 0; ce = P0_FIRST; ngw = NGW;
    } else if (C.tid < 256) {
        for (int gt = C.bid * 256 + C.tid; gt < 65536; gt += C.nblk * 256) {
            const int b = gt >> 15, e2 = gt & 32767, h = __builtin_amdgcn_readfirstlane(e2 >> 12);
            const unsigned* p = (const unsigned*)C.states + (size_t)b * 128 * 32768 + e2;
            unsigned* q = (unsigned*)C.states + (size_t)b * 128 * 32768 + e2;
            const float* cd = C.cdecay + __builtin_amdgcn_readfirstlane(b) * 128 * 8 + h;
            float s0 = 0.f, s1 = 0.f;
#pragma unroll 1
            for (int c0 = 0; c0 < 128; c0 += 16) {
                unsigned u[16];
#pragma unroll
                for (int i = 0; i < 16; ++i) u[i] = __builtin_nontemporal_load(p + (size_t)(c0 + i) * 32768);
#pragma unroll
                for (int i = 0; i < 16; ++i) { const float d = cd[(c0 + i) * 8]; q[(size_t)(c0 + i) * 32768] = pk2(s0, s1); s0 = s0 * d + bflo(u[i]); s1 = s1 * d + bfhi(u[i]); }
            }
        }
    } else { cb = layer == 0 ? P0_FIRST : P0_SPLIT; ce = layer == 0 ? P0_SPLIT : P0_ALL; gw = C.bid * 4 + (C.wave - 4); ngw = C.nblk * 4; }
    if (ce > cb) p0_convert(C, cb, ce, gw, ngw, (LAS float*)(C.lds + C.wave * 8448), C.lane);
}

__device__ __forceinline__ void mix3_phase(const Ctx& C, int layer) {
    LAS float* sDT = (LAS float*)(C.lds); LAS float* sACS = (LAS float*)(C.lds + 2048); LAS float* sPART = (LAS float*)(C.lds + 4096);
    LAS bf16* sC = (LAS bf16*)(C.lds + 8192);
    LAS bf16* sB = (LAS bf16*)(C.lds + 41984);
    LAS float* sCB = (LAS float*)(C.lds + 41984);
    LAS bf16* sXT = (LAS bf16*)(C.lds + 75776);
    for (int ck = ((C.nblk & 7) == 0 ? (C.bid & 7) * (C.nblk >> 3) + (C.bid >> 3) : C.bid); ck < NCHUNK; ck += C.nblk) {
        int tid = C.tid; asm volatile("" : "+v"(tid));
        const int lane = tid & 63, wave = __builtin_amdgcn_readfirstlane(tid >> 6), fr = lane & 15, fq = lane >> 4;
        const int cin = ck & 127, t0 = ck * 64; const bool first = (cin == 0);
        const float* cw = launder(C.in[4]) + (size_t)layer * 4 * 1024; const float* cb = launder(C.in[5]) + layer * 1024;
        ssd_dt_acs(C, layer, ck, sDT, sACS, sPART, false, lane, wave);
        {
            const int ch0 = 2 * tid;
            const f32x2 w0 = *(const f32x2*)(cw + 0 * 1024 + ch0), w1 = *(const f32x2*)(cw + 1 * 1024 + ch0), w2 = *(const f32x2*)(cw + 2 * 1024 + ch0), w3 = *(const f32x2*)(cw + 3 * 1024 + ch0);
            const f32x2 bb = *(const f32x2*)(cb + ch0);
            const unsigned* src = (const unsigned*)(C.proj + (size_t)t0 * NPROJ + PJ_XBC + ch0);
            f32x2 xm3 = {0.f, 0.f}, xm2 = {0.f, 0.f}, xm1 = {0.f, 0.f};
            if (!first) { const unsigned a = src[-3 * (NPROJ / 2)], b = src[-2 * (NPROJ / 2)], c = src[-1 * (NPROJ / 2)];
                xm3 = (f32x2){bflo(a), bfhi(a)}; xm2 = (f32x2){bflo(b), bfhi(b)}; xm1 = (f32x2){bflo(c), bfhi(c)}; }
            LAS bf16* nat = (ch0 < 768) ? (sB + (ch0 - 512)) : (sC + (ch0 - 768));
#pragma unroll 1
            for (int l0 = 0; l0 < 64; l0 += 16) {
            unsigned uu[16];
#pragma unroll
            for (int i = 0; i < 16; ++i) uu[i] = src[(l0 + i) * (NPROJ / 2)];
#pragma unroll
            for (int li = 0; li < 16; li += 2) {
                const int l = l0 + li;
                const unsigned ua = uu[li], ub = uu[li + 1];
                const f32x2 xa = {bflo(ua), bfhi(ua)}, xc = {bflo(ub), bfhi(ub)};
                f32x2 ya = bb + w0 * xm3 + w1 * xm2 + w2 * xm1 + w3 * xa;
                f32x2 yb = bb + w0 * xm2 + w1 * xm1 + w2 * xa + w3 * xc;
                xm3 = xm1; xm2 = xa; xm1 = xc;
                ya.x = fsilu(ya.x); ya.y = fsilu(ya.y); yb.x = fsilu(yb.x); yb.y = fsilu(yb.y);
                if (ch0 < 512) {
                    *(LAS unsigned*)(sXT + ch0 * 72 + l) = pk2(ya.x, yb.x);
                    *(LAS unsigned*)(sXT + (ch0 + 1) * 72 + l) = pk2(ya.y, yb.y);
                } else {
                    *(LAS unsigned*)(nat + l * 264) = pk2(ya.x, ya.y);
                    *(LAS unsigned*)(nat + (l + 1) * 264) = pk2(yb.x, yb.y);
                }
            }
            }
        }
        __syncthreads();
        {
            const int g = wave >> 2, lt = wave & 3;
            f32x4 acc[4];
#pragma unroll
            for (int st = 0; st < 4; ++st) acc[st] = (f32x4){0.f, 0.f, 0.f, 0.f};
#pragma unroll
            for (int ks = 0; ks < 4; ++ks) {
                const bf16x8 af = *(const LAS bf16x8*)(sC + (16 * lt + fr) * 264 + g * 128 + 32 * ks + 8 * fq);
#pragma unroll
                for (int st = 0; st < 4; ++st) { const bf16x8 bfr = *(const LAS bf16x8*)(sB + (16 * st + fr) * 264 + g * 128 + 32 * ks + 8 * fq); acc[st] = mfma16(af, bfr, acc[st]); }
            }
            __syncthreads();
#pragma unroll
            for (int st = 0; st < 4; ++st)
#pragma unroll
                for (int e = 0; e < 4; ++e) sCB[(g * 64 + 16 * lt + 4 * fq + e) * 66 + 16 * st + fr] = acc[st][e];
        }
        __syncthreads();
        {
            const int h = wave, g = h >> 2;
            f32x4 acc[4][4];
#pragma unroll
            for (int lt = 0; lt < 4; ++lt)
#pragma unroll
                for (int pt = 0; pt < 4; ++pt) acc[lt][pt] = (f32x4){0.f, 0.f, 0.f, 0.f};
            const bf16* prev = C.states + (size_t)(ck * 8 + h) * 64 * 128;
#pragma unroll
            for (int ks = 0; ks < 4; ++ks) {
                bf16x8 cf[4];
#pragma unroll
                for (int lt = 0; lt < 4; ++lt) cf[lt] = *(const LAS bf16x8*)(sC + (16 * lt + fr) * 264 + g * 128 + 32 * ks + 8 * fq);
#pragma unroll
                for (int pt = 0; pt < 4; ++pt) {
                    const bf16x8 pfr = *(const bf16x8*)(prev + (16 * pt + fr) * 128 + 32 * ks + 8 * fq);
#pragma unroll
                    for (int lt = 0; lt < 4; ++lt) acc[lt][pt] = mfma16(pfr, cf[lt], acc[lt][pt]);
                }
                __builtin_amdgcn_sched_barrier(0);
            }
#pragma unroll
            for (int lt = 0; lt < 4; ++lt) {
                const float ea = fexp(sACS[h * 64 + 16 * lt + fr]);
#pragma unroll
                for (int pt = 0; pt < 4; ++pt) acc[lt][pt] = acc[lt][pt] * ea;
            }
#pragma unroll
            for (int ks2 = 0; ks2 < 2; ++ks2) {
                bf16x8 xf[4];
#pragma unroll
                for (int pt = 0; pt < 4; ++pt) xf[pt] = *(const LAS bf16x8*)(sXT + (h * 64 + 16 * pt + fr) * 72 + 32 * ks2 + 8 * fq);
                const f32x4 as0 = *(const LAS f32x4*)(sACS + h * 64 + 32 * ks2 + 8 * fq), as1 = *(const LAS f32x4*)(sACS + h * 64 + 32 * ks2 + 8 * fq + 4);
                const f32x4 dt0 = *(const LAS f32x4*)(sDT + h * 64 + 32 * ks2 + 8 * fq), dt1 = *(const LAS f32x4*)(sDT + h * 64 + 32 * ks2 + 8 * fq + 4);
#pragma unroll
                for (int lt = 0; lt < 4; ++lt) {
                    if (ks2 == 1 && lt < 2) continue;
                    const int l = 16 * lt + fr; const float al = sACS[h * 64 + l];
                    const LAS f32x2* cbp = (const LAS f32x2*)(sCB + (g * 64 + l) * 66 + 32 * ks2 + 8 * fq);
                    const f32x2 c01 = cbp[0], c23 = cbp[1], c45 = cbp[2], c67 = cbp[3];
                    const float cbv[8] = {c01.x, c01.y, c23.x, c23.y, c45.x, c45.y, c67.x, c67.y};
                    const float asv[8] = {as0[0], as0[1], as0[2], as0[3], as1[0], as1[1], as1[2], as1[3]};
                    const float dtv[8] = {dt0[0], dt0[1], dt0[2], dt0[3], dt1[0], dt1[1], dt1[2], dt1[3]};
                    float v[8];
#pragma unroll
                    for (int jj = 0; jj < 8; ++jj) { const int sidx = 32 * ks2 + 8 * fq + jj; const float t = cbv[jj] * fexp(al - asv[jj]) * dtv[jj]; v[jj] = (sidx <= l) ? t : 0.f; }
                    u32x4 w; w.x = pk2(v[0], v[1]); w.y = pk2(v[2], v[3]); w.z = pk2(v[4], v[5]); w.w = pk2(v[6], v[7]);
                    const bf16x8 af = __builtin_bit_cast(bf16x8, w);
#pragma unroll
                    for (int pt = 0; pt < 4; ++pt) acc[lt][pt] = mfma16(xf[pt], af, acc[lt][pt]);
                }
            }
            const float Dh = launder(C.in[8])[layer * 8 + h];
#pragma unroll
            for (int lt = 0; lt < 4; ++lt) {
                const int l = 16 * lt + fr; float q = 0.f;
#pragma unroll
                for (int pt = 0; pt < 4; ++pt) {
                    const int p0 = 16 * pt + 4 * fq;
                    const u32x2 zz = *(const u32x2*)(C.proj + (size_t)(t0 + l) * NPROJ + PJ_Z + h * 64 + p0);
                    const float zv[4] = {bflo(zz.x), bfhi(zz.x), bflo(zz.y), bfhi(zz.y)};
#pragma unroll
                    for (int e = 0; e < 4; ++e) {
                        const float xv = bf2f(sXT[(h * 64 + p0 + e) * 72 + l]);
                        const float y = (acc[lt][pt][e] + xv * Dh) * fsilu(zv[e]);
                        acc[lt][pt][e] = y; q += y * y;
                    }
                }
                q += shflx(q, 16, lane); q += shflx(q, 32, lane);
                if (fq == 0) sPART[h * 64 + l] = q;
            }
            __syncthreads();
            const float* ng = launder(C.in[9]) + layer * 512 + h * 64;
#pragma unroll
            for (int lt = 0; lt < 4; ++lt) {
                const int l = 16 * lt + fr;
                const float tot = (sPART[(4 * g) * 64 + l] + sPART[(4 * g + 1) * 64 + l]) + (sPART[(4 * g + 2) * 64 + l] + sPART[(4 * g + 3) * 64 + l]);
                const float rs = 1.0f / sqrtf(tot * (1.f / 256.f) + 1e-6f);
#pragma unroll
                for (int pt = 0; pt < 4; ++pt) {
                    const int p0 = 16 * pt + 4 * fq;
                    const f32x4 gg = *(const f32x4*)(ng + p0);
                    u32x2 w; w.x = pk2(acc[lt][pt][0] * rs * gg[0], acc[lt][pt][1] * rs * gg[1]); w.y = pk2(acc[lt][pt][2] * rs * gg[2], acc[lt][pt][3] * rs * gg[3]);
                    *(u32x2*)(C.mix + (size_t)(t0 + l) * DM + MX_B + h * 64 + p0) = w;
                }
            }
        }
        __syncthreads();
    }
}

__device__ __forceinline__ void final_phase(const Ctx& C) {
    const int gw = C.bid * 8 + C.wave, NGW = C.nblk * 8, lane = C.lane;
    f32x4 gg[2][2];
#pragma unroll
    for (int j = 0; j < 2; ++j) { gg[j][0] = *(const f32x4*)(C.in[19] + 512 * j + 8 * lane); gg[j][1] = *(const f32x4*)(C.in[19] + 512 * j + 8 * lane + 4); }
    for (int row0 = gw * 2; row0 < M; row0 += NGW * 2) {
        u32x4 v[2][2]; float rs[2];
#pragma unroll
        for (int r = 0; r < 2; ++r) {
            rs[r] = pg8::rstd_of(C.ssq, row0 + r);
#pragma unroll
            for (int j = 0; j < 2; ++j) v[r][j] = *(const u32x4*)(C.xb + (size_t)(row0 + r) * DM + 512 * j + 8 * lane);
        }
#pragma unroll
        for (int r = 0; r < 2; ++r)
#pragma unroll
            for (int j = 0; j < 2; ++j) {
                const u32x4 w = v[r][j];
                const f32x4 a = {bflo(w.x), bfhi(w.x), bflo(w.y), bfhi(w.y)}, b = {bflo(w.z), bfhi(w.z), bflo(w.w), bfhi(w.w)};
                float* o = C.out + (size_t)(row0 + r) * DM + 512 * j + 8 * lane;
                *(f32x4*)o = a * rs[r] * gg[j][0]; *(f32x4*)(o + 4) = b * rs[r] * gg[j][1];
            }
    }
}

#define XB_TMO      128
#define XB_XCNT(j)  (256  + 64 * (j))
#define XB_XSUB(j)  (1280 + 64 * (j))
#define XB_XGEN(j)  (2304 + 64 * (j))
#define XB_TOP      3328
#define XB_TOPGEN   3392
#define XCD_BAR_WORDS 3456
#define XB_SPIN_CAP (1u << 18)

__device__ __forceinline__ unsigned xb_ld(unsigned* p)              { return __hip_atomic_load(p, __ATOMIC_RELAXED, __HIP_MEMORY_SCOPE_AGENT); }
__device__ __forceinline__ unsigned xb_add(unsigned* p, unsigned v) { return __hip_atomic_fetch_add(p, v, __ATOMIC_RELAXED, __HIP_MEMORY_SCOPE_AGENT); }
__device__ __forceinline__ unsigned xb_xcc_id() { return (unsigned)__builtin_amdgcn_s_getreg((3 << 11) | 20) & 0xFu; }
#define XB_SPIN(cond, bar) do { unsigned _sp = 0; while (cond) { __builtin_amdgcn_s_sleep(1); \
    if ((++_sp & 255u) == 0u) { if (xb_ld(&(bar)[XB_TMO])) break; if (_sp > XB_SPIN_CAP) { atomicAdd(&(bar)[XB_TMO], 1u); break; } } } } while (0)

struct XcdBarrier {
    unsigned* bar; unsigned x;
    volatile LAS unsigned* st;
};

__device__ __forceinline__ XcdBarrier xcd_barrier_post(unsigned* bar, volatile LAS unsigned* st) {
    XcdBarrier b; b.bar = bar; b.x = xb_xcc_id(); b.st = st;
    if (threadIdx.x == 0) (void)xb_add(&bar[XB_XCNT(b.x)], 1u);
    return b;
}
__device__ __forceinline__ void xcd_barrier_complete(unsigned* bar, unsigned x, unsigned& nloc, unsigned& nx) {
    const unsigned G = gridDim.x * gridDim.y * gridDim.z;
    unsigned sum, cnt, mine, sp = 0u;
    for (;;) {
        sum = 0u; cnt = 0u; mine = 0u;
#pragma unroll
        for (unsigned j = 0; j < 16; ++j) { const unsigned c = xb_ld(&bar[XB_XCNT(j)]); sum += c; cnt += (c > 0u) ? 1u : 0u; mine = (j == x) ? c : mine; }
        if (sum == G) break;
        __builtin_amdgcn_s_sleep(1);
        if ((++sp & 255u) == 0u) { if (xb_ld(&bar[XB_TMO])) break; if (sp > XB_SPIN_CAP) { atomicAdd(&bar[XB_TMO], 1u); break; } }
    }
    nloc = mine > 0u ? mine : 1u; nx = cnt > 0u ? cnt : 1u;
}

__device__ __forceinline__ void xcd_barrier(const XcdBarrier& b) {
    asm volatile("s_waitcnt vmcnt(0)" ::: "memory");
    __syncthreads();
    if (threadIdx.x == 0) {
        unsigned* bar = b.bar;
        __builtin_amdgcn_s_waitcnt(0);
        unsigned nloc = b.st[0], nx = b.st[1];
        if (nloc == 0u) { xcd_barrier_complete(bar, b.x, nloc, nx); b.st[0] = nloc; b.st[1] = nx; }
        const unsigned old = xb_add(&bar[XB_XSUB(b.x)], 1u);
        const unsigned gen = old / nloc;
        if (old + 1u == (gen + 1u) * nloc) {
            __builtin_amdgcn_fence(__ATOMIC_RELEASE, "agent");
            asm volatile("s_waitcnt vmcnt(0)" ::: "memory");
            const unsigned og = xb_add(&bar[XB_TOP], 1u);
            const unsigned tg = og / nx;
            if (og + 1u == (tg + 1u) * nx) xb_add(&bar[XB_TOPGEN], 1u);
            else XB_SPIN(xb_ld(&bar[XB_TOPGEN]) == tg, bar);
            __builtin_amdgcn_fence(__ATOMIC_ACQUIRE, "agent");
            xb_add(&bar[XB_XGEN(b.x)], 1u);
            asm volatile("s_waitcnt vmcnt(0)" ::: "memory");
        } else {
            XB_SPIN(xb_ld(&bar[XB_XGEN(b.x)]) == gen, bar);
            __builtin_amdgcn_fence(__ATOMIC_ACQUIRE, "agent");
            asm volatile("s_waitcnt vmcnt(0)" ::: "memory");
        }
    }
    __syncthreads();
}

#ifndef PHMASK
#define PHMASK 0x1ff
#endif
#define PHEN(x) (((PHMASK) >> (x)) & 1)
#define CAS __attribute__((address_space(4)))
__device__ __forceinline__ Ctx make_ctx(const CAS Args* ap, LAS unsigned char* lds, int tidv, int bid, int nblk) {
    Ctx C; C.bid = bid; C.nblk = nblk;
    C.lds = lds; C.tid = tidv; C.lane = tidv & 63; C.wave = __builtin_amdgcn_readfirstlane(tidv >> 6);
#pragma unroll
    for (int i = 0; i < 20; ++i) C.in[i] = ap->in[i];
    C.out = ap->out;
    unsigned char* ws = ap->ws;
    C.Win = (bf16*)(ws + WS_WIN); C.Wout = (bf16*)(ws + WS_WOUT); C.Wgu = (bf16*)(ws + WS_WGU); C.Wdn = (bf16*)(ws + WS_WDN);
    C.xb = (bf16*)(ws + WS_XB); C.mix = (bf16*)(ws + WS_MIX); C.states = (bf16*)(ws + WS_ST); C.proj = (bf16*)(ws + WS_PROJ);
    C.ssq = (float*)(ws + WS_SSQ); C.dtraw = (float*)(ws + WS_DT); C.cdecay = (float*)(ws + WS_CD);
    return C;
}
__global__ void __launch_bounds__(512, 2) fwd_kernel(Args a_unused) {
    extern __shared__ __attribute__((aligned(16))) unsigned char lds_raw[];
    cg::grid_group grid = cg::this_grid();
    LAS unsigned char* lds = (LAS unsigned char*)lds_raw;
    const CAS Args* ap0 = (const CAS Args*)__builtin_amdgcn_kernarg_segment_ptr();
    const int ph_lo = ap0->ph_lo, ph_hi = ap0->ph_hi, coop = ap0->coop;
    volatile LAS unsigned* MISC = (volatile LAS unsigned*)(lds + LDS_BYTES - 64);
    if (threadIdx.x < 16) MISC[threadIdx.x] = 0u;
    __syncthreads();
    unsigned* barw = (unsigned*)(ap0->ws);
    XcdBarrier bar; bar.bar = barw; bar.x = 0; bar.st = MISC;
    if (coop) bar = xcd_barrier_post(barw, MISC);
    for (int ph = ph_lo; ph < ph_hi; ++ph) {
        const CAS Args* ap = ap0; asm volatile("" : "+s"(ap));
        int tidv = threadIdx.x; asm volatile("" : "+v"(tidv));
        int bid = blockIdx.x, nblk = gridDim.x; asm volatile("" : "+s"(bid), "+s"(nblk));
        if (ph == NPHASES - 1) { if (PHEN(8)) { const Ctx C = make_ctx(ap, lds, tidv, bid, nblk); final_phase(C); } }
        else {
            const int l = (ph == 0) ? 0 : (ph - 1) / 7, t = (ph == 0) ? 2 : (ph - 1) % 7;
            if (t == 0 || t >= 4) { if (PHEN(1)) {
                const Ctx C = make_ctx(ap, lds, tidv, bid, nblk);
                pg8::Gemm g; int N;
                pg8::EpiAny E; E.e0 = pg8::EpiInProj{C.proj, C.dtraw, (const LAS float*)(lds + 131072)}; E.e1 = pg8::EpiResid{(l == 0 && t == 4) ? C.in[0] : (const float*)nullptr, C.xb, C.ssq}; E.e2 = pg8::EpiGateUp{C.proj, (const LAS float*)(lds + 131072)};
                if (t == 0)      { g = pg8::Gemm{C.xb, C.Win + (size_t)l * 3072 * 1024, M, 3072, 1024}; N = 3072; E.mode = 0; }
                else if (t == 4) { g = pg8::Gemm{C.mix, C.Wout + (size_t)l * 1024 * 1024, M, 1024, 1024}; N = 1024; E.mode = 1; }
                else if (t == 5) { g = pg8::Gemm{C.xb, C.Wgu + (size_t)l * 5632 * 1024, M, 5632, 1024}; N = 5632; E.mode = 2; }
                else             { g = pg8::Gemm{C.proj, C.Wdn + (size_t)l * 1024 * 2816, M, 1024, 2816}; N = 1024; E.mode = 1; }
                pg8::StaticOrder S; S.init(M, N, nblk, bid);
                LAS float* rsl = (LAS float*)(lds + 131072);
                if (E.mode != 1) {
                    pg8::Unit uu;
                    for (int i = 0; i < 16 && S.next(i, uu); ++i) if (tidv < 256) rsl[i * 256 + tidv] = pg8::rstd_of(C.ssq, uu.pm * 256 + tidv);
                    __syncthreads();
                }
                pg8::gemm_phase<pg8::EpiAny, pg8::StaticOrder, true, true>(lds, g, S, E, tidv); }
            } else if (t == 1) { if (PHEN(2)) { const Ctx C = make_ctx(ap, lds, tidv, bid, nblk); mix1_phase(C, l); } }
            else if (t == 2) { if (PHEN(3)) { const Ctx C = make_ctx(ap, lds, tidv, bid, nblk); aux_phase(C, ph == 0 ? 0 : 1, l); } }
            else { if (PHEN(4)) { const Ctx C = make_ctx(ap, lds, tidv, bid, nblk); mix3_phase(C, l); } }
        }
        if (ph + 1 < ph_hi && coop) {
            if (coop == 2) grid.sync();
            xcd_barrier(bar);
        }
    }
}

#ifndef MK_MULTI
#define MK_MULTI 0
#endif
extern "C" void kernel_launch(void* const* d_in, const int* in_sizes, int n_in, void* d_out, int out_size, void* d_ws, size_t ws_size, hipStream_t stream) {
    static int grid = 0;
    if (grid == 0) {
        if (n_in != 20 || out_size != M * DM || ws_size < WS_END) { fprintf(stderr, "kernel_launch: unexpected shapes (n_in %d out %d ws %zu)\n", n_in, out_size, ws_size); grid = -1; return; }
        int dev = 0, cus = 0, per_cu = 0;
        hipGetDevice(&dev); hipDeviceGetAttribute(&cus, hipDeviceAttributeMultiprocessorCount, dev);
        if (hipFuncSetAttribute((const void*)fwd_kernel, hipFuncAttributeMaxDynamicSharedMemorySize, LDS_BYTES) != hipSuccess) { fprintf(stderr, "kernel_launch: hipFuncSetAttribute failed\n"); grid = -1; return; }
        if (hipOccupancyMaxActiveBlocksPerMultiprocessor(&per_cu, (const void*)fwd_kernel, 512, LDS_BYTES) != hipSuccess || per_cu < 1) { fprintf(stderr, "kernel_launch: occupancy query gave %d\n", per_cu); per_cu = 1; (void)hipGetLastError(); }
        grid = cus * per_cu; if (grid > 256) grid = 256;
    }
    if (grid < 0) return;
    Args a{};
    for (int i = 0; i < 20; ++i) a.in[i] = (const float*)d_in[i];
    a.out = (float*)d_out; a.ws = (unsigned char*)d_ws;
#if MK_MULTI
    a.coop = 0;
    for (int ph = 0; ph < NPHASES; ++ph) { a.ph_lo = ph; a.ph_hi = ph + 1; hipLaunchKernelGGL(fwd_kernel, dim3(grid), dim3(512), LDS_BYTES, stream, a); }
#else
    a.coop = 1; a.ph_lo = 0; a.ph_hi = NPHASES;
    if (hipMemsetAsync(d_ws, 0, 32768, stream) != hipSuccess) { fprintf(stderr, "kernel_launch: hipMemsetAsync failed\n"); return; }
    void* args[] = {&a};
    hipError_t e = hipLaunchCooperativeKernel((const void*)fwd_kernel, dim3(grid), dim3(512), args, LDS_BYTES, stream);
    if (e != hipSuccess) fprintf(stderr, "kernel_launch: cooperative launch failed: %s (grid %d)\n", hipGetErrorString(e), grid);
#endif
}
```

```cpp
#include <hip/hip_runtime.h>
#include <hip/hip_cooperative_groups.h>
#include <cstdio>
#include <cstdint>
namespace cg = cooperative_groups;
namespace pg8 {
#define PG8_LAS __attribute__((address_space(3)))
typedef unsigned short bf16_t;
typedef short bf16x8 __attribute__((ext_vector_type(8)));
typedef float f32x4 __attribute__((ext_vector_type(4)));
typedef unsigned u32x4 __attribute__((ext_vector_type(4)));
constexpr int BM = 256, BK = 64, HALF = 128, HTB = HALF * BK * 2  , STAGE_BYTES = 8 * HTB, NXCD = 8, WGM = 8;

__host__ __device__ __forceinline__ int lds_byte(int r, int c) { const int st = (r >> 4) * 2 + (c >> 5), rr = r & 15, cc = c & 31, ob = rr * 64 + cc * 2; return st * 1024 + (ob ^ (((ob >> 9) & 1) << 5)); }
__host__ __device__ __forceinline__ void stage_rc(int b, int& R, int& C) { const int st = b / 1024, sb = b % 1024, swz = sb ^ (((sb >> 9) & 1) << 5); R = (st >> 1) * 16 + swz / 64; C = (st & 1) * 32 + (swz % 64) / 2; }
__host__ __device__ __forceinline__ int perm32(int rho) { const int n = rho >> 4, i = rho & 15; return 8 * (i >> 2) + 4 * n + (i & 3); }

struct Unit { int pm, pn, idx; };
struct Gemm { const bf16_t* A; const bf16_t* Bt; int M, N, K; };

struct StaticOrder {
    int nM, nN, nwg, G, c;
    __host__ __device__ void init(int M, int N, int G_, int c_) { nM = M / BM; nN = N / BM; nwg = nM * nN; G = G_; c = c_; }
    __host__ __device__ bool next(int i, Unit& u) const {
        const long L = (long)i * G + c; if (L >= nwg) return false; u.idx = i;
        int wgid = (int)L; { const int q = nwg / NXCD, r = nwg % NXCD, xcd = wgid % NXCD, off = wgid / NXCD; wgid = (xcd < r ? xcd * (q + 1) : r * (q + 1) + (xcd - r) * q) + off; }
        const int nig = WGM * nN, gid = wgid / nig, fm = gid * WGM, gsz = (nM - fm) < WGM ? (nM - fm) : WGM;
        u.pm = fm + ((wgid % nig) % gsz); u.pn = (wgid % nig) / gsz; return true;
    }
    __device__ __forceinline__ void a_ready(const Unit&) const {}
    __device__ __forceinline__ void done(const Unit&) const {}
};

__device__ __forceinline__ unsigned cvt_pk_bf16(float lo, float hi) { unsigned r; asm volatile("v_cvt_pk_bf16_f32 %0, %1, %2" : "=v"(r) : "v"(lo), "v"(hi)); return r; }
__device__ __forceinline__ float shflx(float v, int mask, int lane) { return __int_as_float(__builtin_amdgcn_ds_bpermute((lane ^ mask) << 2, __float_as_int(v))); }
__device__ __forceinline__ float rstd_of(const float* ssq, int row) {
    const f32x4* p = (const f32x4*)(ssq + (size_t)row * 16);
    const f32x4 a = p[0], b = p[1], c = p[2], d = p[3];
    const float s = (((a[0] + a[1]) + (a[2] + a[3])) + ((b[0] + b[1]) + (b[2] + b[3]))) + (((c[0] + c[1]) + (c[2] + c[3])) + ((d[0] + d[1]) + (d[2] + d[3])));
    return __builtin_amdgcn_rsqf(s * (1.0f / 1024.0f) + 1e-6f);
}
__device__ __forceinline__ float silu_f(float x) { return x * __builtin_amdgcn_rcpf(1.0f + __builtin_amdgcn_exp2f(-1.4426950408889634f * x)); }
constexpr float QSCALE = 0.125f * 1.4426950408889634f;
struct EpiInProj {
    static constexpr bool PERM = true, AFTER_DRAIN = false;
    bf16_t* proj; float* dtraw; const PG8_LAS float* rsl;
    __device__ __forceinline__ void operator()(const f32x4 (&acc)[2][2][4][2], const Unit& u, int wr, int wc, int fr, int fq) const {
        const int row0 = u.pm * BM + wr * 64 + fr;
        const float sc = (u.pn == 0) ? QSCALE : 1.0f;
#pragma unroll
        for (int ai = 0; ai < 2; ++ai)
#pragma unroll
            for (int m = 0; m < 4; ++m) {
                const int row = row0 + ai * HALF + m * 16;
                const float rs = rsl[u.idx * 256 + (row & 255)] * sc;
                if (u.pn < 11) {
                    bf16_t* rowp = proj + (size_t)row * 2816 + u.pn * BM + wc * 32 + 8 * fq;
#pragma unroll
                    for (int bj = 0; bj < 2; ++bj) {
                        const f32x4 v0 = acc[ai][bj][m][0] * rs, v1 = acc[ai][bj][m][1] * rs;
                        u32x4 w; w.x = cvt_pk_bf16(v0[0], v0[1]); w.y = cvt_pk_bf16(v0[2], v0[3]); w.z = cvt_pk_bf16(v1[0], v1[1]); w.w = cvt_pk_bf16(v1[2], v1[3]);
                        *(u32x4*)(rowp + bj * HALF) = w;
                    }
                } else if (wc == 0 && fq == 0) {
                    *(f32x4*)(dtraw + (size_t)row * 8) = acc[ai][0][m][0] * rs;
                    *(f32x4*)(dtraw + (size_t)row * 8 + 4) = acc[ai][0][m][1] * rs;
                }
            }
    }
};
struct EpiResid {
    static constexpr bool PERM = true, AFTER_DRAIN = false;
    const float* base32; bf16_t* xb; float* ssq;
    __device__ __forceinline__ void operator()(const f32x4 (&acc)[2][2][4][2], const Unit& u, int wr, int wc, int fr, int fq) const {
        const int col0 = u.pn * BM + wc * 32 + 8 * fq, lane_ = fr + 16 * fq;
#pragma unroll
        for (int ai = 0; ai < 2; ++ai)
#pragma unroll
            for (int m = 0; m < 4; ++m) {
                const int row = u.pm * BM + ai * HALF + wr * 64 + m * 16 + fr;
                const size_t off = (size_t)row * 1024 + col0;
                float q = 0.f;
#pragma unroll
                for (int bj = 0; bj < 2; ++bj) {
                    const u32x4 r = *(const u32x4*)(xb + off + bj * HALF);
                    const f32x4 b0 = {__uint_as_float(r.x << 16), __uint_as_float(r.x & 0xffff0000u), __uint_as_float(r.y << 16), __uint_as_float(r.y & 0xffff0000u)};
                    const f32x4 b1 = {__uint_as_float(r.z << 16), __uint_as_float(r.z & 0xffff0000u), __uint_as_float(r.w << 16), __uint_as_float(r.w & 0xffff0000u)};
                    const f32x4 o0 = b0 + acc[ai][bj][m][0], o1 = b1 + acc[ai][bj][m][1];
                    q += ((o0[0] * o0[0] + o0[1] * o0[1]) + (o0[2] * o0[2] + o0[3] * o0[3])) + ((o1[0] * o1[0] + o1[1] * o1[1]) + (o1[2] * o1[2] + o1[3] * o1[3]));
                    u32x4 w; w.x = cvt_pk_bf16(o0[0], o0[1]); w.y = cvt_pk_bf16(o0[2], o0[3]); w.z = cvt_pk_bf16(o1[0], o1[1]); w.w = cvt_pk_bf16(o1[2], o1[3]);
                    *(u32x4*)(xb + off + bj * HALF) = w;
                }
                q += shflx(q, 16, lane_); q += shflx(q, 32, lane_);
                if (fq == 0) ssq[(size_t)row * 16 + u.pn * 4 + wc] = q;
            }
    }
};
typedef float f32x2v __attribute__((ext_vector_type(2)));
struct EpiGateUp {
    static constexpr bool PERM = true, AFTER_DRAIN = false;
    bf16_t* hdn; const PG8_LAS float* rsl;
    __device__ __forceinline__ void operator()(const f32x4 (&acc)[2][2][4][2], const Unit& u, int wr, int wc, int fr, int fq) const {
        const int row0 = u.pm * BM + wr * 64 + fr, col = u.pn * HALF + wc * 32 + 8 * fq;
#pragma unroll
        for (int ai = 0; ai < 2; ++ai)
#pragma unroll
            for (int m = 0; m < 4; ++m) {
                const int row = row0 + ai * HALF + m * 16;
                const float rs = rsl[u.idx * 256 + (row & 255)];
                const float rs2 = rs * rs, nrs = rs * -1.4426950408889634f;
                u32x4 w;
#pragma unroll
                for (int n = 0; n < 2; ++n)
#pragma unroll
                    for (int hh = 0; hh < 2; ++hh) {
                        const f32x2v g = {acc[ai][0][m][n][2 * hh], acc[ai][0][m][n][2 * hh + 1]}, uu = {acc[ai][1][m][n][2 * hh], acc[ai][1][m][n][2 * hh + 1]};
                        const f32x2v t = g * nrs; f32x2v e; e.x = __builtin_amdgcn_exp2f(t.x); e.y = __builtin_amdgcn_exp2f(t.y);
                        const f32x2v d = e + 1.0f; f32x2v r; r.x = __builtin_amdgcn_rcpf(d.x); r.y = __builtin_amdgcn_rcpf(d.y);
                        const f32x2v o = (g * uu) * (r * rs2);
                        w[2 * n + hh] = cvt_pk_bf16(o.x, o.y);
                    }
                *(u32x4*)(hdn + (size_t)row * 2816 + col) = w;
            }
    }
};

struct EpiAny {
    static constexpr bool PERM = true, AFTER_DRAIN = false;
    int mode; EpiInProj e0; EpiResid e1; EpiGateUp e2;
    __device__ __forceinline__ void operator()(const f32x4 (&acc)[2][2][4][2], const Unit& u, int wr, int wc, int fr, int fq) const {
        if (mode == 0) e0(acc, u, wr, wc, fr, fq); else if (mode == 1) e1(acc, u, wr, wc, fr, fq); else e2(acc, u, wr, wc, fr, fq);
    }
};
template <class Epi, class Sched, bool ALIGN_EPI = false, bool SP2 = false>
__device__ __forceinline__ void gemm_phase(PG8_LAS unsigned char* lds, const Gemm g, const Sched& S, const Epi& E, const int tid) {
    const int wid = __builtin_amdgcn_readfirstlane(tid >> 6), lane = tid & 63, wr = wid >> 2, wc = wid & 3, fr = lane & 15, fq = lane >> 4;
    const int K = g.K, nt = K / BK;
    unsigned voffA[2], voffB[2];
#pragma unroll
    for (int i = 0; i < 2; ++i) { int R, C; stage_rc(tid * 16 + i * 8192, R, C); const int Rb = Epi::PERM ? ((R & ~31) + perm32(R & 31)) : R;
        voffA[i] = (unsigned)(R * K + C) * 2u; voffB[i] = (unsigned)(Rb * K + C) * 2u; }
    const size_t kstep = (size_t)(BK * 2);
    const size_t hstep = (size_t)HALF * K * 2;
    const size_t tstep = 2 * hstep;
    const unsigned ldsw = (unsigned)wid * 1024u;
    const int aoff = lds_byte(wr * 64 + fr, fq * 8), boff = lds_byte(wc * 32 + fr, fq * 8);
#define PG8_SA(b, h) (((b) * 2 + (h)) * HTB)
#define PG8_SB(b, h) ((4 + (b) * 2 + (h)) * HTB)
#define PG8_STAGE(bufoff, gbase, voff) do { _Pragma("unroll") for (int _i = 0; _i < 2; ++_i) \
        __builtin_amdgcn_global_load_lds((const unsigned*)((const char*)(gbase) + (voff)[_i]), (PG8_LAS unsigned*)(lds + (bufoff) + ldsw + _i * 8192), 16, 0, 0); } while (0)
#define PG8_LDA(dst, b, h) do { _Pragma("unroll") for (int m = 0; m < 4; ++m) _Pragma("unroll") for (int k = 0; k < 2; ++k) dst[m][k] = *(const PG8_LAS bf16x8*)(lds + PG8_SA(b, h) + aoff + m * 2048 + k * 1024); } while (0)
#define PG8_LDB(dst, b, h) do { _Pragma("unroll") for (int n = 0; n < 2; ++n) _Pragma("unroll") for (int k = 0; k < 2; ++k) dst[n][k] = *(const PG8_LAS bf16x8*)(lds + PG8_SB(b, h) + boff + n * 2048 + k * 1024); } while (0)
#define PG8_MMA(ai, bj, At, Bt) do { __builtin_amdgcn_s_setprio(1); _Pragma("unroll") for (int m = 0; m < 4; ++m) _Pragma("unroll") for (int n = 0; n < 2; ++n) _Pragma("unroll") for (int k = 0; k < 2; ++k) \
        acc[ai][bj][m][n] = __builtin_amdgcn_mfma_f32_16x16x32_bf16(Bt[n][k], At[m][k], acc[ai][bj][m][n], 0, 0, 0); __builtin_amdgcn_s_setprio(0); } while (0)
#define PG8_WAIT_V(n) asm volatile("s_waitcnt vmcnt(" #n ")" ::: "memory")
#define PG8_WAIT_L(n) asm volatile("s_waitcnt lgkmcnt(" #n ")" ::: "memory")
#define PG8_BAR __builtin_amdgcn_s_barrier()
#define PG8_SCHED __builtin_amdgcn_sched_barrier(0)
    Unit cur, nxt; int ui = 0;
    if (!S.next(0, cur)) return;
    f32x4 acc[2][2][4][2];
#pragma unroll
    for (int a = 0; a < 2; ++a)
#pragma unroll
        for (int b = 0; b < 2; ++b)
#pragma unroll
            for (int m = 0; m < 4; ++m)
#pragma unroll
                for (int n = 0; n < 2; ++n) acc[a][b][m][n] = (f32x4){0.f, 0.f, 0.f, 0.f};
    bf16x8 At[4][2], B0[2][2], B1[2][2];
    const char* cA = (const char*)g.A + (size_t)cur.pm * tstep; const char* cB = (const char*)g.Bt + (size_t)cur.pn * tstep;
    S.a_ready(cur);
    if constexpr (SP2) {
        PG8_STAGE(PG8_SB(0, 0), cB, voffB); PG8_STAGE(PG8_SB(0, 1), cB + hstep, voffB); PG8_STAGE(PG8_SA(0, 0), cA, voffA); PG8_STAGE(PG8_SA(0, 1), cA + hstep, voffA);
        if (wr == 1) PG8_BAR;
        PG8_WAIT_V(2); PG8_BAR;
        PG8_STAGE(PG8_SB(1, 0), cB + kstep, voffB); PG8_STAGE(PG8_SA(1, 0), cA + kstep, voffA); PG8_STAGE(PG8_SB(1, 1), cB + hstep + kstep, voffB);
        PG8_WAIT_V(6); PG8_BAR;
    } else {
        PG8_STAGE(PG8_SB(0, 0), cB, voffB); PG8_STAGE(PG8_SA(0, 0), cA, voffA); PG8_STAGE(PG8_SB(0, 1), cB + hstep, voffB); PG8_STAGE(PG8_SA(0, 1), cA + hstep, voffA);
        if (wr == 1) PG8_BAR;
        PG8_WAIT_V(4); PG8_BAR;
        PG8_STAGE(PG8_SB(1, 0), cB + kstep, voffB); PG8_STAGE(PG8_SA(1, 0), cA + kstep, voffA); PG8_STAGE(PG8_SB(1, 1), cB + hstep + kstep, voffB);
        PG8_WAIT_V(6); PG8_BAR;
    }
    for (;;) {
        const bool has_next = S.next(ui + 1, nxt);
        const char* nA = has_next ? (const char*)g.A + (size_t)nxt.pm * tstep : cA; const char* nB = has_next ? (const char*)g.Bt + (size_t)nxt.pn * tstep : cB;
        for (int t = 0; t < nt; t += 2) {
            const bool last = (t == nt - 2);
            const char* a1 = cA + (size_t)(t + 1) * kstep;
            const char* a2 = last ? nA : cA + (size_t)(t + 2) * kstep; const char* b2 = last ? nB : cB + (size_t)(t + 2) * kstep;
            const char* a3 = a2 + kstep; const char* b3 = b2 + kstep;
            if (last && has_next) S.a_ready(nxt);
            if constexpr (SP2) {
            PG8_LDB(B0, 0, 0); PG8_LDB(B1, 0, 1); PG8_SCHED; PG8_LDA(At, 0, 0); PG8_STAGE(PG8_SA(1, 1), a1 + hstep, voffA);
            PG8_WAIT_V(8); PG8_WAIT_L(0); PG8_BAR; PG8_MMA(0, 0, At, B0); PG8_MMA(0, 1, At, B1); PG8_BAR; PG8_SCHED;
            PG8_LDA(At, 0, 1); PG8_STAGE(PG8_SB(0, 0), b2, voffB); PG8_STAGE(PG8_SB(0, 1), b2 + hstep, voffB); PG8_STAGE(PG8_SA(0, 0), a2, voffA);
            PG8_WAIT_V(8); PG8_WAIT_L(0); PG8_BAR; PG8_MMA(1, 0, At, B0); PG8_MMA(1, 1, At, B1); PG8_BAR; PG8_SCHED;
            PG8_LDB(B0, 1, 0); PG8_LDB(B1, 1, 1); PG8_SCHED; PG8_LDA(At, 1, 0); PG8_STAGE(PG8_SA(0, 1), a2 + hstep, voffA);
            PG8_WAIT_V(8); PG8_WAIT_L(0); PG8_BAR; PG8_MMA(0, 0, At, B0); PG8_MMA(0, 1, At, B1); PG8_BAR; PG8_SCHED;
            PG8_LDA(At, 1, 1); PG8_STAGE(PG8_SB(1, 0), b3, voffB); PG8_STAGE(PG8_SB(1, 1), b3 + hstep, voffB); PG8_STAGE(PG8_SA(1, 0), a3, voffA);
            PG8_WAIT_V(8); PG8_WAIT_L(0); PG8_BAR; PG8_MMA(1, 0, At, B0); PG8_MMA(1, 1, At, B1); PG8_BAR; PG8_SCHED;
            } else {
            PG8_LDB(B0, 0, 0); PG8_SCHED; PG8_LDA(At, 0, 0); PG8_STAGE(PG8_SA(1, 1), a1 + hstep, voffA);
            PG8_WAIT_L(8); PG8_BAR; PG8_WAIT_L(0); PG8_MMA(0, 0, At, B0); PG8_BAR; PG8_SCHED;
            PG8_LDB(B1, 0, 1); PG8_STAGE(PG8_SB(0, 0), b2, voffB);
            PG8_BAR; PG8_WAIT_L(0); PG8_MMA(0, 1, At, B1); PG8_BAR;
            PG8_LDA(At, 0, 1); PG8_STAGE(PG8_SA(0, 0), a2, voffA);
            PG8_BAR; PG8_WAIT_L(0); PG8_MMA(1, 0, At, B0); PG8_BAR; PG8_SCHED;
            PG8_STAGE(PG8_SB(0, 1), b2 + hstep, voffB);
            PG8_WAIT_V(6); PG8_BAR; PG8_MMA(1, 1, At, B1); PG8_BAR;
            PG8_LDB(B0, 1, 0); PG8_SCHED; PG8_LDA(At, 1, 0); PG8_STAGE(PG8_SA(0, 1), a2 + hstep, voffA);
            PG8_WAIT_L(8); PG8_BAR; PG8_WAIT_L(0); PG8_MMA(0, 0, At, B0); PG8_BAR; PG8_SCHED;
            PG8_LDB(B1, 1, 1); PG8_STAGE(PG8_SB(1, 0), b3, voffB);
            PG8_BAR; PG8_WAIT_L(0); PG8_MMA(0, 1, At, B1); PG8_BAR;
            PG8_LDA(At, 1, 1); PG8_STAGE(PG8_SA(1, 0), a3, voffA);
            PG8_BAR; PG8_WAIT_L(0); PG8_MMA(1, 0, At, B0); PG8_BAR; PG8_SCHED;
            PG8_STAGE(PG8_SB(1, 1), b3 + hstep, voffB);
            PG8_WAIT_V(6); PG8_BAR; PG8_MMA(1, 1, At, B1); PG8_BAR;
            }
        }
        if constexpr (ALIGN_EPI) { if (wr == 0) PG8_BAR; }
        if constexpr (!Epi::AFTER_DRAIN) { E(acc, cur, wr, wc, fr, fq); S.done(cur); }
        if (!has_next) break;
#pragma unroll
        for (int a = 0; a < 2; ++a)
#pragma unroll
            for (int b = 0; b < 2; ++b)
#pragma unroll
                for (int m = 0; m < 4; ++m)
#pragma unroll
                    for (int n = 0; n < 2; ++n) acc[a][b][m][n] = (f32x4){0.f, 0.f, 0.f, 0.f};
        cur = nxt; cA = nA; cB = nB; ++ui;
        if constexpr (ALIGN_EPI) { if (wr == 1) PG8_BAR; }
    }
    PG8_WAIT_V(0);
    if constexpr (!ALIGN_EPI) { if (wr == 0) PG8_BAR; }
    PG8_BAR;
    if constexpr (Epi::AFTER_DRAIN) { E.fused(acc, cur, wr, wc, fr, fq, lds, wid, lane); S.done(cur); }
#undef PG8_SA
#undef PG8_SB
#undef PG8_STAGE
#undef PG8_LDA
#undef PG8_LDB
#undef PG8_MMA
#undef PG8_WAIT_V
#undef PG8_WAIT_L
#undef PG8_BAR
#undef PG8_SCHED
}
}

#define LAS __attribute__((address_space(3)))
typedef unsigned short bf16;
typedef float f32x4 __attribute__((ext_vector_type(4)));
typedef float f32x2 __attribute__((ext_vector_type(2)));
typedef short bf16x8 __attribute__((ext_vector_type(8)));
typedef unsigned u32x4 __attribute__((ext_vector_type(4)));
typedef unsigned u32x2 __attribute__((ext_vector_type(2)));
typedef __bf16 bf16x2_t __attribute__((ext_vector_type(2)));
typedef short s16x4 __attribute__((ext_vector_type(4)));

constexpr int M = 16384, DM = 1024, NPROJ = 2816, NCHUNK = 256;
constexpr int PJ_Q = 0, PJ_K = 256, PJ_V = 512, PJ_Z = 768, PJ_XBC = 1280, PJ_GLU = 2304;
constexpr int MX_A = 0, MX_B = 256, MX_C = 768;
constexpr size_t MiB = 1u << 20;
constexpr size_t WS_SSQ = 1 * MiB, WS_DT = 2 * MiB, WS_CD = 2 * MiB + 512 * 1024, WS_WIN = 4 * MiB, WS_WOUT = 16 * MiB, WS_WGU = 20 * MiB, WS_WDN = 42 * MiB,
                 WS_XB = 54 * MiB, WS_MIX = 86 * MiB, WS_ST = 118 * MiB, WS_PROJ = 150 * MiB, WS_END = 238 * MiB;
constexpr int LDS_BYTES = 153600;
constexpr float LOG2E = 1.4426950408889634f;
constexpr int NPHASES = 16;

__device__ __forceinline__ float bflo(unsigned u) { return __uint_as_float(u << 16); }
__device__ __forceinline__ float bfhi(unsigned u) { return __uint_as_float(u & 0xffff0000u); }
__device__ __forceinline__ float bf2f(bf16 h) { return __uint_as_float((unsigned)h << 16); }
__device__ __forceinline__ unsigned pk2(float lo, float hi) { f32x2 v = {lo, hi}; bf16x2_t b = __builtin_convertvector(v, bf16x2_t); return __builtin_bit_cast(unsigned, b); }
__device__ __forceinline__ bf16 f2bf(float f) { return (bf16)(pk2(f, 0.f) & 0xffffu); }
__device__ __forceinline__ f32x4 mfma16(bf16x8 a, bf16x8 b, f32x4 c) { return __builtin_amdgcn_mfma_f32_16x16x32_bf16(a, b, c, 0, 0, 0); }
__device__ __forceinline__ float fsilu(float x) { return x * __builtin_amdgcn_rcpf(1.0f + __builtin_amdgcn_exp2f(-LOG2E * x)); }
__device__ __forceinline__ float fsigmoid(float x) { return __builtin_amdgcn_rcpf(1.0f + __builtin_amdgcn_exp2f(-LOG2E * x)); }
__device__ __forceinline__ float fexp(float x) { return __builtin_amdgcn_exp2f(LOG2E * x); }
using pg8::shflx;
__device__ __forceinline__ float wave_sum(float v, int lane) {
#pragma unroll
    for (int o = 1; o < 64; o <<= 1) v += shflx(v, o, lane);
    return v;
}

template <class T> __device__ __forceinline__ T* launder(T* p) { asm volatile("" : "+s"(p)); return p; }
struct Args { const float* in[20]; float* out; unsigned char* ws; int ph_lo, ph_hi, coop, pad; };
struct Ctx {
    LAS unsigned char* lds; int tid, lane, wave, bid, nblk;
    const float* in[20]; float* out;
    bf16 *Win, *Wout, *Wgu, *Wdn, *xb, *mix, *states, *proj;
    float *ssq, *dtraw, *cdecay;
};

struct P0Item { const float* W; const float* gain; bf16* WT; int nsrc, col, valid, K, drow, k0; };
__device__ __forceinline__ P0Item p0_decode(const Ctx& C, int it) {
    constexpr int I_IN = 16 * 96, I_OUT = 16 * 32, I_GU = 16 * 176, I_DN = 44 * 32, I_L = I_IN + I_OUT + I_GU + I_DN;
    P0Item P; const int l = it / I_L; int r = it % I_L;
    if (r < I_IN) {
        const int kb = r / 96, n0 = 32 * (r % 96);
        int col, valid;
        if (n0 < 2304) { col = n0; valid = 32; } else if (n0 < 2816) { col = n0 + 8; valid = 32; } else if (n0 == 2816) { col = 2304; valid = 8; } else { col = 0; valid = 0; }
        P.W = C.in[2] + (size_t)l * 1024 * 2824; P.nsrc = 2824; P.col = col; P.valid = valid; P.gain = C.in[1] + l * 1024; P.K = 1024; P.WT = C.Win + (size_t)l * 3072 * 1024; P.drow = n0; P.k0 = 64 * kb;
        return P;
    }
    r -= I_IN;
    if (r < I_OUT) { const int kb = r / 32, n0 = 32 * (r % 32);
        P.W = C.in[14] + (size_t)l * 1024 * 1024; P.nsrc = 1024; P.col = n0; P.valid = 32; P.gain = nullptr; P.K = 1024; P.WT = C.Wout + (size_t)l * 1024 * 1024; P.drow = n0; P.k0 = 64 * kb; return P; }
    r -= I_OUT;
    if (r < I_GU) { const int kb = r / 176, n0 = 32 * (r % 176); const int t = n0 >> 8, hs = (n0 >> 7) & 1, i = n0 & 127;
        P.W = (hs ? C.in[17] : C.in[16]) + (size_t)l * 1024 * 2816; P.nsrc = 2816; P.col = 128 * t + i; P.valid = 32; P.gain = C.in[15] + l * 1024; P.K = 1024; P.WT = C.Wgu + (size_t)l * 5632 * 1024; P.drow = n0; P.k0 = 64 * kb; return P; }
    r -= I_GU;
    { const int kb = r / 32, n0 = 32 * (r % 32);
        P.W = C.in[18] + (size_t)l * 2816 * 1024; P.nsrc = 1024; P.col = n0; P.valid = 32; P.gain = nullptr; P.K = 2816; P.WT = C.Wdn + (size_t)l * 1024 * 2816; P.drow = n0; P.k0 = 64 * kb; return P; }
}
__device__ __forceinline__ void p0_load(const P0Item& P, float (&wv)[32], int lane) {
    const int c31 = lane & 31;
#pragma unroll
    for (int i = 0; i < 32; ++i) { const int kk = 2 * i + (lane >> 5); wv[i] = (c31 < P.valid) ? __builtin_nontemporal_load(P.W + (size_t)(P.k0 + kk) * P.nsrc + P.col + c31) : 0.f; }
}
__device__ __forceinline__ void p0_finish(const P0Item& P, float (&wv)[32], LAS float* scr, int lane) {
    const int c31 = lane & 31;
    if (P.gain) {
#pragma unroll
        for (int i = 0; i < 32; ++i) wv[i] *= P.gain[P.k0 + 2 * i + (lane >> 5)];
    }
#pragma unroll
    for (int i = 0; i < 32; ++i) scr[(2 * i + (lane >> 5)) * 33 + c31] = wv[i];
    const int c = lane & 7;
#pragma unroll
    for (int j = 0; j < 4; ++j) {
        const int n = (lane >> 3) + 8 * j; const LAS float* s = scr + (8 * c) * 33 + n;
        u32x4 o; o.x = pk2(s[0 * 33], s[1 * 33]); o.y = pk2(s[2 * 33], s[3 * 33]); o.z = pk2(s[4 * 33], s[5 * 33]); o.w = pk2(s[6 * 33], s[7 * 33]);
        *(u32x4*)(P.WT + (size_t)(P.drow + n) * P.K + P.k0 + 8 * c) = o;
    }
}
__device__ __forceinline__ void p0_convert(const Ctx& C, int it_begin, int it_end, int gw, int NGW, LAS float* scr, int lane) {
#pragma unroll 1
    for (int it = it_begin + gw; it < it_end; it += NGW) {
        float wa[32];
        const P0Item pa = p0_decode(C, it);
        p0_load(pa, wa, lane);
        p0_finish(pa, wa, scr, lane);
    }
}
constexpr int P0_FIRST = 16 * 96;
constexpr int P0_SPLIT = (16 * 96 + 16 * 32 + 16 * 176 + 44 * 32) + 16 * 96;
constexpr int P0_ALL = 2 * (16 * 96 + 16 * 32 + 16 * 176 + 44 * 32);
#ifndef M1P
#define M1P 7
#endif
__device__ __forceinline__ void ssd_dt_acs(const Ctx& C, int layer, int ck, LAS float* sDT, LAS float* sACS, LAS float* sW, bool has_w, int lane, int wave) {
    const int h = wave, t0 = ck * 64;
    const float raw = C.dtraw[(size_t)(t0 + lane) * 8 + h] + C.in[6][layer * 8 + h];
    const float dt = fmaxf(raw, 0.f) + log1pf(expf(-fabsf(raw)));
    const float av = -expf(C.in[7][layer * 8 + h]) * dt;
    float cs = av;
#pragma unroll
    for (int o = 1; o < 64; o <<= 1) { const float v = __int_as_float(__builtin_amdgcn_ds_bpermute(((lane - o) & 63) << 2, __float_as_int(cs))); if (lane >= o) cs += v; }
    const float aend = __int_as_float(__builtin_amdgcn_readlane(__float_as_int(cs), 63));
    sDT[h * 64 + lane] = dt; sACS[h * 64 + lane] = cs;
    if (has_w) { sW[h * 64 + lane] = dt * expf(aend - cs); if (lane == 63) C.cdecay[ck * 8 + h] = expf(cs); }
}

__device__ __forceinline__ void mix1_phase(const Ctx& C, int layer) {
    LAS float* sDT = (LAS float*)(C.lds); LAS float* sACS = (LAS float*)(C.lds + 2048); LAS float* sW = (LAS float*)(C.lds + 4096);
    LAS bf16* sT = (LAS bf16*)(C.lds + 8192);
    LAS float* sBias = (LAS float*)(C.lds + 122880);
    for (int i = C.tid; i < 4 * 257; i += 512) sBias[i] = C.in[3][layer * 4 * 257 + i] * LOG2E;
    for (int ck = ((C.nblk & 7) == 0 ? (C.bid & 7) * (C.nblk >> 3) + (C.bid >> 3) : C.bid); ck < NCHUNK; ck += C.nblk) {
        int tid = C.tid; asm volatile("" : "+v"(tid));
        const int lane = tid & 63, wave = __builtin_amdgcn_readfirstlane(tid >> 6), fr = lane & 15, fq = lane >> 4;
        const int cin = ck & 127, t0 = ck * 64; const bool first = (cin == 0);
        const float* cw = launder(C.in[4]) + (size_t)layer * 4 * 1024; const float* cb = launder(C.in[5]) + layer * 1024;
        ssd_dt_acs(C, layer, ck, sDT, sACS, sW, true, lane, wave);
        __syncthreads();
        if (tid < 384) {
            const int ch0 = 2 * tid;
            const f32x2 w0 = *(const f32x2*)(cw + 0 * 1024 + ch0), w1 = *(const f32x2*)(cw + 1 * 1024 + ch0), w2 = *(const f32x2*)(cw + 2 * 1024 + ch0), w3 = *(const f32x2*)(cw + 3 * 1024 + ch0);
            const f32x2 bb = *(const f32x2*)(cb + ch0);
            const unsigned* src = (const unsigned*)(C.proj + (size_t)t0 * NPROJ + PJ_XBC + ch0);
            f32x2 xm3 = {0.f, 0.f}, xm2 = {0.f, 0.f}, xm1 = {0.f, 0.f};
            if (!first) { const unsigned a = src[-3 * (NPROJ / 2)], b = src[-2 * (NPROJ / 2)], c = src[-1 * (NPROJ / 2)];
                xm3 = (f32x2){bflo(a), bfhi(a)}; xm2 = (f32x2){bflo(b), bfhi(b)}; xm1 = (f32x2){bflo(c), bfhi(c)}; }
            const int hh = ch0 >> 6; const bool isx = ch0 < 512;
#pragma unroll 1
            for (int l0 = 0; l0 < 64; l0 += 16) {
            unsigned uu[16];
#pragma unroll
            for (int i = 0; i < 16; ++i) uu[i] = src[(l0 + i) * (NPROJ / 2)];
#pragma unroll
            for (int li = 0; li < 16; li += 2) {
                const int l = l0 + li;
                const unsigned ua = uu[li], ub = uu[li + 1];
                const f32x2 xa = {bflo(ua), bfhi(ua)}, xc = {bflo(ub), bfhi(ub)};
                f32x2 ya = bb + w0 * xm3 + w1 * xm2 + w2 * xm1 + w3 * xa;
                f32x2 yb = bb + w0 * xm2 + w1 * xm1 + w2 * xa + w3 * xc;
                xm3 = xm1; xm2 = xa; xm1 = xc;
                ya.x = fsilu(ya.x); ya.y = fsilu(ya.y); yb.x = fsilu(yb.x); yb.y = fsilu(yb.y);
                if (isx) { const float wa = sW[hh * 64 + l], wb = sW[hh * 64 + l + 1]; ya = ya * wa; yb = yb * wb; }
                *(LAS unsigned*)(sT + ch0 * 72 + l) = pk2(ya.x, yb.x);
                *(LAS unsigned*)(sT + (ch0 + 1) * 72 + l) = pk2(ya.y, yb.y);
            }
            }
        }
        __syncthreads();
        if (M1P & 1) {
            const int h = wave, g = h >> 2;
            bf16x8 xf[4][2];
#pragma unroll
            for (int pt = 0; pt < 4; ++pt)
#pragma unroll
                for (int ks = 0; ks < 2; ++ks) xf[pt][ks] = *(const LAS bf16x8*)(sT + (h * 64 + 16 * pt + fr) * 72 + 32 * ks + 8 * fq);
            bf16* st = C.states + (size_t)(ck * 8 + h) * 64 * 128;
#pragma unroll 1
            for (int nt = 0; nt < 8; ++nt) {
                bf16x8 bfr[2];
#pragma unroll
                for (int ks = 0; ks < 2; ++ks) bfr[ks] = *(const LAS bf16x8*)(sT + (512 + g * 128 + 16 * nt + fr) * 72 + 32 * ks + 8 * fq);
#pragma unroll
                for (int pt = 0; pt < 4; ++pt) {
                    f32x4 acc = {0.f, 0.f, 0.f, 0.f};
#pragma unroll
                    for (int ks = 0; ks < 2; ++ks) acc = mfma16(bfr[ks], xf[pt][ks], acc);
                    u32x2 w; w.x = pk2(acc[0], acc[1]); w.y = pk2(acc[2], acc[3]);
                    *(u32x2*)(st + (16 * pt + fr) * 128 + 16 * nt + 4 * fq) = w;
                }
            }
        }
        __syncthreads();
        if (M1P & 2) {
            LAS bf16* G = (LAS bf16*)(C.lds + 8192);
            LAS float* CO = (LAS float*)(C.lds + 8192 + 48128);
            const int c = tid & 255, half = tid >> 8;
#pragma unroll
            for (int it = 0; it < 6; ++it) {
                const int u = tid + 512 * it, r = u >> 5, c8 = u & 31;
                if (u < 94 * 32) {
                    u32x4 o = {0u, 0u, 0u, 0u};
                    if (!(first && r < 30)) {
                        const bf16* p = C.proj + (size_t)(t0 - 30 + r) * NPROJ + PJ_GLU + 8 * c8;
                        const u32x4 av = *(const u32x4*)p, gv = *(const u32x4*)(p + 256);
#pragma unroll
                        for (int e = 0; e < 4; ++e) o[e] = pk2(bflo(av[e]) * fsigmoid(bflo(gv[e])), bfhi(av[e]) * fsigmoid(bfhi(gv[e])));
                    }
                    *(LAS u32x4*)(G + r * 256 + 8 * c8) = o;
                }
            }
            __syncthreads();
            {
                const float* dww = launder(C.in[10]) + (size_t)layer * 31 * 256 + c;
                float w[31];
#pragma unroll
                for (int k = 0; k < 31; ++k) w[k] = dww[k * 256];
                const float bias = launder(C.in[11])[layer * 256 + c];
#pragma unroll 1
                for (int grp = 0; grp < 4; ++grp) {
                    float o[8];
#pragma unroll
                    for (int i = 0; i < 8; ++i) o[i] = bias;
                    const LAS bf16* gp = G + (half * 32 + grp * 8) * 256 + c;
#pragma unroll
                    for (int r = 0; r < 38; ++r) {
                        const float v = bf2f(gp[r * 256]);
#pragma unroll
                        for (int i = 0; i < 8; ++i) { const int k = r - i; if (k >= 0 && k <= 30) o[i] += w[k] * v; }
                    }
#pragma unroll
                    for (int i = 0; i < 8; ++i) CO[(half * 32 + grp * 8 + i) * 256 + c] = o[i];
                }
            }
            __syncthreads();
            {
                const f32x4 lg = *((const f32x4*)(launder(C.in[12]) + layer * 256) + lane), lb = *((const f32x4*)(launder(C.in[13]) + layer * 256) + lane);
#pragma unroll 2
                for (int i = 0; i < 8; ++i) {
                    const int l = wave * 8 + i;
                    const f32x4 v = *((const LAS f32x4*)(CO + l * 256) + lane);
                    const float s = wave_sum((v[0] + v[1]) + (v[2] + v[3]), lane);
                    const float mu = s * (1.f / 256.f);
                    const f32x4 d = v - mu;
                    const float s2 = wave_sum((d[0] * d[0] + d[1] * d[1]) + (d[2] * d[2] + d[3] * d[3]), lane);
                    const float rstd = 1.0f / sqrtf(s2 * (1.f / 256.f) + 1e-6f);
                    const f32x4 y = d * rstd * lg + lb;
                    u32x2 w; w.x = pk2(fsilu(y[0]), fsilu(y[1])); w.y = pk2(fsilu(y[2]), fsilu(y[3]));
                    *((u32x2*)(C.mix + (size_t)(t0 + l) * DM + MX_C) + lane) = w;
                }
            }
        }
        __syncthreads();
        if (M1P & 4) {
            LAS bf16* sK = (LAS bf16*)(C.lds + 8192);
            LAS bf16* sV = (LAS bf16*)(C.lds + 8192 + 33792);
            const int h = wave >> 1, qh = wave & 1, q4 = (lane & 15) >> 2, p4 = lane & 3;
            bf16x8 qf[2][2];
#pragma unroll
            for (int qt = 0; qt < 2; ++qt)
#pragma unroll
                for (int ks = 0; ks < 2; ++ks) qf[qt][ks] = *(const bf16x8*)(C.proj + (size_t)(t0 + 32 * qh + 16 * qt + fr) * NPROJ + PJ_Q + h * 64 + 32 * ks + 8 * fq);
            float mrun[2] = {-1e30f, -1e30f}, lsum[2] = {0.f, 0.f};
            f32x4 oacc[4][2];
#pragma unroll
            for (int dt = 0; dt < 4; ++dt)
#pragma unroll
                for (int qt = 0; qt < 2; ++qt) oacc[dt][qt] = (f32x4){0.f, 0.f, 0.f, 0.f};
            const int jmin = cin >= 8 ? 0 : 8 - cin;
            u32x4 kreg[4], vreg[4];
#define ATT_LOAD(jj) do { const bf16* base_ = C.proj + (size_t)(t0 + ((jj) - 8) * 64) * NPROJ; _Pragma("unroll") for (int i = 0; i < 4; ++i) { const int u = tid + 512 * i, row = u >> 5, c8 = u & 31; \
                kreg[i] = *(const u32x4*)(base_ + (size_t)row * NPROJ + PJ_K + 8 * c8); vreg[i] = *(const u32x4*)(base_ + (size_t)row * NPROJ + PJ_V + 8 * c8); } } while (0)
            ATT_LOAD(jmin);
            for (int j = jmin; j <= 8; ++j) {
#pragma unroll
                for (int i = 0; i < 4; ++i) { const int u = tid + 512 * i, row = u >> 5, c8 = u & 31;
                    *(LAS u32x4*)(sK + row * 264 + 8 * c8) = kreg[i]; *(LAS u32x4*)(sV + row * 264 + 8 * c8) = vreg[i]; }
                __syncthreads();
                if (j < 8) ATT_LOAD(j + 1);
                f32x4 st[4][2];
#pragma unroll
                for (int kt = 0; kt < 4; ++kt) {
                    bf16x8 kf[2];
#pragma unroll
                    for (int ks = 0; ks < 2; ++ks) kf[ks] = *(const LAS bf16x8*)(sK + (16 * kt + fr) * 264 + h * 64 + 32 * ks + 8 * fq);
#pragma unroll
                    for (int qt = 0; qt < 2; ++qt) { f32x4 acc = {0.f, 0.f, 0.f, 0.f};
#pragma unroll
                        for (int ks = 0; ks < 2; ++ks) acc = mfma16(kf[ks], qf[qt][ks], acc);
                        st[kt][qt] = acc; }
                }
                if (j >= 6) {
#pragma unroll
                    for (int kt = 0; kt < 4; ++kt)
#pragma unroll
                        for (int qt = 0; qt < 2; ++qt)
#pragma unroll
                            for (int e = 0; e < 4; ++e) {
                                const int rel = (32 * qh + 16 * qt + fr) + 512 - 64 * j - (16 * kt + 4 * fq + e);
                                const int idx = (rel < -128 ? -128 : (rel > 128 ? 128 : rel)) + 128;
                                st[kt][qt][e] += sBias[h * 257 + idx];
                            }
                } else {
                    const float bc = sBias[h * 257 + 256];
#pragma unroll
                    for (int kt = 0; kt < 4; ++kt)
#pragma unroll
                        for (int qt = 0; qt < 2; ++qt) st[kt][qt] = st[kt][qt] + bc;
                }
#pragma unroll
                for (int qt = 0; qt < 2; ++qt) {
                    float mx = -1e30f;
#pragma unroll
                    for (int kt = 0; kt < 4; ++kt)
#pragma unroll
                        for (int e = 0; e < 4; ++e) mx = fmaxf(mx, st[kt][qt][e]);
                    mx = fmaxf(mx, shflx(mx, 16, lane)); mx = fmaxf(mx, shflx(mx, 32, lane));
                    const float mnew = fmaxf(mrun[qt], mx), alpha = __builtin_amdgcn_exp2f(mrun[qt] - mnew);
                    mrun[qt] = mnew;
                    float ps = 0.f;
#pragma unroll
                    for (int kt = 0; kt < 4; ++kt)
#pragma unroll
                        for (int e = 0; e < 4; ++e) { const float p = __builtin_amdgcn_exp2f(st[kt][qt][e] - mnew); st[kt][qt][e] = p; ps += p; }
                    lsum[qt] = lsum[qt] * alpha + ps;
#pragma unroll
                    for (int dt = 0; dt < 4; ++dt) oacc[dt][qt] = oacc[dt][qt] * alpha;
                }
                bf16x8 pf[2][2];
#pragma unroll
                for (int s2 = 0; s2 < 2; ++s2)
#pragma unroll
                    for (int qt = 0; qt < 2; ++qt) {
                        u32x4 w; w.x = pk2(st[2 * s2][qt][0], st[2 * s2][qt][1]); w.y = pk2(st[2 * s2][qt][2], st[2 * s2][qt][3]);
                        w.z = pk2(st[2 * s2 + 1][qt][0], st[2 * s2 + 1][qt][1]); w.w = pk2(st[2 * s2 + 1][qt][2], st[2 * s2 + 1][qt][3]);
                        pf[s2][qt] = __builtin_bit_cast(bf16x8, w);
                    }
#pragma unroll
                for (int dt = 0; dt < 4; ++dt)
#pragma unroll
                    for (int s2 = 0; s2 < 2; ++s2) {
                        const s16x4 lo = __builtin_amdgcn_ds_read_tr16_b64_v4i16((LAS s16x4*)(sV + (32 * s2 + 4 * fq + q4) * 264 + h * 64 + 16 * dt + 4 * p4));
                        const s16x4 hi = __builtin_amdgcn_ds_read_tr16_b64_v4i16((LAS s16x4*)(sV + (32 * s2 + 16 + 4 * fq + q4) * 264 + h * 64 + 16 * dt + 4 * p4));
                        const bf16x8 vf = __builtin_shufflevector(lo, hi, 0, 1, 2, 3, 4, 5, 6, 7);
#pragma unroll
                        for (int qt = 0; qt < 2; ++qt) oacc[dt][qt] = mfma16(vf, pf[s2][qt], oacc[dt][qt]);
                    }
                __syncthreads();
            }
#undef ATT_LOAD
#pragma unroll
            for (int qt = 0; qt < 2; ++qt) {
                float l = lsum[qt]; l += shflx(l, 16, lane); l += shflx(l, 32, lane);
                const float inv = 1.0f / l;
                bf16* op = C.mix + (size_t)(t0 + 32 * qh + 16 * qt + fr) * DM + MX_A + h * 64 + 4 * fq;
#pragma unroll
                for (int dt = 0; dt < 4; ++dt) { u32x2 w; w.x = pk2(oacc[dt][qt][0] * inv, oacc[dt][qt][1] * inv); w.y = pk2(oacc[dt][qt][2] * inv, oacc[dt][qt][3] * inv);
                    *(u32x2*)(op + 16 * dt) = w; }
            }
        }
        __syncthreads();
    }
}

__device__ __forceinline__ void aux_phase(const Ctx& C, int mode, int layer) {
    int cb = 0, ce = 0, gw = 0, ngw = 1;
    if (mode == 0) {
        const int NGW = C.nblk * 8; gw = C.bid * 8 + C.wave; const int lane = C.lane;
        const float* x = C.in[0];
    for (int row0 = gw * 2; row0 < M; row0 += NGW * 2) {
        f32x4 v[2][4];
#pragma unroll
        for (int r = 0; r < 2; ++r)
#pragma unroll
            for (int j = 0; j < 4; ++j) v[r][j] = __builtin_nontemporal_load((const f32x4*)(x + (size_t)(row0 + r) * DM) + lane + 64 * j);
#pragma unroll
        for (int r = 0; r < 2; ++r) {
            float s = 0.f;
#pragma unroll
            for (int j = 0; j < 4; ++j) s += (v[r][j][0] * v[r][j][0] + v[r][j][1] * v[r][j][1]) + (v[r][j][2] * v[r][j][2] + v[r][j][3] * v[r][j][3]);
            s = wave_sum(s, lane);
            u32x2* o = (u32x2*)(C.xb + (size_t)(row0 + r) * DM) + lane;
#pragma unroll
            for (int j = 0; j < 4; ++j) { u32x2 w; w.x = pk2(v[r][j][0], v[r][j][1]); w.y = pk2(v[r][j][2], v[r][j][3]); o[64 * j] = w; }
            if (lane < 16) C.ssq[(size_t)(row0 + r) * 16 + lane] = (lane == 0) ? s : 0.f;
        }
    }

        cb = 0; ce = P0_FIRST; ngw = NGW;
    } else if (C.tid < 256) {
        for (int gt = C.bid * 256 + C.tid; gt < 65536; gt += C.nblk * 256) {
            const int b = gt >> 15, e2 = gt & 32767, h = __builtin_amdgcn_readfirstlane(e2 >> 12);
            const unsigned* p = (const unsigned*)C.states + (size_t)b * 128 * 32768 + e2;
            unsigned* q = (unsigned*)C.states + (size_t)b * 128 * 32768 + e2;
            const float* cd = C.cdecay + __builtin_amdgcn_readfirstlane(b) * 128 * 8 + h;
            float s0 = 0.f, s1 = 0.f;
#pragma unroll 1
            for (int c0 = 0; c0 < 128; c0 += 16) {
                unsigned u[16];
#pragma unroll
                for (int i = 0; i < 16; ++i) u[i] = __builtin_nontemporal_load(p + (size_t)(c0 + i) * 32768);
#pragma unroll
                for (int i = 0; i < 16; ++i) { const float d = cd[(c0 + i) * 8]; q[(size_t)(c0 + i) * 32768] = pk2(s0, s1); s0 = s0 * d + bflo(u[i]); s1 = s1 * d + bfhi(u[i]); }
            }
        }
    } else { cb = layer == 0 ? P0_FIRST : P0_SPLIT; ce = layer == 0 ? P0_SPLIT : P0_ALL; gw = C.bid * 4 + (C.wave - 4); ngw = C.nblk * 4; }
    if (ce > cb) p0_convert(C, cb, ce, gw, ngw, (LAS float*)(C.lds + C.wave * 8448), C.lane);
}

__device__ __forceinline__ void mix3_phase(const Ctx& C, int layer) {
    LAS float* sDT = (LAS float*)(C.lds); LAS float* sACS = (LAS float*)(C.lds + 2048); LAS float* sPART = (LAS float*)(C.lds + 4096);
    LAS bf16* sC = (LAS bf16*)(C.lds + 8192);
    LAS bf16* sB = (LAS bf16*)(C.lds + 41984);
    LAS float* sCB = (LAS float*)(C.lds + 41984);
    LAS bf16* sXT = (LAS bf16*)(C.lds + 75776);
    for (int ck = ((C.nblk & 7) == 0 ? (C.bid & 7) * (C.nblk >> 3) + (C.bid >> 3) : C.bid); ck < NCHUNK; ck += C.nblk) {
        int tid = C.tid; asm volatile("" : "+v"(tid));
        const int lane = tid & 63, wave = __builtin_amdgcn_readfirstlane(tid >> 6), fr = lane & 15, fq = lane >> 4;
        const int cin = ck & 127, t0 = ck * 64; const bool first = (cin == 0);
        const float* cw = launder(C.in[4]) + (size_t)layer * 4 * 1024; const float* cb = launder(C.in[5]) + layer * 1024;
        ssd_dt_acs(C, layer, ck, sDT, sACS, sPART, false, lane, wave);
        {
            const int ch0 = 2 * tid;
            const f32x2 w0 = *(const f32x2*)(cw + 0 * 1024 + ch0), w1 = *(const f32x2*)(cw + 1 * 1024 + ch0), w2 = *(const f32x2*)(cw + 2 * 1024 + ch0), w3 = *(const f32x2*)(cw + 3 * 1024 + ch0);
            const f32x2 bb = *(const f32x2*)(cb + ch0);
            const unsigned* src = (const unsigned*)(C.proj + (size_t)t0 * NPROJ + PJ_XBC + ch0);
            f32x2 xm3 = {0.f, 0.f}, xm2 = {0.f, 0.f}, xm1 = {0.f, 0.f};
            if (!first) { const unsigned a = src[-3 * (NPROJ / 2)], b = src[-2 * (NPROJ / 2)], c = src[-1 * (NPROJ / 2)];
                xm3 = (f32x2){bflo(a), bfhi(a)}; xm2 = (f32x2){bflo(b), bfhi(b)}; xm1 = (f32x2){bflo(c), bfhi(c)}; }
            LAS bf16* nat = (ch0 < 768) ? (sB + (ch0 - 512)) : (sC + (ch0 - 768));
#pragma unroll 1
            for (int l0 = 0; l0 < 64; l0 += 16) {
            unsigned uu[16];
#pragma unroll
            for (int i = 0; i < 16; ++i) uu[i] = src[(l0 + i) * (NPROJ / 2)];
#pragma unroll
            for (int li = 0; li < 16; li += 2) {
                const int l = l0 + li;
                const unsigned ua = uu[li], ub = uu[li + 1];
                const f32x2 xa = {bflo(ua), bfhi(ua)}, xc = {bflo(ub), bfhi(ub)};
                f32x2 ya = bb + w0 * xm3 + w1 * xm2 + w2 * xm1 + w3 * xa;
                f32x2 yb = bb + w0 * xm2 + w1 * xm1 + w2 * xa + w3 * xc;
                xm3 = xm1; xm2 = xa; xm1 = xc;
                ya.x = fsilu(ya.x); ya.y = fsilu(ya.y); yb.x = fsilu(yb.x); yb.y = fsilu(yb.y);
                if (ch0 < 512) {
                    *(LAS unsigned*)(sXT + ch0 * 72 + l) = pk2(ya.x, yb.x);
                    *(LAS unsigned*)(sXT + (ch0 + 1) * 72 + l) = pk2(ya.y, yb.y);
                } else {
                    *(LAS unsigned*)(nat + l * 264) = pk2(ya.x, ya.y);
                    *(LAS unsigned*)(nat + (l + 1) * 264) = pk2(yb.x, yb.y);
                }
            }
            }
        }
        __syncthreads();
        {
            const int g = wave >> 2, lt = wave & 3;
            f32x4 acc[4];
#pragma unroll
            for (int st = 0; st < 4; ++st) acc[st] = (f32x4){0.f, 0.f, 0.f, 0.f};
#pragma unroll
            for (int ks = 0; ks < 4; ++ks) {
                const bf16x8 af = *(const LAS bf16x8*)(sC + (16 * lt + fr) * 264 + g * 128 + 32 * ks + 8 * fq);
#pragma unroll
                for (int st = 0; st < 4; ++st) { const bf16x8 bfr = *(const LAS bf16x8*)(sB + (16 * st + fr) * 264 + g * 128 + 32 * ks + 8 * fq); acc[st] = mfma16(af, bfr, acc[st]); }
            }
            __syncthreads();
#pragma unroll
            for (int st = 0; st < 4; ++st)
#pragma unroll
                for (int e = 0; e < 4; ++e) sCB[(g * 64 + 16 * lt + 4 * fq + e) * 66 + 16 * st + fr] = acc[st][e];
        }
        __syncthreads();
        {
            const int h = wave, g = h >> 2;
            f32x4 acc[4][4];
#pragma unroll
            for (int lt = 0; lt < 4; ++lt)
#pragma unroll
                for (int pt = 0; pt < 4; ++pt) acc[lt][pt] = (f32x4){0.f, 0.f, 0.f, 0.f};
            const bf16* prev = C.states + (size_t)(ck * 8 + h) * 64 * 128;
#pragma unroll
            for (int ks = 0; ks < 4; ++ks) {
                bf16x8 cf[4];
#pragma unroll
                for (int lt = 0; lt < 4; ++lt) cf[lt] = *(const LAS bf16x8*)(sC + (16 * lt + fr) * 264 + g * 128 + 32 * ks + 8 * fq);
#pragma unroll
                for (int pt = 0; pt < 4; ++pt) {
                    const bf16x8 pfr = *(const bf16x8*)(prev + (16 * pt + fr) * 128 + 32 * ks + 8 * fq);
#pragma unroll
                    for (int lt = 0; lt < 4; ++lt) acc[lt][pt] = mfma16(pfr, cf[lt], acc[lt][pt]);
                }
                __builtin_amdgcn_sched_barrier(0);
            }
#pragma unroll
            for (int lt = 0; lt < 4; ++lt) {
                const float ea = fexp(sACS[h * 64 + 16 * lt + fr]);
#pragma unroll
                for (int pt = 0; pt < 4; ++pt) acc[lt][pt] = acc[lt][pt] * ea;
            }
#pragma unroll
            for (int ks2 = 0; ks2 < 2; ++ks2) {
                bf16x8 xf[4];
#pragma unroll
                for (int pt = 0; pt < 4; ++pt) xf[pt] = *(const LAS bf16x8*)(sXT + (h * 64 + 16 * pt + fr) * 72 + 32 * ks2 + 8 * fq);
                const f32x4 as0 = *(const LAS f32x4*)(sACS + h * 64 + 32 * ks2 + 8 * fq), as1 = *(const LAS f32x4*)(sACS + h * 64 + 32 * ks2 + 8 * fq + 4);
                const f32x4 dt0 = *(const LAS f32x4*)(sDT + h * 64 + 32 * ks2 + 8 * fq), dt1 = *(const LAS f32x4*)(sDT + h * 64 + 32 * ks2 + 8 * fq + 4);
#pragma unroll
                for (int lt = 0; lt < 4; ++lt) {
                    if (ks2 == 1 && lt < 2) continue;
                    const int l = 16 * lt + fr; const float al = sACS[h * 64 + l];
                    const LAS f32x2* cbp = (const LAS f32x2*)(sCB + (g * 64 + l) * 66 + 32 * ks2 + 8 * fq);
                    const f32x2 c01 = cbp[0], c23 = cbp[1], c45 = cbp[2], c67 = cbp[3];
                    const float cbv[8] = {c01.x, c01.y, c23.x, c23.y, c45.x, c45.y, c67.x, c67.y};
                    const float asv[8] = {as0[0], as0[1], as0[2], as0[3], as1[0], as1[1], as1[2], as1[3]};
                    const float dtv[8] = {dt0[0], dt0[1], dt0[2], dt0[3], dt1[0], dt1[1], dt1[2], dt1[3]};
                    float v[8];
#pragma unroll
                    for (int jj = 0; jj < 8; ++jj) { const int sidx = 32 * ks2 + 8 * fq + jj; const float t = cbv[jj] * fexp(al - asv[jj]) * dtv[jj]; v[jj] = (sidx <= l) ? t : 0.f; }
                    u32x4 w; w.x = pk2(v[0], v[1]); w.y = pk2(v[2], v[3]); w.z = pk2(v[4], v[5]); w.w = pk2(v[6], v[7]);
                    const bf16x8 af = __builtin_bit_cast(bf16x8, w);
#pragma unroll
                    for (int pt = 0; pt < 4; ++pt) acc[lt][pt] = mfma16(xf[pt], af, acc[lt][pt]);
                }
            }
            const float Dh = launder(C.in[8])[layer * 8 + h];
#pragma unroll
            for (int lt = 0; lt < 4; ++lt) {
                const int l = 16 * lt + fr; float q = 0.f;
#pragma unroll
                for (int pt = 0; pt < 4; ++pt) {
                    const int p0 = 16 * pt + 4 * fq;
                    const u32x2 zz = *(const u32x2*)(C.proj + (size_t)(t0 + l) * NPROJ + PJ_Z + h * 64 + p0);
                    const float zv[4] = {bflo(zz.x), bfhi(zz.x), bflo(zz.y), bfhi(zz.y)};
#pragma unroll
                    for (int e = 0; e < 4; ++e) {
                        const float xv = bf2f(sXT[(h * 64 + p0 + e) * 72 + l]);
                        const float y = (acc[lt][pt][e] + xv * Dh) * fsilu(zv[e]);
                        acc[lt][pt][e] = y; q += y * y;
                    }
                }
                q += shflx(q, 16, lane); q += shflx(q, 32, lane);
                if (fq == 0) sPART[h * 64 + l] = q;
            }
            __syncthreads();
            const float* ng = launder(C.in[9]) + layer * 512 + h * 64;
#pragma unroll
            for (int lt = 0; lt < 4; ++lt) {
                const int l = 16 * lt + fr;
                const float tot = (sPART[(4 * g) * 64 + l] + sPART[(4 * g + 1) * 64 + l]) + (sPART[(4 * g + 2) * 64 + l] + sPART[(4 * g + 3) * 64 + l]);
                const float rs = 1.0f / sqrtf(tot * (1.f / 256.f) + 1e-6f);
#pragma unroll
                for (int pt = 0; pt < 4; ++pt) {
                    const int p0 = 16 * pt + 4 * fq;
                    const f32x4 gg = *(const f32x4*)(ng + p0);
                    u32x2 w; w.x = pk2(acc[lt][pt][0] * rs * gg[0], acc[lt][pt][1] * rs * gg[1]); w.y = pk2(acc[lt][pt][2] * rs * gg[2], acc[lt][pt][3] * rs * gg[3]);
                    *(u32x2*)(C.mix + (size_t)(t0 + l) * DM + MX_B + h * 64 + p0) = w;
                }
            }
        }
        __syncthreads();
    }
}

__device__ __forceinline__ void final_phase(const Ctx& C) {
    const int gw = C.bid * 8 + C.wave, NGW = C.nblk * 8, lane = C.lane;
    f32x4 gg[2][2];
#pragma unroll
    for (int j = 0; j < 2; ++j) { gg[j][0] = *(const f32x4*)(C.in[19] + 512 * j + 8 * lane); gg[j][1] = *(const f32x4*)(C.in[19] + 512 * j + 8 * lane + 4); }
    for (int row0 = gw * 2; row0 < M; row0 += NGW * 2) {
        u32x4 v[2][2]; float rs[2];
#pragma unroll
        for (int r = 0; r < 2; ++r) {
            rs[r] = pg8::rstd_of(C.ssq, row0 + r);
#pragma unroll
            for (int j = 0; j < 2; ++j) v[r][j] = __builtin_nontemporal_load((const u32x4*)(C.xb + (size_t)(row0 + r) * DM + 512 * j + 8 * lane));
        }
#pragma unroll
        for (int r = 0; r < 2; ++r)
#pragma unroll
            for (int j = 0; j < 2; ++j) {
                const u32x4 w = v[r][j];
                const f32x4 a = {bflo(w.x), bfhi(w.x), bflo(w.y), bfhi(w.y)}, b = {bflo(w.z), bfhi(w.z), bflo(w.w), bfhi(w.w)};
                float* o = C.out + (size_t)(row0 + r) * DM + 512 * j + 8 * lane;
                *(f32x4*)o = a * rs[r] * gg[j][0]; *(f32x4*)(o + 4) = b * rs[r] * gg[j][1];
            }
    }
}

#define XB_TMO      128
#define XB_XCNT(j)  (256  + 64 * (j))
#define XB_XSUB(j)  (1280 + 64 * (j))
#define XB_XGEN(j)  (2304 + 64 * (j))
#define XB_TOP      3328
#define XB_TOPGEN   3392
#define XCD_BAR_WORDS 3456
#define XB_SPIN_CAP (1u << 18)

__device__ __forceinline__ unsigned xb_ld(unsigned* p)              { return __hip_atomic_load(p, __ATOMIC_RELAXED, __HIP_MEMORY_SCOPE_AGENT); }
__device__ __forceinline__ unsigned xb_add(unsigned* p, unsigned v) { return __hip_atomic_fetch_add(p, v, __ATOMIC_RELAXED, __HIP_MEMORY_SCOPE_AGENT); }
__device__ __forceinline__ unsigned xb_xcc_id() { return (unsigned)__builtin_amdgcn_s_getreg((3 << 11) | 20) & 0xFu; }
#define XB_SPIN(cond, bar) do { unsigned _sp = 0; while (cond) { __builtin_amdgcn_s_sleep(1); \
    if ((++_sp & 255u) == 0u) { if (xb_ld(&(bar)[XB_TMO])) break; if (_sp > XB_SPIN_CAP) { atomicAdd(&(bar)[XB_TMO], 1u); break; } } } } while (0)

struct XcdBarrier {
    unsigned* bar; unsigned x;
    volatile LAS unsigned* st;
};

__device__ __forceinline__ XcdBarrier xcd_barrier_post(unsigned* bar, volatile LAS unsigned* st) {
    XcdBarrier b; b.bar = bar; b.x = xb_xcc_id(); b.st = st;
    if (threadIdx.x == 0) (void)xb_add(&bar[XB_XCNT(b.x)], 1u);
    return b;
}
__device__ __forceinline__ void xcd_barrier_complete(unsigned* bar, unsigned x, unsigned& nloc, unsigned& nx) {
    const unsigned G = gridDim.x * gridDim.y * gridDim.z;
    unsigned sum, cnt, mine, sp = 0u;
    for (;;) {
        sum = 0u; cnt = 0u; mine = 0u;
#pragma unroll
        for (unsigned j = 0; j < 16; ++j) { const unsigned c = xb_ld(&bar[XB_XCNT(j)]); sum += c; cnt += (c > 0u) ? 1u : 0u; mine = (j == x) ? c : mine; }
        if (sum == G) break;
        __builtin_amdgcn_s_sleep(1);
        if ((++sp & 255u) == 0u) { if (xb_ld(&bar[XB_TMO])) break; if (sp > XB_SPIN_CAP) { atomicAdd(&bar[XB_TMO], 1u); break; } }
    }
    nloc = mine > 0u ? mine : 1u; nx = cnt > 0u ? cnt : 1u;
}

__device__ __forceinline__ void xcd_barrier(const XcdBarrier& b) {
    asm volatile("s_waitcnt vmcnt(0)" ::: "memory");
    __syncthreads();
    if (threadIdx.x == 0) {
        unsigned* bar = b.bar;
        __builtin_amdgcn_s_waitcnt(0);
        unsigned nloc = b.st[0], nx = b.st[1];
        if (nloc == 0u) { xcd_barrier_complete(bar, b.x, nloc, nx); b.st[0] = nloc; b.st[1] = nx; }
        const unsigned old = xb_add(&bar[XB_XSUB(b.x)], 1u);
        const unsigned gen = old / nloc;
        if (old + 1u == (gen + 1u) * nloc) {
            __builtin_amdgcn_fence(__ATOMIC_RELEASE, "agent");
            asm volatile("s_waitcnt vmcnt(0)" ::: "memory");
            const unsigned og = xb_add(&bar[XB_TOP], 1u);
            const unsigned tg = og / nx;
            if (og + 1u == (tg + 1u) * nx) xb_add(&bar[XB_TOPGEN], 1u);
            else XB_SPIN(xb_ld(&bar[XB_TOPGEN]) == tg, bar);
            __builtin_amdgcn_fence(__ATOMIC_ACQUIRE, "agent");
            xb_add(&bar[XB_XGEN(b.x)], 1u);
            asm volatile("s_waitcnt vmcnt(0)" ::: "memory");
        } else {
            XB_SPIN(xb_ld(&bar[XB_XGEN(b.x)]) == gen, bar);
            __builtin_amdgcn_fence(__ATOMIC_ACQUIRE, "agent");
            asm volatile("s_waitcnt vmcnt(0)" ::: "memory");
        }
    }
    __syncthreads();
}

#ifndef PHMASK
#define PHMASK 0x1ff
#endif
#define PHEN(x) (((PHMASK) >> (x)) & 1)
#define CAS __attribute__((address_space(4)))
__device__ __forceinline__ Ctx make_ctx(const CAS Args* ap, LAS unsigned char* lds, int tidv, int bid, int nblk) {
    Ctx C; C.bid = bid; C.nblk = nblk;
    C.lds = lds; C.tid = tidv; C.lane = tidv & 63; C.wave = __builtin_amdgcn_readfirstlane(tidv >> 6);
#pragma unroll
    for (int i = 0; i < 20; ++i) C.in[i] = ap->in[i];
    C.out = ap->out;
    unsigned char* ws = ap->ws;
    C.Win = (bf16*)(ws + WS_WIN); C.Wout = (bf16*)(ws + WS_WOUT); C.Wgu = (bf16*)(ws + WS_WGU); C.Wdn = (bf16*)(ws + WS_WDN);
    C.xb = (bf16*)(ws + WS_XB); C.mix = (bf16*)(ws + WS_MIX); C.states = (bf16*)(ws + WS_ST); C.proj = (bf16*)(ws + WS_PROJ);
    C.ssq = (float*)(ws + WS_SSQ); C.dtraw = (float*)(ws + WS_DT); C.cdecay = (float*)(ws + WS_CD);
    return C;
}
__global__ void __launch_bounds__(512, 2) fwd_kernel(Args a_unused) {
    extern __shared__ __attribute__((aligned(16))) unsigned char lds_raw[];
    cg::grid_group grid = cg::this_grid();
    LAS unsigned char* lds = (LAS unsigned char*)lds_raw;
    const CAS Args* ap0 = (const CAS Args*)__builtin_amdgcn_kernarg_segment_ptr();
    const int ph_lo = ap0->ph_lo, ph_hi = ap0->ph_hi, coop = ap0->coop;
    volatile LAS unsigned* MISC = (volatile LAS unsigned*)(lds + LDS_BYTES - 64);
    if (threadIdx.x < 16) MISC[threadIdx.x] = 0u;
    __syncthreads();
    unsigned* barw = (unsigned*)(ap0->ws);
    XcdBarrier bar; bar.bar = barw; bar.x = 0; bar.st = MISC;
    if (coop) bar = xcd_barrier_post(barw, MISC);
    for (int ph = ph_lo; ph < ph_hi; ++ph) {
        const CAS Args* ap = ap0; asm volatile("" : "+s"(ap));
        int tidv = threadIdx.x; asm volatile("" : "+v"(tidv));
        int bid = blockIdx.x, nblk = gridDim.x; asm volatile("" : "+s"(bid), "+s"(nblk));
        if (ph == NPHASES - 1) { if (PHEN(8)) { const Ctx C = make_ctx(ap, lds, tidv, bid, nblk); final_phase(C); } }
        else {
            const int l = (ph == 0) ? 0 : (ph - 1) / 7, t = (ph == 0) ? 2 : (ph - 1) % 7;
            if (t == 0 || t >= 4) { if (PHEN(1)) {
                const Ctx C = make_ctx(ap, lds, tidv, bid, nblk);
                pg8::Gemm g; int N;
                pg8::EpiAny E; E.e0 = pg8::EpiInProj{C.proj, C.dtraw, (const LAS float*)(lds + 131072)}; E.e1 = pg8::EpiResid{(l == 0 && t == 4) ? C.in[0] : (const float*)nullptr, C.xb, C.ssq}; E.e2 = pg8::EpiGateUp{C.proj, (const LAS float*)(lds + 131072)};
                if (t == 0)      { g = pg8::Gemm{C.xb, C.Win + (size_t)l * 3072 * 1024, M, 3072, 1024}; N = 3072; E.mode = 0; }
                else if (t == 4) { g = pg8::Gemm{C.mix, C.Wout + (size_t)l * 1024 * 1024, M, 1024, 1024}; N = 1024; E.mode = 1; }
                else if (t == 5) { g = pg8::Gemm{C.xb, C.Wgu + (size_t)l * 5632 * 1024, M, 5632, 1024}; N = 5632; E.mode = 2; }
                else             { g = pg8::Gemm{C.proj, C.Wdn + (size_t)l * 1024 * 2816, M, 1024, 2816}; N = 1024; E.mode = 1; }
                pg8::StaticOrder S; S.init(M, N, nblk, bid);
                LAS float* rsl = (LAS float*)(lds + 131072);
                if (E.mode != 1) {
                    pg8::Unit uu;
                    for (int i = 0; i < 16 && S.next(i, uu); ++i) if (tidv < 256) rsl[i * 256 + tidv] = pg8::rstd_of(C.ssq, uu.pm * 256 + tidv);
                    __syncthreads();
                }
                pg8::gemm_phase<pg8::EpiAny, pg8::StaticOrder, true, true>(lds, g, S, E, tidv); }
            } else if (t == 1) { if (PHEN(2)) { const Ctx C = make_ctx(ap, lds, tidv, bid, nblk); mix1_phase(C, l); } }
            else if (t == 2) { if (PHEN(3)) { const Ctx C = make_ctx(ap, lds, tidv, bid, nblk); aux_phase(C, ph == 0 ? 0 : 1, l); } }
            else { if (PHEN(4)) { const Ctx C = make_ctx(ap, lds, tidv, bid, nblk); mix3_phase(C, l); } }
        }
        if (ph + 1 < ph_hi && coop) {
            if (coop == 2) grid.sync();
            xcd_barrier(bar);
        }
    }
}

#ifndef MK_MULTI
#define MK_MULTI 0
#endif
extern "C" void kernel_launch(void* const* d_in, const int* in_sizes, int n_in, void* d_out, int out_size, void* d_ws, size_t ws_size, hipStream_t stream) {
    static int grid = 0;
    if (grid == 0) {
        if (n_in != 20 || out_size != M * DM || ws_size < WS_END) { fprintf(stderr, "kernel_launch: unexpected shapes (n_in %d out %d ws %zu)\n", n_in, out_size, ws_size); grid = -1; return; }
        int dev = 0, cus = 0, per_cu = 0;
        hipGetDevice(&dev); hipDeviceGetAttribute(&cus, hipDeviceAttributeMultiprocessorCount, dev);
        if (hipFuncSetAttribute((const void*)fwd_kernel, hipFuncAttributeMaxDynamicSharedMemorySize, LDS_BYTES) != hipSuccess) { fprintf(stderr, "kernel_launch: hipFuncSetAttribute failed\n"); grid = -1; return; }
        if (hipOccupancyMaxActiveBlocksPerMultiprocessor(&per_cu, (const void*)fwd_kernel, 512, LDS_BYTES) != hipSuccess || per_cu < 1) { fprintf(stderr, "kernel_launch: occupancy query gave %d\n", per_cu); per_cu = 1; (void)hipGetLastError(); }
        grid = cus * per_cu; if (grid > 256) grid = 256;
    }
    if (grid < 0) return;
    Args a{};
    for (int i = 0; i < 20; ++i) a.in[i] = (const float*)d_in[i];
    a.out = (float*)d_out; a.ws = (unsigned char*)d_ws;
#if MK_MULTI
    a.coop = 0;
    for (int ph = 0; ph < NPHASES; ++ph) { a.ph_lo = ph; a.ph_hi = ph + 1; hipLaunchKernelGGL(fwd_kernel, dim3(grid), dim3(512), LDS_BYTES, stream, a); }
#else
    a.coop = 1; a.ph_lo = 0; a.ph_hi = NPHASES;
    if (hipMemsetAsync(d_ws, 0, 32768, stream) != hipSuccess) { fprintf(stderr, "kernel_launch: hipMemsetAsync failed\n"); return; }
    void* args[] = {&a};
    hipError_t e = hipLaunchCooperativeKernel((const void*)fwd_kernel, dim3(grid), dim3(512), args, LDS_BYTES, stream);
    if (e != hipSuccess) fprintf(stderr, "kernel_launch: cooperative launch failed: %s (grid %d)\n", hipGetErrorString(e), grid);
#endif
}
```

```cpp
#include <hip/hip_runtime.h>
#include <hip/hip_cooperative_groups.h>
#include <cstdio>
#include <cstdint>
namespace cg = cooperative_groups;
namespace pg8 {
#define PG8_LAS __attribute__((address_space(3)))
typedef unsigned short bf16_t;
typedef short bf16x8 __attribute__((ext_vector_type(8)));
typedef float f32x4 __attribute__((ext_vector_type(4)));
typedef unsigned u32x4 __attribute__((ext_vector_type(4)));
constexpr int BM = 256, BK = 64, HALF = 128, HTB = HALF * BK * 2  , STAGE_BYTES = 8 * HTB, NXCD = 8, WGM = 8;

__host__ __device__ __forceinline__ int lds_byte(int r, int c) { const int st = (r >> 4) * 2 + (c >> 5), rr = r & 15, cc = c & 31, ob = rr * 64 + cc * 2; return st * 1024 + (ob ^ (((ob >> 9) & 1) << 5)); }
__host__ __device__ __forceinline__ void stage_rc(int b, int& R, int& C) { const int st = b / 1024, sb = b % 1024, swz = sb ^ (((sb >> 9) & 1) << 5); R = (st >> 1) * 16 + swz / 64; C = (st & 1) * 32 + (swz % 64) / 2; }
__host__ __device__ __forceinline__ int perm32(int rho) { const int n = rho >> 4, i = rho & 15; return 8 * (i >> 2) + 4 * n + (i & 3); }

struct Unit { int pm, pn, idx; };
struct Gemm { const bf16_t* A; const bf16_t* Bt; int M, N, K; };

struct StaticOrder {
    int nM, nN, nwg, G, c;
    __host__ __device__ void init(int M, int N, int G_, int c_) { nM = M / BM; nN = N / BM; nwg = nM * nN; G = G_; c = c_; }
    __host__ __device__ bool next(int i, Unit& u) const {
        const long L = (long)i * G + c; if (L >= nwg) return false; u.idx = i;
        int wgid = (int)L; { const int q = nwg / NXCD, r = nwg % NXCD, xcd = wgid % NXCD, off = wgid / NXCD; wgid = (xcd < r ? xcd * (q + 1) : r * (q + 1) + (xcd - r) * q) + off; }
        const int nig = WGM * nN, gid = wgid / nig, fm = gid * WGM, gsz = (nM - fm) < WGM ? (nM - fm) : WGM;
        u.pm = fm + ((wgid % nig) % gsz); u.pn = (wgid % nig) / gsz; return true;
    }
    __device__ __forceinline__ void a_ready(const Unit&) const {}
    __device__ __forceinline__ void done(const Unit&) const {}
};

__device__ __forceinline__ unsigned cvt_pk_bf16(float lo, float hi) { unsigned r; asm volatile("v_cvt_pk_bf16_f32 %0, %1, %2" : "=v"(r) : "v"(lo), "v"(hi)); return r; }
__device__ __forceinline__ float shflx(float v, int mask, int lane) { return __int_as_float(__builtin_amdgcn_ds_bpermute((lane ^ mask) << 2, __float_as_int(v))); }
__device__ __forceinline__ float rstd_of(const float* ssq, int row) {
    const f32x4* p = (const f32x4*)(ssq + (size_t)row * 16);
    const f32x4 a = p[0], b = p[1], c = p[2], d = p[3];
    const float s = (((a[0] + a[1]) + (a[2] + a[3])) + ((b[0] + b[1]) + (b[2] + b[3]))) + (((c[0] + c[1]) + (c[2] + c[3])) + ((d[0] + d[1]) + (d[2] + d[3])));
    return __builtin_amdgcn_rsqf(s * (1.0f / 1024.0f) + 1e-6f);
}
__device__ __forceinline__ float silu_f(float x) { return x * __builtin_amdgcn_rcpf(1.0f + __builtin_amdgcn_exp2f(-1.4426950408889634f * x)); }
constexpr float QSCALE = 0.125f * 1.4426950408889634f;
struct EpiInProj {
    static constexpr bool PERM = true, AFTER_DRAIN = false;
    bf16_t* proj; float* dtraw; const PG8_LAS float* rsl;
    __device__ __forceinline__ void operator()(const f32x4 (&acc)[2][2][4][2], const Unit& u, int wr, int wc, int fr, int fq) const {
        const int row0 = u.pm * BM + wr * 64 + fr;
        const float sc = (u.pn == 0) ? QSCALE : 1.0f;
#pragma unroll
        for (int ai = 0; ai < 2; ++ai)
#pragma unroll
            for (int m = 0; m < 4; ++m) {
                const int row = row0 + ai * HALF + m * 16;
                const float rs = rsl[u.idx * 256 + (row & 255)] * sc;
                if (u.pn < 11) {
                    bf16_t* rowp = proj + (size_t)row * 2816 + u.pn * BM + wc * 32 + 8 * fq;
#pragma unroll
                    for (int bj = 0; bj < 2; ++bj) {
                        const f32x4 v0 = acc[ai][bj][m][0] * rs, v1 = acc[ai][bj][m][1] * rs;
                        u32x4 w; w.x = cvt_pk_bf16(v0[0], v0[1]); w.y = cvt_pk_bf16(v0[2], v0[3]); w.z = cvt_pk_bf16(v1[0], v1[1]); w.w = cvt_pk_bf16(v1[2], v1[3]);
                        *(u32x4*)(rowp + bj * HALF) = w;
                    }
                } else if (wc == 0 && fq == 0) {
                    *(f32x4*)(dtraw + (size_t)row * 8) = acc[ai][0][m][0] * rs;
                    *(f32x4*)(dtraw + (size_t)row * 8 + 4) = acc[ai][0][m][1] * rs;
                }
            }
    }
};
struct EpiResid {
    static constexpr bool PERM = true, AFTER_DRAIN = false;
    const float* base32; bf16_t* xb; float* ssq;
    __device__ __forceinline__ void operator()(const f32x4 (&acc)[2][2][4][2], const Unit& u, int wr, int wc, int fr, int fq) const {
        const int col0 = u.pn * BM + wc * 32 + 8 * fq, lane_ = fr + 16 * fq;
#pragma unroll
        for (int ai = 0; ai < 2; ++ai)
#pragma unroll
            for (int m = 0; m < 4; ++m) {
                const int row = u.pm * BM + ai * HALF + wr * 64 + m * 16 + fr;
                const size_t off = (size_t)row * 1024 + col0;
                float q = 0.f;
#pragma unroll
                for (int bj = 0; bj < 2; ++bj) {
                    const u32x4 r = *(const u32x4*)(xb + off + bj * HALF);
                    const f32x4 b0 = {__uint_as_float(r.x << 16), __uint_as_float(r.x & 0xffff0000u), __uint_as_float(r.y << 16), __uint_as_float(r.y & 0xffff0000u)};
                    const f32x4 b1 = {__uint_as_float(r.z << 16), __uint_as_float(r.z & 0xffff0000u), __uint_as_float(r.w << 16), __uint_as_float(r.w & 0xffff0000u)};
                    const f32x4 o0 = b0 + acc[ai][bj][m][0], o1 = b1 + acc[ai][bj][m][1];
                    q += ((o0[0] * o0[0] + o0[1] * o0[1]) + (o0[2] * o0[2] + o0[3] * o0[3])) + ((o1[0] * o1[0] + o1[1] * o1[1]) + (o1[2] * o1[2] + o1[3] * o1[3]));
                    u32x4 w; w.x = cvt_pk_bf16(o0[0], o0[1]); w.y = cvt_pk_bf16(o0[2], o0[3]); w.z = cvt_pk_bf16(o1[0], o1[1]); w.w = cvt_pk_bf16(o1[2], o1[3]);
                    *(u32x4*)(xb + off + bj * HALF) = w;
                }
                q += shflx(q, 16, lane_); q += shflx(q, 32, lane_);
                if (fq == 0) ssq[(size_t)row * 16 + u.pn * 4 + wc] = q;
            }
    }
};
typedef float f32x2v __attribute__((ext_vector_type(2)));
struct EpiGateUp {
    static constexpr bool PERM = true, AFTER_DRAIN = false;
    bf16_t* hdn; const PG8_LAS float* rsl;
    __device__ __forceinline__ void operator()(const f32x4 (&acc)[2][2][4][2], const Unit& u, int wr, int wc, int fr, int fq) const {
        const int row0 = u.pm * BM + wr * 64 + fr, col = u.pn * HALF + wc * 32 + 8 * fq;
#pragma unroll
        for (int ai = 0; ai < 2; ++ai)
#pragma unroll
            for (int m = 0; m < 4; ++m) {
                const int row = row0 + ai * HALF + m * 16;
                const float rs = rsl[u.idx * 256 + (row & 255)];
                const float rs2 = rs * rs, nrs = rs * -1.4426950408889634f;
                u32x4 w;
#pragma unroll
                for (int n = 0; n < 2; ++n)
#pragma unroll
                    for (int hh = 0; hh < 2; ++hh) {
                        const f32x2v g = {acc[ai][0][m][n][2 * hh], acc[ai][0][m][n][2 * hh + 1]}, uu = {acc[ai][1][m][n][2 * hh], acc[ai][1][m][n][2 * hh + 1]};
                        const f32x2v t = g * nrs; f32x2v e; e.x = __builtin_amdgcn_exp2f(t.x); e.y = __builtin_amdgcn_exp2f(t.y);
                        const f32x2v d = e + 1.0f; f32x2v r; r.x = __builtin_amdgcn_rcpf(d.x); r.y = __builtin_amdgcn_rcpf(d.y);
                        const f32x2v o = (g * uu) * (r * rs2);
                        w[2 * n + hh] = cvt_pk_bf16(o.x, o.y);
                    }
                *(u32x4*)(hdn + (size_t)row * 2816 + col) = w;
            }
    }
};

struct EpiAny {
    static constexpr bool PERM = true, AFTER_DRAIN = false;
    int mode; EpiInProj e0; EpiResid e1; EpiGateUp e2;
    __device__ __forceinline__ void operator()(const f32x4 (&acc)[2][2][4][2], const Unit& u, int wr, int wc, int fr, int fq) const {
        if (mode == 0) e0(acc, u, wr, wc, fr, fq); else if (mode == 1) e1(acc, u, wr, wc, fr, fq); else e2(acc, u, wr, wc, fr, fq);
    }
};
template <class Epi, class Sched, bool ALIGN_EPI = false, bool SP2 = false>
__device__ __forceinline__ void gemm_phase(PG8_LAS unsigned char* lds, const Gemm g, const Sched& S, const Epi& E, const int tid) {
    const int wid = __builtin_amdgcn_readfirstlane(tid >> 6), lane = tid & 63, wr = wid >> 2, wc = wid & 3, fr = lane & 15, fq = lane >> 4;
    const int K = g.K, nt = K / BK;
    unsigned voffA[2], voffB[2];
#pragma unroll
    for (int i = 0; i < 2; ++i) { int R, C; stage_rc(tid * 16 + i * 8192, R, C); const int Rb = Epi::PERM ? ((R & ~31) + perm32(R & 31)) : R;
        voffA[i] = (unsigned)(R * K + C) * 2u; voffB[i] = (unsigned)(Rb * K + C) * 2u; }
    const size_t kstep = (size_t)(BK * 2);
    const size_t hstep = (size_t)HALF * K * 2;
    const size_t tstep = 2 * hstep;
    const unsigned ldsw = (unsigned)wid * 1024u;
    const int aoff = lds_byte(wr * 64 + fr, fq * 8), boff = lds_byte(wc * 32 + fr, fq * 8);
#define PG8_SA(b, h) (((b) * 2 + (h)) * HTB)
#define PG8_SB(b, h) ((4 + (b) * 2 + (h)) * HTB)
#define PG8_STAGE(bufoff, gbase, voff) do { _Pragma("unroll") for (int _i = 0; _i < 2; ++_i) \
        __builtin_amdgcn_global_load_lds((const unsigned*)((const char*)(gbase) + (voff)[_i]), (PG8_LAS unsigned*)(lds + (bufoff) + ldsw + _i * 8192), 16, 0, 0); } while (0)
#define PG8_LDA(dst, b, h) do { _Pragma("unroll") for (int m = 0; m < 4; ++m) _Pragma("unroll") for (int k = 0; k < 2; ++k) dst[m][k] = *(const PG8_LAS bf16x8*)(lds + PG8_SA(b, h) + aoff + m * 2048 + k * 1024); } while (0)
#define PG8_LDB(dst, b, h) do { _Pragma("unroll") for (int n = 0; n < 2; ++n) _Pragma("unroll") for (int k = 0; k < 2; ++k) dst[n][k] = *(const PG8_LAS bf16x8*)(lds + PG8_SB(b, h) + boff + n * 2048 + k * 1024); } while (0)
#define PG8_MMA(ai, bj, At, Bt) do { __builtin_amdgcn_s_setprio(1); _Pragma("unroll") for (int m = 0; m < 4; ++m) _Pragma("unroll") for (int n = 0; n < 2; ++n) _Pragma("unroll") for (int k = 0; k < 2; ++k) \
        acc[ai][bj][m][n] = __builtin_amdgcn_mfma_f32_16x16x32_bf16(Bt[n][k], At[m][k], acc[ai][bj][m][n], 0, 0, 0); __builtin_amdgcn_s_setprio(0); } while (0)
#define PG8_WAIT_V(n) asm volatile("s_waitcnt vmcnt(" #n ")" ::: "memory")
#define PG8_WAIT_L(n) asm volatile("s_waitcnt lgkmcnt(" #n ")" ::: "memory")
#define PG8_BAR __builtin_amdgcn_s_barrier()
#define PG8_SCHED __builtin_amdgcn_sched_barrier(0)
    Unit cur, nxt; int ui = 0;
    if (!S.next(0, cur)) return;
    f32x4 acc[2][2][4][2];
#pragma unroll
    for (int a = 0; a < 2; ++a)
#pragma unroll
        for (int b = 0; b < 2; ++b)
#pragma unroll
            for (int m = 0; m < 4; ++m)
#pragma unroll
                for (int n = 0; n < 2; ++n) acc[a][b][m][n] = (f32x4){0.f, 0.f, 0.f, 0.f};
    bf16x8 At[4][2], B0[2][2], B1[2][2];
    const char* cA = (const char*)g.A + (size_t)cur.pm * tstep; const char* cB = (const char*)g.Bt + (size_t)cur.pn * tstep;
    S.a_ready(cur);
    if constexpr (SP2) {
        PG8_STAGE(PG8_SB(0, 0), cB, voffB); PG8_STAGE(PG8_SB(0, 1), cB + hstep, voffB); PG8_STAGE(PG8_SA(0, 0), cA, voffA); PG8_STAGE(PG8_SA(0, 1), cA + hstep, voffA);
        if (wr == 1) PG8_BAR;
        PG8_WAIT_V(2); PG8_BAR;
        PG8_STAGE(PG8_SB(1, 0), cB + kstep, voffB); PG8_STAGE(PG8_SA(1, 0), cA + kstep, voffA); PG8_STAGE(PG8_SB(1, 1), cB + hstep + kstep, voffB);
        PG8_WAIT_V(6); PG8_BAR;
    } else {
        PG8_STAGE(PG8_SB(0, 0), cB, voffB); PG8_STAGE(PG8_SA(0, 0), cA, voffA); PG8_STAGE(PG8_SB(0, 1), cB + hstep, voffB); PG8_STAGE(PG8_SA(0, 1), cA + hstep, voffA);
        if (wr == 1) PG8_BAR;
        PG8_WAIT_V(4); PG8_BAR;
        PG8_STAGE(PG8_SB(1, 0), cB + kstep, voffB); PG8_STAGE(PG8_SA(1, 0), cA + kstep, voffA); PG8_STAGE(PG8_SB(1, 1), cB + hstep + kstep, voffB);
        PG8_WAIT_V(6); PG8_BAR;
    }
    for (;;) {
        const bool has_next = S.next(ui + 1, nxt);
        const char* nA = has_next ? (const char*)g.A + (size_t)nxt.pm * tstep : cA; const char* nB = has_next ? (const char*)g.Bt + (size_t)nxt.pn * tstep : cB;
        for (int t = 0; t < nt; t += 2) {
            const bool last = (t == nt - 2);
            const char* a1 = cA + (size_t)(t + 1) * kstep;
            const char* a2 = last ? nA : cA + (size_t)(t + 2) * kstep; const char* b2 = last ? nB : cB + (size_t)(t + 2) * kstep;
            const char* a3 = a2 + kstep; const char* b3 = b2 + kstep;
            if (last && has_next) S.a_ready(nxt);
            if constexpr (SP2) {
            PG8_LDB(B0, 0, 0); PG8_LDB(B1, 0, 1); PG8_SCHED; PG8_LDA(At, 0, 0); PG8_STAGE(PG8_SA(1, 1), a1 + hstep, voffA);
            PG8_WAIT_V(8); PG8_WAIT_L(0); PG8_BAR; PG8_MMA(0, 0, At, B0); PG8_MMA(0, 1, At, B1); PG8_BAR; PG8_SCHED;
            PG8_LDA(At, 0, 1); PG8_STAGE(PG8_SB(0, 0), b2, voffB); PG8_STAGE(PG8_SB(0, 1), b2 + hstep, voffB); PG8_STAGE(PG8_SA(0, 0), a2, voffA);
            PG8_WAIT_V(8); PG8_WAIT_L(0); PG8_BAR; PG8_MMA(1, 0, At, B0); PG8_MMA(1, 1, At, B1); PG8_BAR; PG8_SCHED;
            PG8_LDB(B0, 1, 0); PG8_LDB(B1, 1, 1); PG8_SCHED; PG8_LDA(At, 1, 0); PG8_STAGE(PG8_SA(0, 1), a2 + hstep, voffA);
            PG8_WAIT_V(8); PG8_WAIT_L(0); PG8_BAR; PG8_MMA(0, 0, At, B0); PG8_MMA(0, 1, At, B1); PG8_BAR; PG8_SCHED;
            PG8_LDA(At, 1, 1); PG8_STAGE(PG8_SB(1, 0), b3, voffB); PG8_STAGE(PG8_SB(1, 1), b3 + hstep, voffB); PG8_STAGE(PG8_SA(1, 0), a3, voffA);
            PG8_WAIT_V(8); PG8_WAIT_L(0); PG8_BAR; PG8_MMA(1, 0, At, B0); PG8_MMA(1, 1, At, B1); PG8_BAR; PG8_SCHED;
            } else {
            PG8_LDB(B0, 0, 0); PG8_SCHED; PG8_LDA(At, 0, 0); PG8_STAGE(PG8_SA(1, 1), a1 + hstep, voffA);
            PG8_WAIT_L(8); PG8_BAR; PG8_WAIT_L(0); PG8_MMA(0, 0, At, B0); PG8_BAR; PG8_SCHED;
            PG8_LDB(B1, 0, 1); PG8_STAGE(PG8_SB(0, 0), b2, voffB);
            PG8_BAR; PG8_WAIT_L(0); PG8_MMA(0, 1, At, B1); PG8_BAR;
            PG8_LDA(At, 0, 1); PG8_STAGE(PG8_SA(0, 0), a2, voffA);
            PG8_BAR; PG8_WAIT_L(0); PG8_MMA(1, 0, At, B0); PG8_BAR; PG8_SCHED;
            PG8_STAGE(PG8_SB(0, 1), b2 + hstep, voffB);
            PG8_WAIT_V(6); PG8_BAR; PG8_MMA(1, 1, At, B1); PG8_BAR;
            PG8_LDB(B0, 1, 0); PG8_SCHED; PG8_LDA(At, 1, 0); PG8_STAGE(PG8_SA(0, 1), a2 + hstep, voffA);
            PG8_WAIT_L(8); PG8_BAR; PG8_WAIT_L(0); PG8_MMA(0, 0, At, B0); PG8_BAR; PG8_SCHED;
            PG8_LDB(B1, 1, 1); PG8_STAGE(PG8_SB(1, 0), b3, voffB);
            PG8_BAR; PG8_WAIT_L(0); PG8_MMA(0, 1, At, B1); PG8_BAR;
            PG8_LDA(At, 1, 1); PG8_STAGE(PG8_SA(1, 0), a3, voffA);
            PG8_BAR; PG8_WAIT_L(0); PG8_MMA(1, 0, At, B0); PG8_BAR; PG8_SCHED;
            PG8_STAGE(PG8_SB(1, 1), b3 + hstep, voffB);
            PG8_WAIT_V(6); PG8_BAR; PG8_MMA(1, 1, At, B1); PG8_BAR;
            }
        }
        if constexpr (ALIGN_EPI) { if (wr == 0) PG8_BAR; }
        if constexpr (!Epi::AFTER_DRAIN) { E(acc, cur, wr, wc, fr, fq); S.done(cur); }
        if (!has_next) break;
#pragma unroll
        for (int a = 0; a < 2; ++a)
#pragma unroll
            for (int b = 0; b < 2; ++b)
#pragma unroll
                for (int m = 0; m < 4; ++m)
#pragma unroll
                    for (int n = 0; n < 2; ++n) acc[a][b][m][n] = (f32x4){0.f, 0.f, 0.f, 0.f};
        cur = nxt; cA = nA; cB = nB; ++ui;
        if constexpr (ALIGN_EPI) { if (wr == 1) PG8_BAR; }
    }
    PG8_WAIT_V(0);
    if constexpr (!ALIGN_EPI) { if (wr == 0) PG8_BAR; }
    PG8_BAR;
    if constexpr (Epi::AFTER_DRAIN) { E.fused(acc, cur, wr, wc, fr, fq, lds, wid, lane); S.done(cur); }
#undef PG8_SA
#undef PG8_SB
#undef PG8_STAGE
#undef PG8_LDA
#undef PG8_LDB
#undef PG8_MMA
#undef PG8_WAIT_V
#undef PG8_WAIT_L
#undef PG8_BAR
#undef PG8_SCHED
}
}

#define LAS __attribute__((address_space(3)))
typedef unsigned short bf16;
typedef float f32x4 __attribute__((ext_vector_type(4)));
typedef float f32x2 __attribute__((ext_vector_type(2)));
typedef short bf16x8 __attribute__((ext_vector_type(8)));
typedef unsigned u32x4 __attribute__((ext_vector_type(4)));
typedef unsigned u32x2 __attribute__((ext_vector_type(2)));
typedef __bf16 bf16x2_t __attribute__((ext_vector_type(2)));
typedef short s16x4 __attribute__((ext_vector_type(4)));

constexpr int M = 16384, DM = 1024, NPROJ = 2816, NCHUNK = 256;
constexpr int PJ_Q = 0, PJ_K = 256, PJ_V = 512, PJ_Z = 768, PJ_XBC = 1280, PJ_GLU = 2304;
constexpr int MX_A = 0, MX_B = 256, MX_C = 768;
constexpr size_t MiB = 1u << 20;
constexpr size_t WS_SSQ = 1 * MiB, WS_DT = 2 * MiB, WS_CD = 2 * MiB + 512 * 1024, WS_WIN = 4 * MiB, WS_WOUT = 16 * MiB, WS_WGU = 20 * MiB, WS_WDN = 42 * MiB,
                 WS_XB = 54 * MiB, WS_MIX = 86 * MiB, WS_ST = 118 * MiB, WS_PROJ = 150 * MiB, WS_END = 238 * MiB;
constexpr int LDS_BYTES = 153600;
constexpr float LOG2E = 1.4426950408889634f;
constexpr int NPHASES = 16;

__device__ __forceinline__ float bflo(unsigned u) { return __uint_as_float(u << 16); }
__device__ __forceinline__ float bfhi(unsigned u) { return __uint_as_float(u & 0xffff0000u); }
__device__ __forceinline__ float bf2f(bf16 h) { return __uint_as_float((unsigned)h << 16); }
__device__ __forceinline__ unsigned pk2(float lo, float hi) { f32x2 v = {lo, hi}; bf16x2_t b = __builtin_convertvector(v, bf16x2_t); return __builtin_bit_cast(unsigned, b); }
__device__ __forceinline__ bf16 f2bf(float f) { return (bf16)(pk2(f, 0.f) & 0xffffu); }
__device__ __forceinline__ f32x4 mfma16(bf16x8 a, bf16x8 b, f32x4 c) { return __builtin_amdgcn_mfma_f32_16x16x32_bf16(a, b, c, 0, 0, 0); }
__device__ __forceinline__ float fsilu(float x) { return x * __builtin_amdgcn_rcpf(1.0f + __builtin_amdgcn_exp2f(-LOG2E * x)); }
__device__ __forceinline__ float fsigmoid(float x) { return __builtin_amdgcn_rcpf(1.0f + __builtin_amdgcn_exp2f(-LOG2E * x)); }
__device__ __forceinline__ float fexp(float x) { return __builtin_amdgcn_exp2f(LOG2E * x); }
using pg8::shflx;
__device__ __forceinline__ float wave_sum(float v, int lane) {
#pragma unroll
    for (int o = 1; o < 64; o <<= 1) v += shflx(v, o, lane);
    return v;
}

template <class T> __device__ __forceinline__ T* launder(T* p) { asm volatile("" : "+s"(p)); return p; }
struct Args { const float* in[20]; float* out; unsigned char* ws; int ph_lo, ph_hi, coop, pad; };
struct Ctx {
    LAS unsigned char* lds; int tid, lane, wave, bid, nblk;
    const float* in[20]; float* out;
    bf16 *Win, *Wout, *Wgu, *Wdn, *xb, *mix, *states, *proj;
    float *ssq, *dtraw, *cdecay;
};

struct P0Item { const float* W; const float* gain; bf16* WT; int nsrc, col, valid, K, drow, k0; };
__device__ __forceinline__ P0Item p0_decode(const Ctx& C, int it) {
    constexpr int I_IN = 16 * 96, I_OUT = 16 * 32, I_GU = 16 * 176, I_DN = 44 * 32, I_L = I_IN + I_OUT + I_GU + I_DN;
    P0Item P; const int l = it / I_L; int r = it % I_L;
    if (r < I_IN) {
        const int kb = r / 96, n0 = 32 * (r % 96);
        int col, valid;
        if (n0 < 2304) { col = n0; valid = 32; } else if (n0 < 2816) { col = n0 + 8; valid = 32; } else if (n0 == 2816) { col = 2304; valid = 8; } else { col = 0; valid = 0; }
        P.W = C.in[2] + (size_t)l * 1024 * 2824; P.nsrc = 2824; P.col = col; P.valid = valid; P.gain = C.in[1] + l * 1024; P.K = 1024; P.WT = C.Win + (size_t)l * 3072 * 1024; P.drow = n0; P.k0 = 64 * kb;
        return P;
    }
    r -= I_IN;
    if (r < I_OUT) { const int kb = r / 32, n0 = 32 * (r % 32);
        P.W = C.in[14] + (size_t)l * 1024 * 1024; P.nsrc = 1024; P.col = n0; P.valid = 32; P.gain = nullptr; P.K = 1024; P.WT = C.Wout + (size_t)l * 1024 * 1024; P.drow = n0; P.k0 = 64 * kb; return P; }
    r -= I_OUT;
    if (r < I_GU) { const int kb = r / 176, n0 = 32 * (r % 176); const int t = n0 >> 8, hs = (n0 >> 7) & 1, i = n0 & 127;
        P.W = (hs ? C.in[17] : C.in[16]) + (size_t)l * 1024 * 2816; P.nsrc = 2816; P.col = 128 * t + i; P.valid = 32; P.gain = C.in[15] + l * 1024; P.K = 1024; P.WT = C.Wgu + (size_t)l * 5632 * 1024; P.drow = n0; P.k0 = 64 * kb; return P; }
    r -= I_GU;
    { const int kb = r / 32, n0 = 32 * (r % 32);
        P.W = C.in[18] + (size_t)l * 2816 * 1024; P.nsrc = 1024; P.col = n0; P.valid = 32; P.gain = nullptr; P.K = 2816; P.WT = C.Wdn + (size_t)l * 1024 * 2816; P.drow = n0; P.k0 = 64 * kb; return P; }
}
__device__ __forceinline__ void p0_load(const P0Item& P, float (&wv)[32], int lane) {
    const int c31 = lane & 31;
#pragma unroll
    for (int i = 0; i < 32; ++i) { const int kk = 2 * i + (lane >> 5); wv[i] = (c31 < P.valid) ? __builtin_nontemporal_load(P.W + (size_t)(P.k0 + kk) * P.nsrc + P.col + c31) : 0.f; }
}
__device__ __forceinline__ void p0_finish(const P0Item& P, float (&wv)[32], LAS float* scr, int lane) {
    const int c31 = lane & 31;
    if (P.gain) {
#pragma unroll
        for (int i = 0; i < 32; ++i) wv[i] *= P.gain[P.k0 + 2 * i + (lane >> 5)];
    }
#pragma unroll
    for (int i = 0; i < 32; ++i) scr[(2 * i + (lane >> 5)) * 33 + c31] = wv[i];
    const int c = lane & 7;
#pragma unroll
    for (int j = 0; j < 4; ++j) {
        const int n = (lane >> 3) + 8 * j; const LAS float* s = scr + (8 * c) * 33 + n;
        u32x4 o; o.x = pk2(s[0 * 33], s[1 * 33]); o.y = pk2(s[2 * 33], s[3 * 33]); o.z = pk2(s[4 * 33], s[5 * 33]); o.w = pk2(s[6 * 33], s[7 * 33]);
        *(u32x4*)(P.WT + (size_t)(P.drow + n) * P.K + P.k0 + 8 * c) = o;
    }
}
__device__ __forceinline__ void p0_convert(const Ctx& C, int it_begin, int it_end, int gw, int NGW, LAS float* scr, int lane) {
#pragma unroll 1
    for (int it = it_begin + gw; it < it_end; it += NGW) {
        float wa[32];
        const P0Item pa = p0_decode(C, it);
        p0_load(pa, wa, lane);
        p0_finish(pa, wa, scr, lane);
    }
}
constexpr int P0_FIRST = 16 * 96;
constexpr int P0_SPLIT = (16 * 96 + 16 * 32 + 16 * 176 + 44 * 32) + 16 * 96;
constexpr int P0_ALL = 2 * (16 * 96 + 16 * 32 + 16 * 176 + 44 * 32);
#ifndef M1P
#define M1P 7
#endif
__device__ __forceinline__ void ssd_dt_acs(const Ctx& C, int layer, int ck, LAS float* sDT, LAS float* sACS, LAS float* sW, bool has_w, int lane, int wave) {
    const int h = wave, t0 = ck * 64;
    const float raw = C.dtraw[(size_t)(t0 + lane) * 8 + h] + C.in[6][layer * 8 + h];
    const float dt = fmaxf(raw, 0.f) + log1pf(expf(-fabsf(raw)));
    const float av = -expf(C.in[7][layer * 8 + h]) * dt;
    float cs = av;
#pragma unroll
    for (int o = 1; o < 64; o <<= 1) { const float v = __int_as_float(__builtin_amdgcn_ds_bpermute(((lane - o) & 63) << 2, __float_as_int(cs))); if (lane >= o) cs += v; }
    const float aend = __int_as_float(__builtin_amdgcn_readlane(__float_as_int(cs), 63));
    sDT[h * 64 + lane] = dt; sACS[h * 64 + lane] = cs;
    if (has_w) { sW[h * 64 + lane] = dt * expf(aend - cs); if (lane == 63) C.cdecay[ck * 8 + h] = expf(cs); }
}

__device__ __forceinline__ void mix1_phase(const Ctx& C, int layer) {
    LAS float* sDT = (LAS float*)(C.lds); LAS float* sACS = (LAS float*)(C.lds + 2048); LAS float* sW = (LAS float*)(C.lds + 4096);
    LAS bf16* sT = (LAS bf16*)(C.lds + 8192);
    for (int ck = ((C.nblk & 7) == 0 ? (C.bid & 7) * (C.nblk >> 3) + (C.bid >> 3) : C.bid); ck < NCHUNK; ck += C.nblk) {
        int tid = C.tid; asm volatile("" : "+v"(tid));
        const int lane = tid & 63, wave = __builtin_amdgcn_readfirstlane(tid >> 6), fr = lane & 15, fq = lane >> 4;
        const int cin = ck & 127, t0 = ck * 64; const bool first = (cin == 0);
        const float* cw = launder(C.in[4]) + (size_t)layer * 4 * 1024; const float* cb = launder(C.in[5]) + layer * 1024;
        ssd_dt_acs(C, layer, ck, sDT, sACS, sW, true, lane, wave);
        __syncthreads();
        if (tid < 384) {
            const int ch0 = 2 * tid;
            const f32x2 w0 = *(const f32x2*)(cw + 0 * 1024 + ch0), w1 = *(const f32x2*)(cw + 1 * 1024 + ch0), w2 = *(const f32x2*)(cw + 2 * 1024 + ch0), w3 = *(const f32x2*)(cw + 3 * 1024 + ch0);
            const f32x2 bb = *(const f32x2*)(cb + ch0);
            const unsigned* src = (const unsigned*)(C.proj + (size_t)t0 * NPROJ + PJ_XBC + ch0);
            f32x2 xm3 = {0.f, 0.f}, xm2 = {0.f, 0.f}, xm1 = {0.f, 0.f};
            if (!first) { const unsigned a = src[-3 * (NPROJ / 2)], b = src[-2 * (NPROJ / 2)], c = src[-1 * (NPROJ / 2)];
                xm3 = (f32x2){bflo(a), bfhi(a)}; xm2 = (f32x2){bflo(b), bfhi(b)}; xm1 = (f32x2){bflo(c), bfhi(c)}; }
            const int hh = ch0 >> 6; const bool isx = ch0 < 512;
#pragma unroll 1
            for (int l0 = 0; l0 < 64; l0 += 16) {
            unsigned uu[16];
#pragma unroll
            for (int i = 0; i < 16; ++i) uu[i] = src[(l0 + i) * (NPROJ / 2)];
#pragma unroll
            for (int li = 0; li < 16; li += 2) {
                const int l = l0 + li;
                const unsigned ua = uu[li], ub = uu[li + 1];
                const f32x2 xa = {bflo(ua), bfhi(ua)}, xc = {bflo(ub), bfhi(ub)};
                f32x2 ya = bb + w0 * xm3 + w1 * xm2 + w2 * xm1 + w3 * xa;
                f32x2 yb = bb + w0 * xm2 + w1 * xm1 + w2 * xa + w3 * xc;
                xm3 = xm1; xm2 = xa; xm1 = xc;
                ya.x = fsilu(ya.x); ya.y = fsilu(ya.y); yb.x = fsilu(yb.x); yb.y = fsilu(yb.y);
                if (isx) { const float wa = sW[hh * 64 + l], wb = sW[hh * 64 + l + 1]; ya = ya * wa; yb = yb * wb; }
                *(LAS unsigned*)(sT + ch0 * 72 + l) = pk2(ya.x, yb.x);
                *(LAS unsigned*)(sT + (ch0 + 1) * 72 + l) = pk2(ya.y, yb.y);
            }
            }
        }
        __syncthreads();
        if (M1P & 1) {
            const int h = wave, g = h >> 2;
            bf16x8 xf[4][2];
#pragma unroll
            for (int pt = 0; pt < 4; ++pt)
#pragma unroll
                for (int ks = 0; ks < 2; ++ks) xf[pt][ks] = *(const LAS bf16x8*)(sT + (h * 64 + 16 * pt + fr) * 72 + 32 * ks + 8 * fq);
            bf16* st = C.states + (size_t)(ck * 8 + h) * 64 * 128;
#pragma unroll 1
            for (int nt = 0; nt < 8; ++nt) {
                bf16x8 bfr[2];
#pragma unroll
                for (int ks = 0; ks < 2; ++ks) bfr[ks] = *(const LAS bf16x8*)(sT + (512 + g * 128 + 16 * nt + fr) * 72 + 32 * ks + 8 * fq);
#pragma unroll
                for (int pt = 0; pt < 4; ++pt) {
                    f32x4 acc = {0.f, 0.f, 0.f, 0.f};
#pragma unroll
                    for (int ks = 0; ks < 2; ++ks) acc = mfma16(bfr[ks], xf[pt][ks], acc);
                    u32x2 w; w.x = pk2(acc[0], acc[1]); w.y = pk2(acc[2], acc[3]);
                    *(u32x2*)(st + (16 * pt + fr) * 128 + 16 * nt + 4 * fq) = w;
                }
            }
        }
        __syncthreads();
        if (M1P & 2) {
            LAS bf16* G = (LAS bf16*)(C.lds + 8192);
            LAS float* CO = (LAS float*)(C.lds + 8192 + 48128);
            const int c = tid & 255, half = tid >> 8;
#pragma unroll
            for (int it = 0; it < 6; ++it) {
                const int u = tid + 512 * it, r = u >> 5, c8 = u & 31;
                if (u < 94 * 32) {
                    u32x4 o = {0u, 0u, 0u, 0u};
                    if (!(first && r < 30)) {
                        const bf16* p = C.proj + (size_t)(t0 - 30 + r) * NPROJ + PJ_GLU + 8 * c8;
                        const u32x4 av = *(const u32x4*)p, gv = *(const u32x4*)(p + 256);
#pragma unroll
                        for (int e = 0; e < 4; ++e) o[e] = pk2(bflo(av[e]) * fsigmoid(bflo(gv[e])), bfhi(av[e]) * fsigmoid(bfhi(gv[e])));
                    }
                    *(LAS u32x4*)(G + r * 256 + 8 * c8) = o;
                }
            }
            __syncthreads();
            {
                const float* dww = launder(C.in[10]) + (size_t)layer * 31 * 256 + c;
                float w[31];
#pragma unroll
                for (int k = 0; k < 31; ++k) w[k] = dww[k * 256];
                const float bias = launder(C.in[11])[layer * 256 + c];
#pragma unroll 1
                for (int grp = 0; grp < 4; ++grp) {
                    float o[8];
#pragma unroll
                    for (int i = 0; i < 8; ++i) o[i] = bias;
                    const LAS bf16* gp = G + (half * 32 + grp * 8) * 256 + c;
#pragma unroll
                    for (int r = 0; r < 38; ++r) {
                        const float v = bf2f(gp[r * 256]);
#pragma unroll
                        for (int i = 0; i < 8; ++i) { const int k = r - i; if (k >= 0 && k <= 30) o[i] += w[k] * v; }
                    }
#pragma unroll
                    for (int i = 0; i < 8; ++i) CO[(half * 32 + grp * 8 + i) * 256 + c] = o[i];
                }
            }
            __syncthreads();
            {
                const f32x4 lg = *((const f32x4*)(launder(C.in[12]) + layer * 256) + lane), lb = *((const f32x4*)(launder(C.in[13]) + layer * 256) + lane);
#pragma unroll 2
                for (int i = 0; i < 8; ++i) {
                    const int l = wave * 8 + i;
                    const f32x4 v = *((const LAS f32x4*)(CO + l * 256) + lane);
                    const float s = wave_sum((v[0] + v[1]) + (v[2] + v[3]), lane);
                    const float mu = s * (1.f / 256.f);
                    const f32x4 d = v - mu;
                    const float s2 = wave_sum((d[0] * d[0] + d[1] * d[1]) + (d[2] * d[2] + d[3] * d[3]), lane);
                    const float rstd = 1.0f / sqrtf(s2 * (1.f / 256.f) + 1e-6f);
                    const f32x4 y = d * rstd * lg + lb;
                    u32x2 w; w.x = pk2(fsilu(y[0]), fsilu(y[1])); w.y = pk2(fsilu(y[2]), fsilu(y[3]));
                    *((u32x2*)(C.mix + (size_t)(t0 + l) * DM + MX_C) + lane) = w;
                }
            }
        }
        __syncthreads();
        __syncthreads();
    }
}

__device__ __forceinline__ void aux_phase(const Ctx& C, int mode, int layer) {
    int cb = 0, ce = 0, gw = 0, ngw = 1;
    if (mode == 0) {
        const int NGW = C.nblk * 8; gw = C.bid * 8 + C.wave; const int lane = C.lane;
        const float* x = C.in[0];
    for (int row0 = gw * 2; row0 < M; row0 += NGW * 2) {
        f32x4 v[2][4];
#pragma unroll
        for (int r = 0; r < 2; ++r)
#pragma unroll
            for (int j = 0; j < 4; ++j) v[r][j] = __builtin_nontemporal_load((const f32x4*)(x + (size_t)(row0 + r) * DM) + lane + 64 * j);
#pragma unroll
        for (int r = 0; r < 2; ++r) {
            float s = 0.f;
#pragma unroll
            for (int j = 0; j < 4; ++j) s += (v[r][j][0] * v[r][j][0] + v[r][j][1] * v[r][j][1]) + (v[r][j][2] * v[r][j][2] + v[r][j][3] * v[r][j][3]);
            s = wave_sum(s, lane);
            u32x2* o = (u32x2*)(C.xb + (size_t)(row0 + r) * DM) + lane;
#pragma unroll
            for (int j = 0; j < 4; ++j) { u32x2 w; w.x = pk2(v[r][j][0], v[r][j][1]); w.y = pk2(v[r][j][2], v[r][j][3]); o[64 * j] = w; }
            if (lane < 16) C.ssq[(size_t)(row0 + r) * 16 + lane] = (lane == 0) ? s : 0.f;
        }
    }

        cb = 0; ce = P0_FIRST; ngw = NGW;
    }
    if (ce > cb) p0_convert(C, cb, ce, gw, ngw, (LAS float*)(C.lds + C.wave * 8448), C.lane);
}


__device__ __forceinline__ void scanatt_phase(const Ctx& C, int layer) {
    LAS float* sBias = (LAS float*)(C.lds + 143360);
    for (int i = C.tid; i < 4 * 257; i += 512) sBias[i] = C.in[3][layer * 4 * 257 + i] * LOG2E;
    const bool scanner = C.tid < 256;
    const int gt0 = C.bid * 256 + (C.tid & 255);
    const int sb_ = gt0 >> 15, se2 = gt0 & 32767;
    unsigned* sp = (unsigned*)C.states + (size_t)(sb_ & 1) * 128 * 32768 + se2;
    const float* scd = C.cdecay + (sb_ & 1) * 128 * 8 + (se2 >> 12);
    float s0 = 0.f, s1 = 0.f; int sc0 = (scanner && gt0 < 65536) ? 0 : 128;
    const int cve2 = 2 * (layer == 0 ? P0_SPLIT : P0_ALL), cngw2 = C.nblk * 4;
    int cit2 = scanner ? cve2 : 2 * (layer == 0 ? P0_FIRST : P0_SPLIT) + C.bid * 4 + (C.wave - 4);
    LAS float* scr = (LAS float*)(C.lds + 75776 + (C.wave & 3) * 8448);
    P0Item pa = p0_decode(C, 0); int k0h = 0;
    unsigned fb[16]; bool pend = false;
#define BG_ISSUE() do { if (scanner) { if (sc0 < 128) { _Pragma("unroll") for (int i_ = 0; i_ < 16; ++i_) fb[i_] = __builtin_nontemporal_load(sp + (size_t)(sc0 + i_) * 32768); pend = true; } } \
        else if (cit2 < cve2) { pa = p0_decode(C, cit2 >> 1); k0h = pa.k0 + 32 * (cit2 & 1); const int c31_ = C.lane & 31; \
            _Pragma("unroll") for (int i_ = 0; i_ < 16; ++i_) { const int kk_ = 2 * i_ + (C.lane >> 5); fb[i_] = (c31_ < pa.valid) ? __float_as_uint(__builtin_nontemporal_load(pa.W + (size_t)(k0h + kk_) * pa.nsrc + pa.col + c31_)) : 0u; } \
            pend = true; } } while (0)
#define BG_CONSUME() do { if (pend) { if (scanner) { _Pragma("unroll") for (int i_ = 0; i_ < 16; ++i_) { const float d_ = scd[(sc0 + i_) * 8]; sp[(size_t)(sc0 + i_) * 32768] = pk2(s0, s1); \
                const unsigned u_ = fb[i_]; s0 = s0 * d_ + bflo(u_); s1 = s1 * d_ + bfhi(u_); } sc0 += 16; } \
            else { const int c31_ = C.lane & 31; \
                _Pragma("unroll") for (int i_ = 0; i_ < 16; ++i_) { const int kk_ = 2 * i_ + (C.lane >> 5); float v_ = __uint_as_float(fb[i_]); if (pa.gain) v_ *= pa.gain[k0h + kk_]; scr[kk_ * 33 + c31_] = v_; } \
                const int c_ = C.lane & 3; \
                _Pragma("unroll") for (int j_ = 0; j_ < 2; ++j_) { const int n_ = (C.lane >> 2) + 16 * j_; const LAS float* s_ = scr + (8 * c_) * 33 + n_; \
                    u32x4 o_; o_.x = pk2(s_[0 * 33], s_[1 * 33]); o_.y = pk2(s_[2 * 33], s_[3 * 33]); o_.z = pk2(s_[4 * 33], s_[5 * 33]); o_.w = pk2(s_[6 * 33], s_[7 * 33]); \
                    *(u32x4*)(pa.WT + (size_t)(pa.drow + n_) * pa.K + k0h + 8 * c_) = o_; } \
                cit2 += cngw2; } \
            pend = false; } } while (0)
    for (int ck = ((C.nblk & 7) == 0 ? (C.bid & 7) * (C.nblk >> 3) + (C.bid >> 3) : C.bid); ck < NCHUNK; ck += C.nblk) {
        int tid = C.tid; asm volatile("" : "+v"(tid));
        const int lane = tid & 63, wave = __builtin_amdgcn_readfirstlane(tid >> 6), fr = lane & 15, fq = lane >> 4;
        const int cin = ck & 127, t0 = ck * 64;
        {
            LAS bf16* sK = (LAS bf16*)(C.lds + 8192);
            LAS bf16* sV = (LAS bf16*)(C.lds + 8192 + 33792);
            const int h = wave >> 1, qh = wave & 1, q4 = (lane & 15) >> 2, p4 = lane & 3;
            bf16x8 qf[2][2];
#pragma unroll
            for (int qt = 0; qt < 2; ++qt)
#pragma unroll
                for (int ks = 0; ks < 2; ++ks) qf[qt][ks] = *(const bf16x8*)(C.proj + (size_t)(t0 + 32 * qh + 16 * qt + fr) * NPROJ + PJ_Q + h * 64 + 32 * ks + 8 * fq);
            float mrun[2] = {-1e30f, -1e30f}, lsum[2] = {0.f, 0.f};
            f32x4 oacc[4][2];
#pragma unroll
            for (int dt = 0; dt < 4; ++dt)
#pragma unroll
                for (int qt = 0; qt < 2; ++qt) oacc[dt][qt] = (f32x4){0.f, 0.f, 0.f, 0.f};
            const int jmin = cin >= 8 ? 0 : 8 - cin;
            u32x4 kreg[4], vreg[4];
#define ATT_LOAD(jj) do { const bf16* base_ = C.proj + (size_t)(t0 + ((jj) - 8) * 64) * NPROJ; _Pragma("unroll") for (int i = 0; i < 4; ++i) { const int u = tid + 512 * i, row = u >> 5, c8 = u & 31; \
                kreg[i] = *(const u32x4*)(base_ + (size_t)row * NPROJ + PJ_K + 8 * c8); vreg[i] = *(const u32x4*)(base_ + (size_t)row * NPROJ + PJ_V + 8 * c8); } } while (0)
            ATT_LOAD(jmin);
            for (int j = jmin; j <= 8; ++j) {
#pragma unroll
                for (int i = 0; i < 4; ++i) { const int u = tid + 512 * i, row = u >> 5, c8 = u & 31;
                    *(LAS u32x4*)(sK + row * 264 + 8 * c8) = kreg[i]; *(LAS u32x4*)(sV + row * 264 + 8 * c8) = vreg[i]; }
                __syncthreads();
                if (j < 8) ATT_LOAD(j + 1);
                BG_ISSUE();
                f32x4 st[4][2];
#pragma unroll
                for (int kt = 0; kt < 4; ++kt) {
                    bf16x8 kf[2];
#pragma unroll
                    for (int ks = 0; ks < 2; ++ks) kf[ks] = *(const LAS bf16x8*)(sK + (16 * kt + fr) * 264 + h * 64 + 32 * ks + 8 * fq);
#pragma unroll
                    for (int qt = 0; qt < 2; ++qt) { f32x4 acc = {0.f, 0.f, 0.f, 0.f};
#pragma unroll
                        for (int ks = 0; ks < 2; ++ks) acc = mfma16(kf[ks], qf[qt][ks], acc);
                        st[kt][qt] = acc; }
                }
                if (j >= 6) {
#pragma unroll
                    for (int kt = 0; kt < 4; ++kt)
#pragma unroll
                        for (int qt = 0; qt < 2; ++qt)
#pragma unroll
                            for (int e = 0; e < 4; ++e) {
                                const int rel = (32 * qh + 16 * qt + fr) + 512 - 64 * j - (16 * kt + 4 * fq + e);
                                const int idx = (rel < -128 ? -128 : (rel > 128 ? 128 : rel)) + 128;
                                st[kt][qt][e] += sBias[h * 257 + idx];
                            }
                } else {
                    const float bc = sBias[h * 257 + 256];
#pragma unroll
                    for (int kt = 0; kt < 4; ++kt)
#pragma unroll
                        for (int qt = 0; qt < 2; ++qt) st[kt][qt] = st[kt][qt] + bc;
                }
#pragma unroll
                for (int qt = 0; qt < 2; ++qt) {
                    float mx = -1e30f;
#pragma unroll
                    for (int kt = 0; kt < 4; ++kt)
#pragma unroll
                        for (int e = 0; e < 4; ++e) mx = fmaxf(mx, st[kt][qt][e]);
                    mx = fmaxf(mx, shflx(mx, 16, lane)); mx = fmaxf(mx, shflx(mx, 32, lane));
                    const float mnew = fmaxf(mrun[qt], mx), alpha = __builtin_amdgcn_exp2f(mrun[qt] - mnew);
                    mrun[qt] = mnew;
                    float ps = 0.f;
#pragma unroll
                    for (int kt = 0; kt < 4; ++kt)
#pragma unroll
                        for (int e = 0; e < 4; ++e) { const float p = __builtin_amdgcn_exp2f(st[kt][qt][e] - mnew); st[kt][qt][e] = p; ps += p; }
                    lsum[qt] = lsum[qt] * alpha + ps;
#pragma unroll
                    for (int dt = 0; dt < 4; ++dt) oacc[dt][qt] = oacc[dt][qt] * alpha;
                }
                bf16x8 pf[2][2];
#pragma unroll
                for (int s2 = 0; s2 < 2; ++s2)
#pragma unroll
                    for (int qt = 0; qt < 2; ++qt) {
                        u32x4 w; w.x = pk2(st[2 * s2][qt][0], st[2 * s2][qt][1]); w.y = pk2(st[2 * s2][qt][2], st[2 * s2][qt][3]);
                        w.z = pk2(st[2 * s2 + 1][qt][0], st[2 * s2 + 1][qt][1]); w.w = pk2(st[2 * s2 + 1][qt][2], st[2 * s2 + 1][qt][3]);
                        pf[s2][qt] = __builtin_bit_cast(bf16x8, w);
                    }
#pragma unroll
                for (int dt = 0; dt < 4; ++dt)
#pragma unroll
                    for (int s2 = 0; s2 < 2; ++s2) {
                        const s16x4 lo = __builtin_amdgcn_ds_read_tr16_b64_v4i16((LAS s16x4*)(sV + (32 * s2 + 4 * fq + q4) * 264 + h * 64 + 16 * dt + 4 * p4));
                        const s16x4 hi = __builtin_amdgcn_ds_read_tr16_b64_v4i16((LAS s16x4*)(sV + (32 * s2 + 16 + 4 * fq + q4) * 264 + h * 64 + 16 * dt + 4 * p4));
                        const bf16x8 vf = __builtin_shufflevector(lo, hi, 0, 1, 2, 3, 4, 5, 6, 7);
#pragma unroll
                        for (int qt = 0; qt < 2; ++qt) oacc[dt][qt] = mfma16(vf, pf[s2][qt], oacc[dt][qt]);
                    }
                BG_CONSUME();
                __syncthreads();
            }
#undef ATT_LOAD
#pragma unroll
            for (int qt = 0; qt < 2; ++qt) {
                float l = lsum[qt]; l += shflx(l, 16, lane); l += shflx(l, 32, lane);
                const float inv = 1.0f / l;
                bf16* op = C.mix + (size_t)(t0 + 32 * qh + 16 * qt + fr) * DM + MX_A + h * 64 + 4 * fq;
#pragma unroll
                for (int dt = 0; dt < 4; ++dt) { u32x2 w; w.x = pk2(oacc[dt][qt][0] * inv, oacc[dt][qt][1] * inv); w.y = pk2(oacc[dt][qt][2] * inv, oacc[dt][qt][3] * inv);
                    *(u32x2*)(op + 16 * dt) = w; }
            }
        }
        __syncthreads();
    }
    while (sc0 < 128 || cit2 < cve2) { BG_ISSUE(); BG_CONSUME(); }
#undef BG_ISSUE
#undef BG_CONSUME
    if (scanner)
        for (int gt = gt0 + C.nblk * 256; gt < 65536; gt += C.nblk * 256) {
            const int b = gt >> 15, e2 = gt & 32767;
            unsigned* q = (unsigned*)C.states + (size_t)b * 128 * 32768 + e2; const float* cd = C.cdecay + b * 128 * 8 + (e2 >> 12);
            float t0_ = 0.f, t1_ = 0.f;
#pragma unroll 1
            for (int c = 0; c < 128; ++c) { const unsigned u = q[(size_t)c * 32768]; const float d = cd[c * 8]; q[(size_t)c * 32768] = pk2(t0_, t1_); t0_ = t0_ * d + bflo(u); t1_ = t1_ * d + bfhi(u); }
        }
}

__device__ __forceinline__ void mix3_phase(const Ctx& C, int layer) {
    LAS float* sDT = (LAS float*)(C.lds); LAS float* sACS = (LAS float*)(C.lds + 2048); LAS float* sPART = (LAS float*)(C.lds + 4096);
    LAS bf16* sC = (LAS bf16*)(C.lds + 8192);
    LAS bf16* sB = (LAS bf16*)(C.lds + 41984);
    LAS float* sCB = (LAS float*)(C.lds + 41984);
    LAS bf16* sXT = (LAS bf16*)(C.lds + 75776);
    for (int ck = ((C.nblk & 7) == 0 ? (C.bid & 7) * (C.nblk >> 3) + (C.bid >> 3) : C.bid); ck < NCHUNK; ck += C.nblk) {
        int tid = C.tid; asm volatile("" : "+v"(tid));
        const int lane = tid & 63, wave = __builtin_amdgcn_readfirstlane(tid >> 6), fr = lane & 15, fq = lane >> 4;
        const int cin = ck & 127, t0 = ck * 64; const bool first = (cin == 0);
        const float* cw = launder(C.in[4]) + (size_t)layer * 4 * 1024; const float* cb = launder(C.in[5]) + layer * 1024;
        ssd_dt_acs(C, layer, ck, sDT, sACS, sPART, false, lane, wave);
        {
            const int ch0 = 2 * tid;
            const f32x2 w0 = *(const f32x2*)(cw + 0 * 1024 + ch0), w1 = *(const f32x2*)(cw + 1 * 1024 + ch0), w2 = *(const f32x2*)(cw + 2 * 1024 + ch0), w3 = *(const f32x2*)(cw + 3 * 1024 + ch0);
            const f32x2 bb = *(const f32x2*)(cb + ch0);
            const unsigned* src = (const unsigned*)(C.proj + (size_t)t0 * NPROJ + PJ_XBC + ch0);
            f32x2 xm3 = {0.f, 0.f}, xm2 = {0.f, 0.f}, xm1 = {0.f, 0.f};
            if (!first) { const unsigned a = src[-3 * (NPROJ / 2)], b = src[-2 * (NPROJ / 2)], c = src[-1 * (NPROJ / 2)];
                xm3 = (f32x2){bflo(a), bfhi(a)}; xm2 = (f32x2){bflo(b), bfhi(b)}; xm1 = (f32x2){bflo(c), bfhi(c)}; }
            LAS bf16* nat = (ch0 < 768) ? (sB + (ch0 - 512)) : (sC + (ch0 - 768));
#pragma unroll 1
            for (int l0 = 0; l0 < 64; l0 += 16) {
            unsigned uu[16];
#pragma unroll
            for (int i = 0; i < 16; ++i) uu[i] = src[(l0 + i) * (NPROJ / 2)];
#pragma unroll
            for (int li = 0; li < 16; li += 2) {
                const int l = l0 + li;
                const unsigned ua = uu[li], ub = uu[li + 1];
                const f32x2 xa = {bflo(ua), bfhi(ua)}, xc = {bflo(ub), bfhi(ub)};
                f32x2 ya = bb + w0 * xm3 + w1 * xm2 + w2 * xm1 + w3 * xa;
                f32x2 yb = bb + w0 * xm2 + w1 * xm1 + w2 * xa + w3 * xc;
                xm3 = xm1; xm2 = xa; xm1 = xc;
                ya.x = fsilu(ya.x); ya.y = fsilu(ya.y); yb.x = fsilu(yb.x); yb.y = fsilu(yb.y);
                if (ch0 < 512) {
                    *(LAS unsigned*)(sXT + ch0 * 72 + l) = pk2(ya.x, yb.x);
                    *(LAS unsigned*)(sXT + (ch0 + 1) * 72 + l) = pk2(ya.y, yb.y);
                } else {
                    *(LAS unsigned*)(nat + l * 264) = pk2(ya.x, ya.y);
                    *(LAS unsigned*)(nat + (l + 1) * 264) = pk2(yb.x, yb.y);
                }
            }
            }
        }
        __syncthreads();
        {
            const int g = wave >> 2, lt = wave & 3;
            f32x4 acc[4];
#pragma unroll
            for (int st = 0; st < 4; ++st) acc[st] = (f32x4){0.f, 0.f, 0.f, 0.f};
#pragma unroll
            for (int ks = 0; ks < 4; ++ks) {
                const bf16x8 af = *(const LAS bf16x8*)(sC + (16 * lt + fr) * 264 + g * 128 + 32 * ks + 8 * fq);
#pragma unroll
                for (int st = 0; st < 4; ++st) { const bf16x8 bfr = *(const LAS bf16x8*)(sB + (16 * st + fr) * 264 + g * 128 + 32 * ks + 8 * fq); acc[st] = mfma16(af, bfr, acc[st]); }
            }
            __syncthreads();
#pragma unroll
            for (int st = 0; st < 4; ++st)
#pragma unroll
                for (int e = 0; e < 4; ++e) sCB[(g * 64 + 16 * lt + 4 * fq + e) * 66 + 16 * st + fr] = acc[st][e];
        }
        __syncthreads();
        {
            const int h = wave, g = h >> 2;
            f32x4 acc[4][4];
#pragma unroll
            for (int lt = 0; lt < 4; ++lt)
#pragma unroll
                for (int pt = 0; pt < 4; ++pt) acc[lt][pt] = (f32x4){0.f, 0.f, 0.f, 0.f};
            const bf16* prev = C.states + (size_t)(ck * 8 + h) * 64 * 128;
#pragma unroll
            for (int ks = 0; ks < 4; ++ks) {
                bf16x8 cf[4];
#pragma unroll
                for (int lt = 0; lt < 4; ++lt) cf[lt] = *(const LAS bf16x8*)(sC + (16 * lt + fr) * 264 + g * 128 + 32 * ks + 8 * fq);
#pragma unroll
                for (int pt = 0; pt < 4; ++pt) {
                    const bf16x8 pfr = *(const bf16x8*)(prev + (16 * pt + fr) * 128 + 32 * ks + 8 * fq);
#pragma unroll
                    for (int lt = 0; lt < 4; ++lt) acc[lt][pt] = mfma16(pfr, cf[lt], acc[lt][pt]);
                }
                __builtin_amdgcn_sched_barrier(0);
            }
#pragma unroll
            for (int lt = 0; lt < 4; ++lt) {
                const float ea = fexp(sACS[h * 64 + 16 * lt + fr]);
#pragma unroll
                for (int pt = 0; pt < 4; ++pt) acc[lt][pt] = acc[lt][pt] * ea;
            }
#pragma unroll
            for (int ks2 = 0; ks2 < 2; ++ks2) {
                bf16x8 xf[4];
#pragma unroll
                for (int pt = 0; pt < 4; ++pt) xf[pt] = *(const LAS bf16x8*)(sXT + (h * 64 + 16 * pt + fr) * 72 + 32 * ks2 + 8 * fq);
                const f32x4 as0 = *(const LAS f32x4*)(sACS + h * 64 + 32 * ks2 + 8 * fq), as1 = *(const LAS f32x4*)(sACS + h * 64 + 32 * ks2 + 8 * fq + 4);
                const f32x4 dt0 = *(const LAS f32x4*)(sDT + h * 64 + 32 * ks2 + 8 * fq), dt1 = *(const LAS f32x4*)(sDT + h * 64 + 32 * ks2 + 8 * fq + 4);
#pragma unroll
                for (int lt = 0; lt < 4; ++lt) {
                    if (ks2 == 1 && lt < 2) continue;
                    const int l = 16 * lt + fr; const float al = sACS[h * 64 + l];
                    const LAS f32x2* cbp = (const LAS f32x2*)(sCB + (g * 64 + l) * 66 + 32 * ks2 + 8 * fq);
                    const f32x2 c01 = cbp[0], c23 = cbp[1], c45 = cbp[2], c67 = cbp[3];
                    const float cbv[8] = {c01.x, c01.y, c23.x, c23.y, c45.x, c45.y, c67.x, c67.y};
                    const float asv[8] = {as0[0], as0[1], as0[2], as0[3], as1[0], as1[1], as1[2], as1[3]};
                    const float dtv[8] = {dt0[0], dt0[1], dt0[2], dt0[3], dt1[0], dt1[1], dt1[2], dt1[3]};
                    float v[8];
#pragma unroll
                    for (int jj = 0; jj < 8; ++jj) { const int sidx = 32 * ks2 + 8 * fq + jj; const float t = cbv[jj] * fexp(al - asv[jj]) * dtv[jj]; v[jj] = (sidx <= l) ? t : 0.f; }
                    u32x4 w; w.x = pk2(v[0], v[1]); w.y = pk2(v[2], v[3]); w.z = pk2(v[4], v[5]); w.w = pk2(v[6], v[7]);
                    const bf16x8 af = __builtin_bit_cast(bf16x8, w);
#pragma unroll
                    for (int pt = 0; pt < 4; ++pt) acc[lt][pt] = mfma16(xf[pt], af, acc[lt][pt]);
                }
            }
            const float Dh = launder(C.in[8])[layer * 8 + h];
#pragma unroll
            for (int lt = 0; lt < 4; ++lt) {
                const int l = 16 * lt + fr; float q = 0.f;
#pragma unroll
                for (int pt = 0; pt < 4; ++pt) {
                    const int p0 = 16 * pt + 4 * fq;
                    const u32x2 zz = *(const u32x2*)(C.proj + (size_t)(t0 + l) * NPROJ + PJ_Z + h * 64 + p0);
                    const float zv[4] = {bflo(zz.x), bfhi(zz.x), bflo(zz.y), bfhi(zz.y)};
#pragma unroll
                    for (int e = 0; e < 4; ++e) {
                        const float xv = bf2f(sXT[(h * 64 + p0 + e) * 72 + l]);
                        const float y = (acc[lt][pt][e] + xv * Dh) * fsilu(zv[e]);
                        acc[lt][pt][e] = y; q += y * y;
                    }
                }
                q += shflx(q, 16, lane); q += shflx(q, 32, lane);
                if (fq == 0) sPART[h * 64 + l] = q;
            }
            __syncthreads();
            const float* ng = launder(C.in[9]) + layer * 512 + h * 64;
#pragma unroll
            for (int lt = 0; lt < 4; ++lt) {
                const int l = 16 * lt + fr;
                const float tot = (sPART[(4 * g) * 64 + l] + sPART[(4 * g + 1) * 64 + l]) + (sPART[(4 * g + 2) * 64 + l] + sPART[(4 * g + 3) * 64 + l]);
                const float rs = 1.0f / sqrtf(tot * (1.f / 256.f) + 1e-6f);
#pragma unroll
                for (int pt = 0; pt < 4; ++pt) {
                    const int p0 = 16 * pt + 4 * fq;
                    const f32x4 gg = *(const f32x4*)(ng + p0);
                    u32x2 w; w.x = pk2(acc[lt][pt][0] * rs * gg[0], acc[lt][pt][1] * rs * gg[1]); w.y = pk2(acc[lt][pt][2] * rs * gg[2], acc[lt][pt][3] * rs * gg[3]);
                    *(u32x2*)(C.mix + (size_t)(t0 + l) * DM + MX_B + h * 64 + p0) = w;
                }
            }
        }
        __syncthreads();
    }
}

__device__ __forceinline__ void final_phase(const Ctx& C) {
    const int gw = C.bid * 8 + C.wave, NGW = C.nblk * 8, lane = C.lane;
    f32x4 gg[2][2];
#pragma unroll
    for (int j = 0; j < 2; ++j) { gg[j][0] = *(const f32x4*)(C.in[19] + 512 * j + 8 * lane); gg[j][1] = *(const f32x4*)(C.in[19] + 512 * j + 8 * lane + 4); }
    for (int row0 = gw * 2; row0 < M; row0 += NGW * 2) {
        u32x4 v[2][2]; float rs[2];
#pragma unroll
        for (int r = 0; r < 2; ++r) {
            rs[r] = pg8::rstd_of(C.ssq, row0 + r);
#pragma unroll
            for (int j = 0; j < 2; ++j) v[r][j] = __builtin_nontemporal_load((const u32x4*)(C.xb + (size_t)(row0 + r) * DM + 512 * j + 8 * lane));
        }
#pragma unroll
        for (int r = 0; r < 2; ++r)
#pragma unroll
            for (int j = 0; j < 2; ++j) {
                const u32x4 w = v[r][j];
                const f32x4 a = {bflo(w.x), bfhi(w.x), bflo(w.y), bfhi(w.y)}, b = {bflo(w.z), bfhi(w.z), bflo(w.w), bfhi(w.w)};
                float* o = C.out + (size_t)(row0 + r) * DM + 512 * j + 8 * lane;
                *(f32x4*)o = a * rs[r] * gg[j][0]; *(f32x4*)(o + 4) = b * rs[r] * gg[j][1];
            }
    }
}

#define XB_TMO      128
#define XB_XCNT(j)  (256  + 64 * (j))
#define XB_XSUB(j)  (1280 + 64 * (j))
#define XB_XGEN(j)  (2304 + 64 * (j))
#define XB_TOP      3328
#define XB_TOPGEN   3392
#define XCD_BAR_WORDS 3456
#define XB_SPIN_CAP (1u << 18)

__device__ __forceinline__ unsigned xb_ld(unsigned* p)              { return __hip_atomic_load(p, __ATOMIC_RELAXED, __HIP_MEMORY_SCOPE_AGENT); }
__device__ __forceinline__ unsigned xb_add(unsigned* p, unsigned v) { return __hip_atomic_fetch_add(p, v, __ATOMIC_RELAXED, __HIP_MEMORY_SCOPE_AGENT); }
__device__ __forceinline__ unsigned xb_xcc_id() { return (unsigned)__builtin_amdgcn_s_getreg((3 << 11) | 20) & 0xFu; }
#define XB_SPIN(cond, bar) do { unsigned _sp = 0; while (cond) { __builtin_amdgcn_s_sleep(1); \
    if ((++_sp & 255u) == 0u) { if (xb_ld(&(bar)[XB_TMO])) break; if (_sp > XB_SPIN_CAP) { atomicAdd(&(bar)[XB_TMO], 1u); break; } } } } while (0)

struct XcdBarrier {
    unsigned* bar; unsigned x;
    volatile LAS unsigned* st;
};

__device__ __forceinline__ XcdBarrier xcd_barrier_post(unsigned* bar, volatile LAS unsigned* st) {
    XcdBarrier b; b.bar = bar; b.x = xb_xcc_id(); b.st = st;
    if (threadIdx.x == 0) (void)xb_add(&bar[XB_XCNT(b.x)], 1u);
    return b;
}
__device__ __forceinline__ void xcd_barrier_complete(unsigned* bar, unsigned x, unsigned& nloc, unsigned& nx) {
    const unsigned G = gridDim.x * gridDim.y * gridDim.z;
    unsigned sum, cnt, mine, sp = 0u;
    for (;;) {
        sum = 0u; cnt = 0u; mine = 0u;
#pragma unroll
        for (unsigned j = 0; j < 16; ++j) { const unsigned c = xb_ld(&bar[XB_XCNT(j)]); sum += c; cnt += (c > 0u) ? 1u : 0u; mine = (j == x) ? c : mine; }
        if (sum == G) break;
        __builtin_amdgcn_s_sleep(1);
        if ((++sp & 255u) == 0u) { if (xb_ld(&bar[XB_TMO])) break; if (sp > XB_SPIN_CAP) { atomicAdd(&bar[XB_TMO], 1u); break; } }
    }
    nloc = mine > 0u ? mine : 1u; nx = cnt > 0u ? cnt : 1u;
}

__device__ __forceinline__ void xcd_barrier(const XcdBarrier& b) {
    asm volatile("s_waitcnt vmcnt(0)" ::: "memory");
    __syncthreads();
    if (threadIdx.x == 0) {
        unsigned* bar = b.bar;
        __builtin_amdgcn_s_waitcnt(0);
        unsigned nloc = b.st[0], nx = b.st[1];
        if (nloc == 0u) { xcd_barrier_complete(bar, b.x, nloc, nx); b.st[0] = nloc; b.st[1] = nx; }
        const unsigned old = xb_add(&bar[XB_XSUB(b.x)], 1u);
        const unsigned gen = old / nloc;
        if (old + 1u == (gen + 1u) * nloc) {
            __builtin_amdgcn_fence(__ATOMIC_RELEASE, "agent");
            asm volatile("s_waitcnt vmcnt(0)" ::: "memory");
            const unsigned og = xb_add(&bar[XB_TOP], 1u);
            const unsigned tg = og / nx;
            if (og + 1u == (tg + 1u) * nx) xb_add(&bar[XB_TOPGEN], 1u);
            else XB_SPIN(xb_ld(&bar[XB_TOPGEN]) == tg, bar);
            __builtin_amdgcn_fence(__ATOMIC_ACQUIRE, "agent");
            xb_add(&bar[XB_XGEN(b.x)], 1u);
            asm volatile("s_waitcnt vmcnt(0)" ::: "memory");
        } else {
            XB_SPIN(xb_ld(&bar[XB_XGEN(b.x)]) == gen, bar);
            __builtin_amdgcn_fence(__ATOMIC_ACQUIRE, "agent");
            asm volatile("s_waitcnt vmcnt(0)" ::: "memory");
        }
    }
    __syncthreads();
}

#ifndef PHMASK
#define PHMASK 0x1ff
#endif
#define PHEN(x) (((PHMASK) >> (x)) & 1)
#define CAS __attribute__((address_space(4)))
__device__ __forceinline__ Ctx make_ctx(const CAS Args* ap, LAS unsigned char* lds, int tidv, int bid, int nblk) {
    Ctx C; C.bid = bid; C.nblk = nblk;
    C.lds = lds; C.tid = tidv; C.lane = tidv & 63; C.wave = __builtin_amdgcn_readfirstlane(tidv >> 6);
#pragma unroll
    for (int i = 0; i < 20; ++i) C.in[i] = ap->in[i];
    C.out = ap->out;
    unsigned char* ws = ap->ws;
    C.Win = (bf16*)(ws + WS_WIN); C.Wout = (bf16*)(ws + WS_WOUT); C.Wgu = (bf16*)(ws + WS_WGU); C.Wdn = (bf16*)(ws + WS_WDN);
    C.xb = (bf16*)(ws + WS_XB); C.mix = (bf16*)(ws + WS_MIX); C.states = (bf16*)(ws + WS_ST); C.proj = (bf16*)(ws + WS_PROJ);
    C.ssq = (float*)(ws + WS_SSQ); C.dtraw = (float*)(ws + WS_DT); C.cdecay = (float*)(ws + WS_CD);
    return C;
}
__global__ void __launch_bounds__(512, 2) fwd_kernel(Args a_unused) {
    extern __shared__ __attribute__((aligned(16))) unsigned char lds_raw[];
    cg::grid_group grid = cg::this_grid();
    LAS unsigned char* lds = (LAS unsigned char*)lds_raw;
    const CAS Args* ap0 = (const CAS Args*)__builtin_amdgcn_kernarg_segment_ptr();
    const int ph_lo = ap0->ph_lo, ph_hi = ap0->ph_hi, coop = ap0->coop;
    volatile LAS unsigned* MISC = (volatile LAS unsigned*)(lds + LDS_BYTES - 64);
    if (threadIdx.x < 16) MISC[threadIdx.x] = 0u;
    __syncthreads();
    unsigned* barw = (unsigned*)(ap0->ws);
    XcdBarrier bar; bar.bar = barw; bar.x = 0; bar.st = MISC;
    if (coop) bar = xcd_barrier_post(barw, MISC);
    for (int ph = ph_lo; ph < ph_hi; ++ph) {
        const CAS Args* ap = ap0; asm volatile("" : "+s"(ap));
        int tidv = threadIdx.x; asm volatile("" : "+v"(tidv));
        int bid = blockIdx.x, nblk = gridDim.x; asm volatile("" : "+s"(bid), "+s"(nblk));
        if (ph == NPHASES - 1) { if (PHEN(8)) { const Ctx C = make_ctx(ap, lds, tidv, bid, nblk); final_phase(C); } }
        else {
            const int l = (ph == 0) ? 0 : (ph - 1) / 7, t = (ph == 0) ? 2 : (ph - 1) % 7;
            if (t == 0 || t >= 4) { if (PHEN(1)) {
                const Ctx C = make_ctx(ap, lds, tidv, bid, nblk);
                pg8::Gemm g; int N;
                pg8::EpiAny E; E.e0 = pg8::EpiInProj{C.proj, C.dtraw, (const LAS float*)(lds + 131072)}; E.e1 = pg8::EpiResid{(l == 0 && t == 4) ? C.in[0] : (const float*)nullptr, C.xb, C.ssq}; E.e2 = pg8::EpiGateUp{C.proj, (const LAS float*)(lds + 131072)};
                if (t == 0)      { g = pg8::Gemm{C.xb, C.Win + (size_t)l * 3072 * 1024, M, 3072, 1024}; N = 3072; E.mode = 0; }
                else if (t == 4) { g = pg8::Gemm{C.mix, C.Wout + (size_t)l * 1024 * 1024, M, 1024, 1024}; N = 1024; E.mode = 1; }
                else if (t == 5) { g = pg8::Gemm{C.xb, C.Wgu + (size_t)l * 5632 * 1024, M, 5632, 1024}; N = 5632; E.mode = 2; }
                else             { g = pg8::Gemm{C.proj, C.Wdn + (size_t)l * 1024 * 2816, M, 1024, 2816}; N = 1024; E.mode = 1; }
                pg8::StaticOrder S; S.init(M, N, nblk, bid);
                LAS float* rsl = (LAS float*)(lds + 131072);
                if (E.mode != 1) {
                    pg8::Unit uu;
                    for (int i = 0; i < 16 && S.next(i, uu); ++i) if (tidv < 256) rsl[i * 256 + tidv] = pg8::rstd_of(C.ssq, uu.pm * 256 + tidv);
                    __syncthreads();
                }
                pg8::gemm_phase<pg8::EpiAny, pg8::StaticOrder, true, true>(lds, g, S, E, tidv); }
            } else if (t == 1) { if (PHEN(2)) { const Ctx C = make_ctx(ap, lds, tidv, bid, nblk); mix1_phase(C, l); } }
            else if (t == 2) { if (PHEN(3)) { const Ctx C = make_ctx(ap, lds, tidv, bid, nblk); if (ph == 0) aux_phase(C, 0, l); else scanatt_phase(C, l); } }
            else { if (PHEN(4)) { const Ctx C = make_ctx(ap, lds, tidv, bid, nblk); mix3_phase(C, l); } }
        }
        if (ph + 1 < ph_hi && coop) {
            if (coop == 2) grid.sync();
            xcd_barrier(bar);
        }
    }
}

#ifndef MK_MULTI
#define MK_MULTI 0
#endif
extern "C" void kernel_launch(void* const* d_in, const int* in_sizes, int n_in, void* d_out, int out_size, void* d_ws, size_t ws_size, hipStream_t stream) {
    static int grid = 0;
    if (grid == 0) {
        if (n_in != 20 || out_size != M * DM || ws_size < WS_END) { fprintf(stderr, "kernel_launch: unexpected shapes (n_in %d out %d ws %zu)\n", n_in, out_size, ws_size); grid = -1; return; }
        int dev = 0, cus = 0, per_cu = 0;
        hipGetDevice(&dev); hipDeviceGetAttribute(&cus, hipDeviceAttributeMultiprocessorCount, dev);
        if (hipFuncSetAttribute((const void*)fwd_kernel, hipFuncAttributeMaxDynamicSharedMemorySize, LDS_BYTES) != hipSuccess) { fprintf(stderr, "kernel_launch: hipFuncSetAttribute failed\n"); grid = -1; return; }
        if (hipOccupancyMaxActiveBlocksPerMultiprocessor(&per_cu, (const void*)fwd_kernel, 512, LDS_BYTES) != hipSuccess || per_cu < 1) { fprintf(stderr, "kernel_launch: occupancy query gave %d\n", per_cu); per_cu = 1; (void)hipGetLastError(); }
        grid = cus * per_cu; if (grid > 256) grid = 256;
    }
    if (grid < 0) return;
    Args a{};
    for (int i = 0; i < 20; ++i) a.in[i] = (const float*)d_in[i];
    a.out = (float*)d_out; a.ws = (unsigned char*)d_ws;
#if MK_MULTI
    a.coop = 0;
    for (int ph = 0; ph < NPHASES; ++ph) { a.ph_lo = ph; a.ph_hi = ph + 1; hipLaunchKernelGGL(fwd_kernel, dim3(grid), dim3(512), LDS_BYTES, stream, a); }
#else
    a.coop = 1; a.ph_lo = 0; a.ph_hi = NPHASES;
    if (hipMemsetAsync(d_ws, 0, 32768, stream) != hipSuccess) { fprintf(stderr, "kernel_launch: hipMemsetAsync failed\n"); return; }
    void* args[] = {&a};
    hipError_t e = hipLaunchCooperativeKernel((const void*)fwd_kernel, dim3(grid), dim3(512), args, LDS_BYTES, stream);
    if (e != hipSuccess) fprintf(stderr, "kernel_launch: cooperative launch failed: %s (grid %d)\n", hipGetErrorString(e), grid);
#endif
}
```

```cpp
#include <hip/hip_runtime.h>
#include <hip/hip_cooperative_groups.h>
#include <cstdio>
#include <cstdint>
namespace cg = cooperative_groups;
namespace pg8 {
#define PG8_LAS __attribute__((address_space(3)))
typedef unsigned short bf16_t;
typedef short bf16x8 __attribute__((ext_vector_type(8)));
typedef float f32x4 __attribute__((ext_vector_type(4)));
typedef unsigned u32x4 __attribute__((ext_vector_type(4)));
constexpr int BM = 256, BK = 64, HALF = 128, HTB = HALF * BK * 2  , STAGE_BYTES = 8 * HTB, NXCD = 8, WGM = 8;

__host__ __device__ __forceinline__ int lds_byte(int r, int c) { const int st = (r >> 4) * 2 + (c >> 5), rr = r & 15, cc = c & 31, ob = rr * 64 + cc * 2; return st * 1024 + (ob ^ (((ob >> 9) & 1) << 5)); }
__host__ __device__ __forceinline__ void stage_rc(int b, int& R, int& C) { const int st = b / 1024, sb = b % 1024, swz = sb ^ (((sb >> 9) & 1) << 5); R = (st >> 1) * 16 + swz / 64; C = (st & 1) * 32 + (swz % 64) / 2; }
__host__ __device__ __forceinline__ int perm32(int rho) { const int n = rho >> 4, i = rho & 15; return 8 * (i >> 2) + 4 * n + (i & 3); }

struct Unit { int pm, pn, idx; };
struct Gemm { const bf16_t* A; const bf16_t* Bt; int M, N, K; };

struct StaticOrder {
    int nM, nN, nwg, G, c;
    __host__ __device__ void init(int M, int N, int G_, int c_) { nM = M / BM; nN = N / BM; nwg = nM * nN; G = G_; c = c_; }
    __host__ __device__ bool next(int i, Unit& u) const {
        const long L = (long)i * G + c; if (L >= nwg) return false; u.idx = i;
        int wgid = (int)L; { const int q = nwg / NXCD, r = nwg % NXCD, xcd = wgid % NXCD, off = wgid / NXCD; wgid = (xcd < r ? xcd * (q + 1) : r * (q + 1) + (xcd - r) * q) + off; }
        const int nig = WGM * nN, gid = wgid / nig, fm = gid * WGM, gsz = (nM - fm) < WGM ? (nM - fm) : WGM;
        u.pm = fm + ((wgid % nig) % gsz); u.pn = (wgid % nig) / gsz; return true;
    }
    __device__ __forceinline__ void a_ready(const Unit&) const {}
    __device__ __forceinline__ void done(const Unit&) const {}
};

__device__ __forceinline__ unsigned cvt_pk_bf16(float lo, float hi) { unsigned r; asm volatile("v_cvt_pk_bf16_f32 %0, %1, %2" : "=v"(r) : "v"(lo), "v"(hi)); return r; }
__device__ __forceinline__ float shflx(float v, int mask, int lane) { return __int_as_float(__builtin_amdgcn_ds_bpermute((lane ^ mask) << 2, __float_as_int(v))); }
__device__ __forceinline__ float rstd_of(const float* ssq, int row) {
    const f32x4* p = (const f32x4*)(ssq + (size_t)row * 16);
    const f32x4 a = p[0], b = p[1], c = p[2], d = p[3];
    const float s = (((a[0] + a[1]) + (a[2] + a[3])) + ((b[0] + b[1]) + (b[2] + b[3]))) + (((c[0] + c[1]) + (c[2] + c[3])) + ((d[0] + d[1]) + (d[2] + d[3])));
    return __builtin_amdgcn_rsqf(s * (1.0f / 1024.0f) + 1e-6f);
}
__device__ __forceinline__ float silu_f(float x) { return x * __builtin_amdgcn_rcpf(1.0f + __builtin_amdgcn_exp2f(-1.4426950408889634f * x)); }
constexpr float QSCALE = 0.125f * 1.4426950408889634f;
struct EpiInProj {
    static constexpr bool PERM = true, AFTER_DRAIN = false;
    bf16_t* proj; float* dtraw; const PG8_LAS float* rsl;
    __device__ __forceinline__ void operator()(const f32x4 (&acc)[2][2][4][2], const Unit& u, int wr, int wc, int fr, int fq) const {
        const int row0 = u.pm * BM + wr * 64 + fr;
        const float sc = (u.pn == 0) ? QSCALE : 1.0f;
#pragma unroll
        for (int ai = 0; ai < 2; ++ai)
#pragma unroll
            for (int m = 0; m < 4; ++m) {
                const int row = row0 + ai * HALF + m * 16;
                const float rs = rsl[u.idx * 256 + (row & 255)] * sc;
                if (u.pn < 11) {
                    bf16_t* rowp = proj + (size_t)row * 2816 + u.pn * BM + wc * 32 + 8 * fq;
#pragma unroll
                    for (int bj = 0; bj < 2; ++bj) {
                        const f32x4 v0 = acc[ai][bj][m][0] * rs, v1 = acc[ai][bj][m][1] * rs;
                        u32x4 w; w.x = cvt_pk_bf16(v0[0], v0[1]); w.y = cvt_pk_bf16(v0[2], v0[3]); w.z = cvt_pk_bf16(v1[0], v1[1]); w.w = cvt_pk_bf16(v1[2], v1[3]);
                        *(u32x4*)(rowp + bj * HALF) = w;
                    }
                } else if (wc == 0 && fq == 0) {
                    *(f32x4*)(dtraw + (size_t)row * 8) = acc[ai][0][m][0] * rs;
                    *(f32x4*)(dtraw + (size_t)row * 8 + 4) = acc[ai][0][m][1] * rs;
                }
            }
    }
};
struct EpiResid {
    static constexpr bool PERM = true, AFTER_DRAIN = false;
    const float* base32; bf16_t* xb; float* ssq;
    __device__ __forceinline__ void operator()(const f32x4 (&acc)[2][2][4][2], const Unit& u, int wr, int wc, int fr, int fq) const {
        const int col0 = u.pn * BM + wc * 32 + 8 * fq, lane_ = fr + 16 * fq;
#pragma unroll
        for (int ai = 0; ai < 2; ++ai)
#pragma unroll
            for (int m = 0; m < 4; ++m) {
                const int row = u.pm * BM + ai * HALF + wr * 64 + m * 16 + fr;
                const size_t off = (size_t)row * 1024 + col0;
                float q = 0.f;
#pragma unroll
                for (int bj = 0; bj < 2; ++bj) {
                    const u32x4 r = *(const u32x4*)(xb + off + bj * HALF);
                    const f32x4 b0 = {__uint_as_float(r.x << 16), __uint_as_float(r.x & 0xffff0000u), __uint_as_float(r.y << 16), __uint_as_float(r.y & 0xffff0000u)};
                    const f32x4 b1 = {__uint_as_float(r.z << 16), __uint_as_float(r.z & 0xffff0000u), __uint_as_float(r.w << 16), __uint_as_float(r.w & 0xffff0000u)};
                    const f32x4 o0 = b0 + acc[ai][bj][m][0], o1 = b1 + acc[ai][bj][m][1];
                    q += ((o0[0] * o0[0] + o0[1] * o0[1]) + (o0[2] * o0[2] + o0[3] * o0[3])) + ((o1[0] * o1[0] + o1[1] * o1[1]) + (o1[2] * o1[2] + o1[3] * o1[3]));
                    u32x4 w; w.x = cvt_pk_bf16(o0[0], o0[1]); w.y = cvt_pk_bf16(o0[2], o0[3]); w.z = cvt_pk_bf16(o1[0], o1[1]); w.w = cvt_pk_bf16(o1[2], o1[3]);
                    *(u32x4*)(xb + off + bj * HALF) = w;
                }
                q += shflx(q, 16, lane_); q += shflx(q, 32, lane_);
                if (fq == 0) ssq[(size_t)row * 16 + u.pn * 4 + wc] = q;
            }
    }
};
typedef float f32x2v __attribute__((ext_vector_type(2)));
struct EpiGateUp {
    static constexpr bool PERM = true, AFTER_DRAIN = false;
    bf16_t* hdn; const PG8_LAS float* rsl;
    __device__ __forceinline__ void operator()(const f32x4 (&acc)[2][2][4][2], const Unit& u, int wr, int wc, int fr, int fq) const {
        const int row0 = u.pm * BM + wr * 64 + fr, col = u.pn * HALF + wc * 32 + 8 * fq;
#pragma unroll
        for (int ai = 0; ai < 2; ++ai)
#pragma unroll
            for (int m = 0; m < 4; ++m) {
                const int row = row0 + ai * HALF + m * 16;
                const float rs = rsl[u.idx * 256 + (row & 255)];
                const float rs2 = rs * rs, nrs = rs * -1.4426950408889634f;
                u32x4 w;
#pragma unroll
                for (int n = 0; n < 2; ++n)
#pragma unroll
                    for (int hh = 0; hh < 2; ++hh) {
                        const f32x2v g = {acc[ai][0][m][n][2 * hh], acc[ai][0][m][n][2 * hh + 1]}, uu = {acc[ai][1][m][n][2 * hh], acc[ai][1][m][n][2 * hh + 1]};
                        const f32x2v t = g * nrs; f32x2v e; e.x = __builtin_amdgcn_exp2f(t.x); e.y = __builtin_amdgcn_exp2f(t.y);
                        const f32x2v d = e + 1.0f; f32x2v r; r.x = __builtin_amdgcn_rcpf(d.x); r.y = __builtin_amdgcn_rcpf(d.y);
                        const f32x2v o = (g * uu) * (r * rs2);
                        w[2 * n + hh] = cvt_pk_bf16(o.x, o.y);
                    }
                *(u32x4*)(hdn + (size_t)row * 2816 + col) = w;
            }
    }
};

struct EpiAny {
    static constexpr bool PERM = true, AFTER_DRAIN = false;
    int mode; EpiInProj e0; EpiResid e1; EpiGateUp e2;
    __device__ __forceinline__ void operator()(const f32x4 (&acc)[2][2][4][2], const Unit& u, int wr, int wc, int fr, int fq) const {
        if (mode == 0) e0(acc, u, wr, wc, fr, fq); else if (mode == 1) e1(acc, u, wr, wc, fr, fq); else e2(acc, u, wr, wc, fr, fq);
    }
};
template <class Epi, class Sched, bool ALIGN_EPI = false, bool SP2 = false>
__device__ __forceinline__ void gemm_phase(PG8_LAS unsigned char* lds, const Gemm g, const Sched& S, const Epi& E, const int tid) {
    const int wid = __builtin_amdgcn_readfirstlane(tid >> 6), lane = tid & 63, wr = wid >> 2, wc = wid & 3, fr = lane & 15, fq = lane >> 4;
    const int K = g.K, nt = K / BK;
    unsigned voffA[2], voffB[2];
#pragma unroll
    for (int i = 0; i < 2; ++i) { int R, C; stage_rc(tid * 16 + i * 8192, R, C); const int Rb = Epi::PERM ? ((R & ~31) + perm32(R & 31)) : R;
        voffA[i] = (unsigned)(R * K + C) * 2u; voffB[i] = (unsigned)(Rb * K + C) * 2u; }
    const size_t kstep = (size_t)(BK * 2);
    const size_t hstep = (size_t)HALF * K * 2;
    const size_t tstep = 2 * hstep;
    const unsigned ldsw = (unsigned)wid * 1024u;
    const int aoff = lds_byte(wr * 64 + fr, fq * 8), boff = lds_byte(wc * 32 + fr, fq * 8);
#define PG8_SA(b, h) (((b) * 2 + (h)) * HTB)
#define PG8_SB(b, h) ((4 + (b) * 2 + (h)) * HTB)
#define PG8_STAGE(bufoff, gbase, voff) do { _Pragma("unroll") for (int _i = 0; _i < 2; ++_i) \
        __builtin_amdgcn_global_load_lds((const unsigned*)((const char*)(gbase) + (voff)[_i]), (PG8_LAS unsigned*)(lds + (bufoff) + ldsw + _i * 8192), 16, 0, 0); } while (0)
#define PG8_LDA(dst, b, h) do { _Pragma("unroll") for (int m = 0; m < 4; ++m) _Pragma("unroll") for (int k = 0; k < 2; ++k) dst[m][k] = *(const PG8_LAS bf16x8*)(lds + PG8_SA(b, h) + aoff + m * 2048 + k * 1024); } while (0)
#define PG8_LDB(dst, b, h) do { _Pragma("unroll") for (int n = 0; n < 2; ++n) _Pragma("unroll") for (int k = 0; k < 2; ++k) dst[n][k] = *(const PG8_LAS bf16x8*)(lds + PG8_SB(b, h) + boff + n * 2048 + k * 1024); } while (0)
#define PG8_MMA(ai, bj, At, Bt) do { __builtin_amdgcn_s_setprio(1); _Pragma("unroll") for (int m = 0; m < 4; ++m) _Pragma("unroll") for (int n = 0; n < 2; ++n) _Pragma("unroll") for (int k = 0; k < 2; ++k) \
        acc[ai][bj][m][n] = __builtin_amdgcn_mfma_f32_16x16x32_bf16(Bt[n][k], At[m][k], acc[ai][bj][m][n], 0, 0, 0); __builtin_amdgcn_s_setprio(0); } while (0)
#define PG8_WAIT_V(n) asm volatile("s_waitcnt vmcnt(" #n ")" ::: "memory")
#define PG8_WAIT_L(n) asm volatile("s_waitcnt lgkmcnt(" #n ")" ::: "memory")
#define PG8_BAR __builtin_amdgcn_s_barrier()
#define PG8_SCHED __builtin_amdgcn_sched_barrier(0)
    Unit cur, nxt; int ui = 0;
    if (!S.next(0, cur)) return;
    f32x4 acc[2][2][4][2];
#pragma unroll
    for (int a = 0; a < 2; ++a)
#pragma unroll
        for (int b = 0; b < 2; ++b)
#pragma unroll
            for (int m = 0; m < 4; ++m)
#pragma unroll
                for (int n = 0; n < 2; ++n) acc[a][b][m][n] = (f32x4){0.f, 0.f, 0.f, 0.f};
    bf16x8 At[4][2], B0[2][2], B1[2][2];
    const char* cA = (const char*)g.A + (size_t)cur.pm * tstep; const char* cB = (const char*)g.Bt + (size_t)cur.pn * tstep;
    S.a_ready(cur);
    if constexpr (SP2) {
        PG8_STAGE(PG8_SB(0, 0), cB, voffB); PG8_STAGE(PG8_SB(0, 1), cB + hstep, voffB); PG8_STAGE(PG8_SA(0, 0), cA, voffA); PG8_STAGE(PG8_SA(0, 1), cA + hstep, voffA);
        if (wr == 1) PG8_BAR;
        PG8_WAIT_V(2); PG8_BAR;
        PG8_STAGE(PG8_SB(1, 0), cB + kstep, voffB); PG8_STAGE(PG8_SA(1, 0), cA + kstep, voffA); PG8_STAGE(PG8_SB(1, 1), cB + hstep + kstep, voffB);
        PG8_WAIT_V(6); PG8_BAR;
    } else {
        PG8_STAGE(PG8_SB(0, 0), cB, voffB); PG8_STAGE(PG8_SA(0, 0), cA, voffA); PG8_STAGE(PG8_SB(0, 1), cB + hstep, voffB); PG8_STAGE(PG8_SA(0, 1), cA + hstep, voffA);
        if (wr == 1) PG8_BAR;
        PG8_WAIT_V(4); PG8_BAR;
        PG8_STAGE(PG8_SB(1, 0), cB + kstep, voffB); PG8_STAGE(PG8_SA(1, 0), cA + kstep, voffA); PG8_STAGE(PG8_SB(1, 1), cB + hstep + kstep, voffB);
        PG8_WAIT_V(6); PG8_BAR;
    }
    for (;;) {
        const bool has_next = S.next(ui + 1, nxt);
        const char* nA = has_next ? (const char*)g.A + (size_t)nxt.pm * tstep : cA; const char* nB = has_next ? (const char*)g.Bt + (size_t)nxt.pn * tstep : cB;
        for (int t = 0; t < nt; t += 2) {
            const bool last = (t == nt - 2);
            const char* a1 = cA + (size_t)(t + 1) * kstep;
            const char* a2 = last ? nA : cA + (size_t)(t + 2) * kstep; const char* b2 = last ? nB : cB + (size_t)(t + 2) * kstep;
            const char* a3 = a2 + kstep; const char* b3 = b2 + kstep;
            if (last && has_next) S.a_ready(nxt);
            if constexpr (SP2) {
            PG8_LDB(B0, 0, 0); PG8_LDB(B1, 0, 1); PG8_SCHED; PG8_LDA(At, 0, 0); PG8_STAGE(PG8_SA(1, 1), a1 + hstep, voffA);
            PG8_WAIT_V(8); PG8_WAIT_L(0); PG8_BAR; PG8_MMA(0, 0, At, B0); PG8_MMA(0, 1, At, B1); PG8_BAR; PG8_SCHED;
            PG8_LDA(At, 0, 1); PG8_STAGE(PG8_SB(0, 0), b2, voffB); PG8_STAGE(PG8_SB(0, 1), b2 + hstep, voffB); PG8_STAGE(PG8_SA(0, 0), a2, voffA);
            PG8_WAIT_V(8); PG8_WAIT_L(0); PG8_BAR; PG8_MMA(1, 0, At, B0); PG8_MMA(1, 1, At, B1); PG8_BAR; PG8_SCHED;
            PG8_LDB(B0, 1, 0); PG8_LDB(B1, 1, 1); PG8_SCHED; PG8_LDA(At, 1, 0); PG8_STAGE(PG8_SA(0, 1), a2 + hstep, voffA);
            PG8_WAIT_V(8); PG8_WAIT_L(0); PG8_BAR; PG8_MMA(0, 0, At, B0); PG8_MMA(0, 1, At, B1); PG8_BAR; PG8_SCHED;
            PG8_LDA(At, 1, 1); PG8_STAGE(PG8_SB(1, 0), b3, voffB); PG8_STAGE(PG8_SB(1, 1), b3 + hstep, voffB); PG8_STAGE(PG8_SA(1, 0), a3, voffA);
            PG8_WAIT_V(8); PG8_WAIT_L(0); PG8_BAR; PG8_MMA(1, 0, At, B0); PG8_MMA(1, 1, At, B1); PG8_BAR; PG8_SCHED;
            } else {
            PG8_LDB(B0, 0, 0); PG8_SCHED; PG8_LDA(At, 0, 0); PG8_STAGE(PG8_SA(1, 1), a1 + hstep, voffA);
            PG8_WAIT_L(8); PG8_BAR; PG8_WAIT_L(0); PG8_MMA(0, 0, At, B0); PG8_BAR; PG8_SCHED;
            PG8_LDB(B1, 0, 1); PG8_STAGE(PG8_SB(0, 0), b2, voffB);
            PG8_BAR; PG8_WAIT_L(0); PG8_MMA(0, 1, At, B1); PG8_BAR;
            PG8_LDA(At, 0, 1); PG8_STAGE(PG8_SA(0, 0), a2, voffA);
            PG8_BAR; PG8_WAIT_L(0); PG8_MMA(1, 0, At, B0); PG8_BAR; PG8_SCHED;
            PG8_STAGE(PG8_SB(0, 1), b2 + hstep, voffB);
            PG8_WAIT_V(6); PG8_BAR; PG8_MMA(1, 1, At, B1); PG8_BAR;
            PG8_LDB(B0, 1, 0); PG8_SCHED; PG8_LDA(At, 1, 0); PG8_STAGE(PG8_SA(0, 1), a2 + hstep, voffA);
            PG8_WAIT_L(8); PG8_BAR; PG8_WAIT_L(0); PG8_MMA(0, 0, At, B0); PG8_BAR; PG8_SCHED;
            PG8_LDB(B1, 1, 1); PG8_STAGE(PG8_SB(1, 0), b3, voffB);
            PG8_BAR; PG8_WAIT_L(0); PG8_MMA(0, 1, At, B1); PG8_BAR;
            PG8_LDA(At, 1, 1); PG8_STAGE(PG8_SA(1, 0), a3, voffA);
            PG8_BAR; PG8_WAIT_L(0); PG8_MMA(1, 0, At, B0); PG8_BAR; PG8_SCHED;
            PG8_STAGE(PG8_SB(1, 1), b3 + hstep, voffB);
            PG8_WAIT_V(6); PG8_BAR; PG8_MMA(1, 1, At, B1); PG8_BAR;
            }
        }
        if constexpr (ALIGN_EPI) { if (wr == 0) PG8_BAR; }
        if constexpr (!Epi::AFTER_DRAIN) { E(acc, cur, wr, wc, fr, fq); S.done(cur); }
        if (!has_next) break;
#pragma unroll
        for (int a = 0; a < 2; ++a)
#pragma unroll
            for (int b = 0; b < 2; ++b)
#pragma unroll
                for (int m = 0; m < 4; ++m)
#pragma unroll
                    for (int n = 0; n < 2; ++n) acc[a][b][m][n] = (f32x4){0.f, 0.f, 0.f, 0.f};
        cur = nxt; cA = nA; cB = nB; ++ui;
        if constexpr (ALIGN_EPI) { if (wr == 1) PG8_BAR; }
    }
    PG8_WAIT_V(0);
    if constexpr (!ALIGN_EPI) { if (wr == 0) PG8_BAR; }
    PG8_BAR;
    if constexpr (Epi::AFTER_DRAIN) { E.fused(acc, cur, wr, wc, fr, fq, lds, wid, lane); S.done(cur); }
#undef PG8_SA
#undef PG8_SB
#undef PG8_STAGE
#undef PG8_LDA
#undef PG8_LDB
#undef PG8_MMA
#undef PG8_WAIT_V
#undef PG8_WAIT_L
#undef PG8_BAR
#undef PG8_SCHED
}
}

#define LAS __attribute__((address_space(3)))
typedef unsigned short bf16;
typedef float f32x4 __attribute__((ext_vector_type(4)));
typedef float f32x2 __attribute__((ext_vector_type(2)));
typedef short bf16x8 __attribute__((ext_vector_type(8)));
typedef unsigned u32x4 __attribute__((ext_vector_type(4)));
typedef unsigned u32x2 __attribute__((ext_vector_type(2)));
typedef __bf16 bf16x2_t __attribute__((ext_vector_type(2)));
typedef short s16x4 __attribute__((ext_vector_type(4)));

constexpr int M = 16384, DM = 1024, NPROJ = 2816, NCHUNK = 256;
constexpr int PJ_Q = 0, PJ_K = 256, PJ_V = 512, PJ_Z = 768, PJ_XBC = 1280, PJ_GLU = 2304;
constexpr int MX_A = 0, MX_B = 256, MX_C = 768;
constexpr size_t MiB = 1u << 20;
constexpr size_t WS_SSQ = 1 * MiB, WS_DT = 2 * MiB, WS_CD = 2 * MiB + 512 * 1024, WS_WIN = 4 * MiB, WS_WOUT = 16 * MiB, WS_WGU = 20 * MiB, WS_WDN = 42 * MiB,
                 WS_XB = 54 * MiB, WS_MIX = 86 * MiB, WS_ST = 118 * MiB, WS_PROJ = 150 * MiB, WS_END = 238 * MiB;
constexpr int LDS_BYTES = 153600;
constexpr float LOG2E = 1.4426950408889634f;
constexpr int NPHASES = 16;

__device__ __forceinline__ float bflo(unsigned u) { return __uint_as_float(u << 16); }
__device__ __forceinline__ float bfhi(unsigned u) { return __uint_as_float(u & 0xffff0000u); }
__device__ __forceinline__ float bf2f(bf16 h) { return __uint_as_float((unsigned)h << 16); }
__device__ __forceinline__ unsigned pk2(float lo, float hi) { f32x2 v = {lo, hi}; bf16x2_t b = __builtin_convertvector(v, bf16x2_t); return __builtin_bit_cast(unsigned, b); }
__device__ __forceinline__ bf16 f2bf(float f) { return (bf16)(pk2(f, 0.f) & 0xffffu); }
__device__ __forceinline__ f32x4 mfma16(bf16x8 a, bf16x8 b, f32x4 c) { return __builtin_amdgcn_mfma_f32_16x16x32_bf16(a, b, c, 0, 0, 0); }
__device__ __forceinline__ float fsilu(float x) { return x * __builtin_amdgcn_rcpf(1.0f + __builtin_amdgcn_exp2f(-LOG2E * x)); }
__device__ __forceinline__ float fsigmoid(float x) { return __builtin_amdgcn_rcpf(1.0f + __builtin_amdgcn_exp2f(-LOG2E * x)); }
__device__ __forceinline__ float fexp(float x) { return __builtin_amdgcn_exp2f(LOG2E * x); }
using pg8::shflx;
__device__ __forceinline__ float wave_sum(float v, int lane) {
#pragma unroll
    for (int o = 1; o < 64; o <<= 1) v += shflx(v, o, lane);
    return v;
}

template <class T> __device__ __forceinline__ T* launder(T* p) { asm volatile("" : "+s"(p)); return p; }
struct Args { const float* in[20]; float* out; unsigned char* ws; int ph_lo, ph_hi, coop, pad; };
struct Ctx {
    LAS unsigned char* lds; int tid, lane, wave, bid, nblk;
    const float* in[20]; float* out;
    bf16 *Win, *Wout, *Wgu, *Wdn, *xb, *mix, *states, *proj;
    float *ssq, *dtraw, *cdecay;
};

struct P0Item { const float* W; const float* gain; bf16* WT; int nsrc, col, valid, K, drow, k0; };
__device__ __forceinline__ P0Item p0_decode(const Ctx& C, int it) {
    constexpr int I_IN = 16 * 96, I_OUT = 16 * 32, I_GU = 16 * 176, I_DN = 44 * 32, I_L = I_IN + I_OUT + I_GU + I_DN;
    P0Item P; const int l = it / I_L; int r = it % I_L;
    if (r < I_IN) {
        const int kb = r / 96, n0 = 32 * (r % 96);
        int col, valid;
        if (n0 < 2304) { col = n0; valid = 32; } else if (n0 < 2816) { col = n0 + 8; valid = 32; } else if (n0 == 2816) { col = 2304; valid = 8; } else { col = 0; valid = 0; }
        P.W = C.in[2] + (size_t)l * 1024 * 2824; P.nsrc = 2824; P.col = col; P.valid = valid; P.gain = C.in[1] + l * 1024; P.K = 1024; P.WT = C.Win + (size_t)l * 3072 * 1024; P.drow = n0; P.k0 = 64 * kb;
        return P;
    }
    r -= I_IN;
    if (r < I_OUT) { const int kb = r / 32, n0 = 32 * (r % 32);
        P.W = C.in[14] + (size_t)l * 1024 * 1024; P.nsrc = 1024; P.col = n0; P.valid = 32; P.gain = nullptr; P.K = 1024; P.WT = C.Wout + (size_t)l * 1024 * 1024; P.drow = n0; P.k0 = 64 * kb; return P; }
    r -= I_OUT;
    if (r < I_GU) { const int kb = r / 176, n0 = 32 * (r % 176); const int t = n0 >> 8, hs = (n0 >> 7) & 1, i = n0 & 127;
        P.W = (hs ? C.in[17] : C.in[16]) + (size_t)l * 1024 * 2816; P.nsrc = 2816; P.col = 128 * t + i; P.valid = 32; P.gain = C.in[15] + l * 1024; P.K = 1024; P.WT = C.Wgu + (size_t)l * 5632 * 1024; P.drow = n0; P.k0 = 64 * kb; return P; }
    r -= I_GU;
    { const int kb = r / 32, n0 = 32 * (r % 32);
        P.W = C.in[18] + (size_t)l * 2816 * 1024; P.nsrc = 1024; P.col = n0; P.valid = 32; P.gain = nullptr; P.K = 2816; P.WT = C.Wdn + (size_t)l * 1024 * 2816; P.drow = n0; P.k0 = 64 * kb; return P; }
}
__device__ __forceinline__ void p0_load(const P0Item& P, float (&wv)[32], int lane) {
    const int c31 = lane & 31;
#pragma unroll
    for (int i = 0; i < 32; ++i) { const int kk = 2 * i + (lane >> 5); wv[i] = (c31 < P.valid) ? __builtin_nontemporal_load(P.W + (size_t)(P.k0 + kk) * P.nsrc + P.col + c31) : 0.f; }
}
__device__ __forceinline__ void p0_finish(const P0Item& P, float (&wv)[32], LAS float* scr, int lane) {
    const int c31 = lane & 31;
    if (P.gain) {
#pragma unroll
        for (int i = 0; i < 32; ++i) wv[i] *= P.gain[P.k0 + 2 * i + (lane >> 5)];
    }
#pragma unroll
    for (int i = 0; i < 32; ++i) scr[(2 * i + (lane >> 5)) * 33 + c31] = wv[i];
    const int c = lane & 7;
#pragma unroll
    for (int j = 0; j < 4; ++j) {
        const int n = (lane >> 3) + 8 * j; const LAS float* s = scr + (8 * c) * 33 + n;
        u32x4 o; o.x = pk2(s[0 * 33], s[1 * 33]); o.y = pk2(s[2 * 33], s[3 * 33]); o.z = pk2(s[4 * 33], s[5 * 33]); o.w = pk2(s[6 * 33], s[7 * 33]);
        *(u32x4*)(P.WT + (size_t)(P.drow + n) * P.K + P.k0 + 8 * c) = o;
    }
}
__device__ __forceinline__ void p0_convert(const Ctx& C, int it_begin, int it_end, int gw, int NGW, LAS float* scr, int lane) {
#pragma unroll 1
    for (int it = it_begin + gw; it < it_end; it += NGW) {
        float wa[32];
        const P0Item pa = p0_decode(C, it);
        p0_load(pa, wa, lane);
        p0_finish(pa, wa, scr, lane);
    }
}
constexpr int P0_FIRST = 16 * 96;
constexpr int P0_SPLIT = (16 * 96 + 16 * 32 + 16 * 176 + 44 * 32) + 16 * 96;
constexpr int P0_ALL = 2 * (16 * 96 + 16 * 32 + 16 * 176 + 44 * 32);
#ifndef M1P
#define M1P 7
#endif
__device__ __forceinline__ void ssd_dt_acs(const Ctx& C, int layer, int ck, LAS float* sDT, LAS float* sACS, LAS float* sW, bool has_w, int lane, int wave) {
    const int h = wave, t0 = ck * 64;
    const float raw = C.dtraw[(size_t)(t0 + lane) * 8 + h] + C.in[6][layer * 8 + h];
    const float dt = fmaxf(raw, 0.f) + log1pf(expf(-fabsf(raw)));
    const float av = -expf(C.in[7][layer * 8 + h]) * dt;
    float cs = av;
#pragma unroll
    for (int o = 1; o < 64; o <<= 1) { const float v = __int_as_float(__builtin_amdgcn_ds_bpermute(((lane - o) & 63) << 2, __float_as_int(cs))); if (lane >= o) cs += v; }
    const float aend = __int_as_float(__builtin_amdgcn_readlane(__float_as_int(cs), 63));
    sDT[h * 64 + lane] = dt; sACS[h * 64 + lane] = cs;
    if (has_w) { sW[h * 64 + lane] = dt * expf(aend - cs); if (lane == 63) C.cdecay[ck * 8 + h] = expf(cs); }
}

__device__ __forceinline__ void mix1_phase(const Ctx& C, int layer) {
    LAS float* sDT = (LAS float*)(C.lds); LAS float* sACS = (LAS float*)(C.lds + 2048); LAS float* sW = (LAS float*)(C.lds + 4096);
    LAS bf16* sT = (LAS bf16*)(C.lds + 8192);
    for (int ck = ((C.nblk & 7) == 0 ? (C.bid & 7) * (C.nblk >> 3) + (C.bid >> 3) : C.bid); ck < NCHUNK; ck += C.nblk) {
        int tid = C.tid; asm volatile("" : "+v"(tid));
        const int lane = tid & 63, wave = __builtin_amdgcn_readfirstlane(tid >> 6), fr = lane & 15, fq = lane >> 4;
        const int cin = ck & 127, t0 = ck * 64; const bool first = (cin == 0);
        const float* cw = launder(C.in[4]) + (size_t)layer * 4 * 1024; const float* cb = launder(C.in[5]) + layer * 1024;
        ssd_dt_acs(C, layer, ck, sDT, sACS, sW, true, lane, wave);
        __syncthreads();
        if (tid < 384) {
            const int ch0 = 2 * tid;
            const f32x2 w0 = *(const f32x2*)(cw + 0 * 1024 + ch0), w1 = *(const f32x2*)(cw + 1 * 1024 + ch0), w2 = *(const f32x2*)(cw + 2 * 1024 + ch0), w3 = *(const f32x2*)(cw + 3 * 1024 + ch0);
            const f32x2 bb = *(const f32x2*)(cb + ch0);
            const unsigned* src = (const unsigned*)(C.proj + (size_t)t0 * NPROJ + PJ_XBC + ch0);
            f32x2 xm3 = {0.f, 0.f}, xm2 = {0.f, 0.f}, xm1 = {0.f, 0.f};
            if (!first) { const unsigned a = src[-3 * (NPROJ / 2)], b = src[-2 * (NPROJ / 2)], c = src[-1 * (NPROJ / 2)];
                xm3 = (f32x2){bflo(a), bfhi(a)}; xm2 = (f32x2){bflo(b), bfhi(b)}; xm1 = (f32x2){bflo(c), bfhi(c)}; }
            const int hh = ch0 >> 6; const bool isx = ch0 < 512;
#pragma unroll 1
            for (int l0 = 0; l0 < 64; l0 += 16) {
            unsigned uu[16];
#pragma unroll
            for (int i = 0; i < 16; ++i) uu[i] = src[(l0 + i) * (NPROJ / 2)];
#pragma unroll
            for (int li = 0; li < 16; li += 2) {
                const int l = l0 + li;
                const unsigned ua = uu[li], ub = uu[li + 1];
                const f32x2 xa = {bflo(ua), bfhi(ua)}, xc = {bflo(ub), bfhi(ub)};
                f32x2 ya = bb + w0 * xm3 + w1 * xm2 + w2 * xm1 + w3 * xa;
                f32x2 yb = bb + w0 * xm2 + w1 * xm1 + w2 * xa + w3 * xc;
                xm3 = xm1; xm2 = xa; xm1 = xc;
                ya.x = fsilu(ya.x); ya.y = fsilu(ya.y); yb.x = fsilu(yb.x); yb.y = fsilu(yb.y);
                if (isx) { const float wa = sW[hh * 64 + l], wb = sW[hh * 64 + l + 1]; ya = ya * wa; yb = yb * wb; }
                *(LAS unsigned*)(sT + ch0 * 72 + l) = pk2(ya.x, yb.x);
                *(LAS unsigned*)(sT + (ch0 + 1) * 72 + l) = pk2(ya.y, yb.y);
            }
            }
        }
        __syncthreads();
        if (M1P & 1) {
            const int h = wave, g = h >> 2;
            bf16x8 xf[4][2];
#pragma unroll
            for (int pt = 0; pt < 4; ++pt)
#pragma unroll
                for (int ks = 0; ks < 2; ++ks) xf[pt][ks] = *(const LAS bf16x8*)(sT + (h * 64 + 16 * pt + fr) * 72 + 32 * ks + 8 * fq);
            bf16* st = C.states + (size_t)(ck * 8 + h) * 64 * 128;
#pragma unroll 1
            for (int nt = 0; nt < 8; ++nt) {
                bf16x8 bfr[2];
#pragma unroll
                for (int ks = 0; ks < 2; ++ks) bfr[ks] = *(const LAS bf16x8*)(sT + (512 + g * 128 + 16 * nt + fr) * 72 + 32 * ks + 8 * fq);
#pragma unroll
                for (int pt = 0; pt < 4; ++pt) {
                    f32x4 acc = {0.f, 0.f, 0.f, 0.f};
#pragma unroll
                    for (int ks = 0; ks < 2; ++ks) acc = mfma16(bfr[ks], xf[pt][ks], acc);
                    u32x2 w; w.x = pk2(acc[0], acc[1]); w.y = pk2(acc[2], acc[3]);
                    *(u32x2*)(st + (16 * pt + fr) * 128 + 16 * nt + 4 * fq) = w;
                }
            }
        }
        __syncthreads();
        if (M1P & 2) {
            LAS bf16* G = (LAS bf16*)(C.lds + 8192);
            LAS float* CO = (LAS float*)(C.lds + 8192 + 48128);
            const int c = tid & 255, half = tid >> 8;
#pragma unroll
            for (int it = 0; it < 6; ++it) {
                const int u = tid + 512 * it, r = u >> 5, c8 = u & 31;
                if (u < 94 * 32) {
                    u32x4 o = {0u, 0u, 0u, 0u};
                    if (!(first && r < 30)) {
                        const bf16* p = C.proj + (size_t)(t0 - 30 + r) * NPROJ + PJ_GLU + 8 * c8;
                        const u32x4 av = *(const u32x4*)p, gv = *(const u32x4*)(p + 256);
#pragma unroll
                        for (int e = 0; e < 4; ++e) o[e] = pk2(bflo(av[e]) * fsigmoid(bflo(gv[e])), bfhi(av[e]) * fsigmoid(bfhi(gv[e])));
                    }
                    *(LAS u32x4*)(G + r * 256 + 8 * c8) = o;
                }
            }
            __syncthreads();
            {
                const float* dww = launder(C.in[10]) + (size_t)layer * 31 * 256 + c;
                float w[31];
#pragma unroll
                for (int k = 0; k < 31; ++k) w[k] = dww[k * 256];
                const float bias = launder(C.in[11])[layer * 256 + c];
#pragma unroll 1
                for (int grp = 0; grp < 4; ++grp) {
                    float o[8];
#pragma unroll
                    for (int i = 0; i < 8; ++i) o[i] = bias;
                    const LAS bf16* gp = G + (half * 32 + grp * 8) * 256 + c;
#pragma unroll
                    for (int r = 0; r < 38; ++r) {
                        const float v = bf2f(gp[r * 256]);
#pragma unroll
                        for (int i = 0; i < 8; ++i) { const int k = r - i; if (k >= 0 && k <= 30) o[i] += w[k] * v; }
                    }
#pragma unroll
                    for (int i = 0; i < 8; ++i) CO[(half * 32 + grp * 8 + i) * 256 + c] = o[i];
                }
            }
            __syncthreads();
            {
                const f32x4 lg = *((const f32x4*)(launder(C.in[12]) + layer * 256) + lane), lb = *((const f32x4*)(launder(C.in[13]) + layer * 256) + lane);
#pragma unroll 2
                for (int i = 0; i < 8; ++i) {
                    const int l = wave * 8 + i;
                    const f32x4 v = *((const LAS f32x4*)(CO + l * 256) + lane);
                    const float s = wave_sum((v[0] + v[1]) + (v[2] + v[3]), lane);
                    const float mu = s * (1.f / 256.f);
                    const f32x4 d = v - mu;
                    const float s2 = wave_sum((d[0] * d[0] + d[1] * d[1]) + (d[2] * d[2] + d[3] * d[3]), lane);
                    const float rstd = 1.0f / sqrtf(s2 * (1.f / 256.f) + 1e-6f);
                    const f32x4 y = d * rstd * lg + lb;
                    u32x2 w; w.x = pk2(fsilu(y[0]), fsilu(y[1])); w.y = pk2(fsilu(y[2]), fsilu(y[3]));
                    *((u32x2*)(C.mix + (size_t)(t0 + l) * DM + MX_C) + lane) = w;
                }
            }
        }
        __syncthreads();
        __syncthreads();
    }
}

__device__ __forceinline__ void aux_phase(const Ctx& C, int mode, int layer) {
    int cb = 0, ce = 0, gw = 0, ngw = 1;
    if (mode == 0) {
        const int NGW = C.nblk * 8; gw = C.bid * 8 + C.wave; const int lane = C.lane;
        const float* x = C.in[0];
    for (int row0 = gw * 2; row0 < M; row0 += NGW * 2) {
        f32x4 v[2][4];
#pragma unroll
        for (int r = 0; r < 2; ++r)
#pragma unroll
            for (int j = 0; j < 4; ++j) v[r][j] = __builtin_nontemporal_load((const f32x4*)(x + (size_t)(row0 + r) * DM) + lane + 64 * j);
#pragma unroll
        for (int r = 0; r < 2; ++r) {
            float s = 0.f;
#pragma unroll
            for (int j = 0; j < 4; ++j) s += (v[r][j][0] * v[r][j][0] + v[r][j][1] * v[r][j][1]) + (v[r][j][2] * v[r][j][2] + v[r][j][3] * v[r][j][3]);
            s = wave_sum(s, lane);
            u32x2* o = (u32x2*)(C.xb + (size_t)(row0 + r) * DM) + lane;
#pragma unroll
            for (int j = 0; j < 4; ++j) { u32x2 w; w.x = pk2(v[r][j][0], v[r][j][1]); w.y = pk2(v[r][j][2], v[r][j][3]); o[64 * j] = w; }
            if (lane < 16) C.ssq[(size_t)(row0 + r) * 16 + lane] = (lane == 0) ? s : 0.f;
        }
    }

        cb = 0; ce = P0_FIRST; ngw = NGW;
    }
    if (ce > cb) p0_convert(C, cb, ce, gw, ngw, (LAS float*)(C.lds + C.wave * 8448), C.lane);
}


__device__ __forceinline__ void scanatt_phase(const Ctx& C, int layer) {
    LAS float* sBias = (LAS float*)(C.lds + 143360);
    for (int i = C.tid; i < 4 * 257; i += 512) sBias[i] = C.in[3][layer * 4 * 257 + i] * LOG2E;
    const bool scanner = C.tid < 256;
    const int gt0 = C.bid * 256 + (C.tid & 255);
    const int sb_ = gt0 >> 15, se2 = gt0 & 32767;
    unsigned* sp = (unsigned*)C.states + (size_t)(sb_ & 1) * 128 * 32768 + se2;
    const float* scd = C.cdecay + (sb_ & 1) * 128 * 8 + (se2 >> 12);
    float s0 = 0.f, s1 = 0.f; int sc0 = (scanner && gt0 < 65536) ? 0 : 128;
    const int c2b = 2 * (layer == 0 ? P0_FIRST : P0_SPLIT), c2e = 2 * (layer == 0 ? P0_SPLIT : P0_ALL), cvsplit = c2e - ((layer == 0) ? 2048 : 1024), cngw2 = C.nblk * 4;
    const int cve2 = scanner ? c2e : cvsplit;
    int cit2 = scanner ? cvsplit + C.bid * 4 + C.wave : c2b + C.bid * 4 + (C.wave - 4);
    LAS float* scr = (LAS float*)(C.lds + 75776 + C.wave * 4352);
    bool pend_scan = false;
    P0Item pa = p0_decode(C, 0); int k0h = 0;
    unsigned fb[16]; bool pend = false;
#define BG_ISSUE() do { if (sc0 < 128) { _Pragma("unroll") for (int i_ = 0; i_ < 16; ++i_) fb[i_] = __builtin_nontemporal_load(sp + (size_t)(sc0 + i_) * 32768); pend = true; pend_scan = true; } \
        else if (cit2 < cve2) { pa = p0_decode(C, cit2 >> 1); k0h = pa.k0 + 32 * (cit2 & 1); const int c31_ = C.lane & 31; \
            _Pragma("unroll") for (int i_ = 0; i_ < 16; ++i_) { const int kk_ = 2 * i_ + (C.lane >> 5); fb[i_] = (c31_ < pa.valid) ? __float_as_uint(__builtin_nontemporal_load(pa.W + (size_t)(k0h + kk_) * pa.nsrc + pa.col + c31_)) : 0u; } \
            pend = true; pend_scan = false; } } while (0)
#define BG_CONSUME() do { if (pend) { if (pend_scan) { _Pragma("unroll") for (int i_ = 0; i_ < 16; ++i_) { const float d_ = scd[(sc0 + i_) * 8]; sp[(size_t)(sc0 + i_) * 32768] = pk2(s0, s1); \
                const unsigned u_ = fb[i_]; s0 = s0 * d_ + bflo(u_); s1 = s1 * d_ + bfhi(u_); } sc0 += 16; } \
            else { const int c31_ = C.lane & 31; \
                _Pragma("unroll") for (int i_ = 0; i_ < 16; ++i_) { const int kk_ = 2 * i_ + (C.lane >> 5); float v_ = __uint_as_float(fb[i_]); if (pa.gain) v_ *= pa.gain[k0h + kk_]; scr[kk_ * 33 + c31_] = v_; } \
                const int c_ = C.lane & 3; \
                _Pragma("unroll") for (int j_ = 0; j_ < 2; ++j_) { const int n_ = (C.lane >> 2) + 16 * j_; const LAS float* s_ = scr + (8 * c_) * 33 + n_; \
                    u32x4 o_; o_.x = pk2(s_[0 * 33], s_[1 * 33]); o_.y = pk2(s_[2 * 33], s_[3 * 33]); o_.z = pk2(s_[4 * 33], s_[5 * 33]); o_.w = pk2(s_[6 * 33], s_[7 * 33]); \
                    *(u32x4*)(pa.WT + (size_t)(pa.drow + n_) * pa.K + k0h + 8 * c_) = o_; } \
                cit2 += cngw2; } \
            pend = false; } } while (0)
    for (int ck = ((C.nblk & 7) == 0 ? (C.bid & 7) * (C.nblk >> 3) + (C.bid >> 3) : C.bid); ck < NCHUNK; ck += C.nblk) {
        int tid = C.tid; asm volatile("" : "+v"(tid));
        const int lane = tid & 63, wave = __builtin_amdgcn_readfirstlane(tid >> 6), fr = lane & 15, fq = lane >> 4;
        const int cin = ck & 127, t0 = ck * 64;
        {
            LAS bf16* sK = (LAS bf16*)(C.lds + 8192);
            LAS bf16* sV = (LAS bf16*)(C.lds + 8192 + 33792);
            const int h = wave >> 1, qh = wave & 1, q4 = (lane & 15) >> 2, p4 = lane & 3;
            bf16x8 qf[2][2];
#pragma unroll
            for (int qt = 0; qt < 2; ++qt)
#pragma unroll
                for (int ks = 0; ks < 2; ++ks) qf[qt][ks] = *(const bf16x8*)(C.proj + (size_t)(t0 + 32 * qh + 16 * qt + fr) * NPROJ + PJ_Q + h * 64 + 32 * ks + 8 * fq);
            float mrun[2] = {-1e30f, -1e30f}, lsum[2] = {0.f, 0.f};
            f32x4 oacc[4][2];
#pragma unroll
            for (int dt = 0; dt < 4; ++dt)
#pragma unroll
                for (int qt = 0; qt < 2; ++qt) oacc[dt][qt] = (f32x4){0.f, 0.f, 0.f, 0.f};
            const int jmin = cin >= 8 ? 0 : 8 - cin;
            u32x4 kreg[4], vreg[4];
#define ATT_LOAD(jj) do { const bf16* base_ = C.proj + (size_t)(t0 + ((jj) - 8) * 64) * NPROJ; _Pragma("unroll") for (int i = 0; i < 4; ++i) { const int u = tid + 512 * i, row = u >> 5, c8 = u & 31; \
                kreg[i] = *(const u32x4*)(base_ + (size_t)row * NPROJ + PJ_K + 8 * c8); vreg[i] = *(const u32x4*)(base_ + (size_t)row * NPROJ + PJ_V + 8 * c8); } } while (0)
            ATT_LOAD(jmin);
            for (int j = jmin; j <= 8; ++j) {
#pragma unroll
                for (int i = 0; i < 4; ++i) { const int u = tid + 512 * i, row = u >> 5, c8 = u & 31;
                    *(LAS u32x4*)(sK + row * 264 + 8 * c8) = kreg[i]; *(LAS u32x4*)(sV + row * 264 + 8 * c8) = vreg[i]; }
                __syncthreads();
                if (j < 8) ATT_LOAD(j + 1);
                BG_ISSUE();
                f32x4 st[4][2];
#pragma unroll
                for (int kt = 0; kt < 4; ++kt) {
                    bf16x8 kf[2];
#pragma unroll
                    for (int ks = 0; ks < 2; ++ks) kf[ks] = *(const LAS bf16x8*)(sK + (16 * kt + fr) * 264 + h * 64 + 32 * ks + 8 * fq);
#pragma unroll
                    for (int qt = 0; qt < 2; ++qt) { f32x4 acc = {0.f, 0.f, 0.f, 0.f};
#pragma unroll
                        for (int ks = 0; ks < 2; ++ks) acc = mfma16(kf[ks], qf[qt][ks], acc);
                        st[kt][qt] = acc; }
                }
                if (j >= 6) {
#pragma unroll
                    for (int kt = 0; kt < 4; ++kt)
#pragma unroll
                        for (int qt = 0; qt < 2; ++qt)
#pragma unroll
                            for (int e = 0; e < 4; ++e) {
                                const int rel = (32 * qh + 16 * qt + fr) + 512 - 64 * j - (16 * kt + 4 * fq + e);
                                const int idx = (rel < -128 ? -128 : (rel > 128 ? 128 : rel)) + 128;
                                st[kt][qt][e] += sBias[h * 257 + idx];
                            }
                } else {
                    const float bc = sBias[h * 257 + 256];
#pragma unroll
                    for (int kt = 0; kt < 4; ++kt)
#pragma unroll
                        for (int qt = 0; qt < 2; ++qt) st[kt][qt] = st[kt][qt] + bc;
                }
#pragma unroll
                for (int qt = 0; qt < 2; ++qt) {
                    float mx = -1e30f;
#pragma unroll
                    for (int kt = 0; kt < 4; ++kt)
#pragma unroll
                        for (int e = 0; e < 4; ++e) mx = fmaxf(mx, st[kt][qt][e]);
                    mx = fmaxf(mx, shflx(mx, 16, lane)); mx = fmaxf(mx, shflx(mx, 32, lane));
                    const float mnew = fmaxf(mrun[qt], mx), alpha = __builtin_amdgcn_exp2f(mrun[qt] - mnew);
                    mrun[qt] = mnew;
                    float ps = 0.f;
#pragma unroll
                    for (int kt = 0; kt < 4; ++kt)
#pragma unroll
                        for (int e = 0; e < 4; ++e) { const float p = __builtin_amdgcn_exp2f(st[kt][qt][e] - mnew); st[kt][qt][e] = p; ps += p; }
                    lsum[qt] = lsum[qt] * alpha + ps;
#pragma unroll
                    for (int dt = 0; dt < 4; ++dt) oacc[dt][qt] = oacc[dt][qt] * alpha;
                }
                bf16x8 pf[2][2];
#pragma unroll
                for (int s2 = 0; s2 < 2; ++s2)
#pragma unroll
                    for (int qt = 0; qt < 2; ++qt) {
                        u32x4 w; w.x = pk2(st[2 * s2][qt][0], st[2 * s2][qt][1]); w.y = pk2(st[2 * s2][qt][2], st[2 * s2][qt][3]);
                        w.z = pk2(st[2 * s2 + 1][qt][0], st[2 * s2 + 1][qt][1]); w.w = pk2(st[2 * s2 + 1][qt][2], st[2 * s2 + 1][qt][3]);
                        pf[s2][qt] = __builtin_bit_cast(bf16x8, w);
                    }
#pragma unroll
                for (int dt = 0; dt < 4; ++dt)
#pragma unroll
                    for (int s2 = 0; s2 < 2; ++s2) {
                        const s16x4 lo = __builtin_amdgcn_ds_read_tr16_b64_v4i16((LAS s16x4*)(sV + (32 * s2 + 4 * fq + q4) * 264 + h * 64 + 16 * dt + 4 * p4));
                        const s16x4 hi = __builtin_amdgcn_ds_read_tr16_b64_v4i16((LAS s16x4*)(sV + (32 * s2 + 16 + 4 * fq + q4) * 264 + h * 64 + 16 * dt + 4 * p4));
                        const bf16x8 vf = __builtin_shufflevector(lo, hi, 0, 1, 2, 3, 4, 5, 6, 7);
#pragma unroll
                        for (int qt = 0; qt < 2; ++qt) oacc[dt][qt] = mfma16(vf, pf[s2][qt], oacc[dt][qt]);
                    }
                BG_CONSUME();
                __syncthreads();
            }
#undef ATT_LOAD
#pragma unroll
            for (int qt = 0; qt < 2; ++qt) {
                float l = lsum[qt]; l += shflx(l, 16, lane); l += shflx(l, 32, lane);
                const float inv = 1.0f / l;
                bf16* op = C.mix + (size_t)(t0 + 32 * qh + 16 * qt + fr) * DM + MX_A + h * 64 + 4 * fq;
#pragma unroll
                for (int dt = 0; dt < 4; ++dt) { u32x2 w; w.x = pk2(oacc[dt][qt][0] * inv, oacc[dt][qt][1] * inv); w.y = pk2(oacc[dt][qt][2] * inv, oacc[dt][qt][3] * inv);
                    *(u32x2*)(op + 16 * dt) = w; }
            }
        }
        __syncthreads();
    }
    while (sc0 < 128 || cit2 < cve2) { BG_ISSUE(); BG_CONSUME(); }
#undef BG_ISSUE
#undef BG_CONSUME
    if (scanner)
        for (int gt = gt0 + C.nblk * 256; gt < 65536; gt += C.nblk * 256) {
            const int b = gt >> 15, e2 = gt & 32767;
            unsigned* q = (unsigned*)C.states + (size_t)b * 128 * 32768 + e2; const float* cd = C.cdecay + b * 128 * 8 + (e2 >> 12);
            float t0_ = 0.f, t1_ = 0.f;
#pragma unroll 1
            for (int c = 0; c < 128; ++c) { const unsigned u = q[(size_t)c * 32768]; const float d = cd[c * 8]; q[(size_t)c * 32768] = pk2(t0_, t1_); t0_ = t0_ * d + bflo(u); t1_ = t1_ * d + bfhi(u); }
        }
}

__device__ __forceinline__ void mix3_phase(const Ctx& C, int layer) {
    LAS float* sDT = (LAS float*)(C.lds); LAS float* sACS = (LAS float*)(C.lds + 2048); LAS float* sPART = (LAS float*)(C.lds + 4096);
    LAS bf16* sC = (LAS bf16*)(C.lds + 8192);
    LAS bf16* sB = (LAS bf16*)(C.lds + 41984);
    LAS float* sCB = (LAS float*)(C.lds + 41984);
    LAS bf16* sXT = (LAS bf16*)(C.lds + 75776);
    for (int ck = ((C.nblk & 7) == 0 ? (C.bid & 7) * (C.nblk >> 3) + (C.bid >> 3) : C.bid); ck < NCHUNK; ck += C.nblk) {
        int tid = C.tid; asm volatile("" : "+v"(tid));
        const int lane = tid & 63, wave = __builtin_amdgcn_readfirstlane(tid >> 6), fr = lane & 15, fq = lane >> 4;
        const int cin = ck & 127, t0 = ck * 64; const bool first = (cin == 0);
        const float* cw = launder(C.in[4]) + (size_t)layer * 4 * 1024; const float* cb = launder(C.in[5]) + layer * 1024;
        ssd_dt_acs(C, layer, ck, sDT, sACS, sPART, false, lane, wave);
        {
            const int ch0 = 2 * tid;
            const f32x2 w0 = *(const f32x2*)(cw + 0 * 1024 + ch0), w1 = *(const f32x2*)(cw + 1 * 1024 + ch0), w2 = *(const f32x2*)(cw + 2 * 1024 + ch0), w3 = *(const f32x2*)(cw + 3 * 1024 + ch0);
            const f32x2 bb = *(const f32x2*)(cb + ch0);
            const unsigned* src = (const unsigned*)(C.proj + (size_t)t0 * NPROJ + PJ_XBC + ch0);
            f32x2 xm3 = {0.f, 0.f}, xm2 = {0.f, 0.f}, xm1 = {0.f, 0.f};
            if (!first) { const unsigned a = src[-3 * (NPROJ / 2)], b = src[-2 * (NPROJ / 2)], c = src[-1 * (NPROJ / 2)];
                xm3 = (f32x2){bflo(a), bfhi(a)}; xm2 = (f32x2){bflo(b), bfhi(b)}; xm1 = (f32x2){bflo(c), bfhi(c)}; }
            LAS bf16* nat = (ch0 < 768) ? (sB + (ch0 - 512)) : (sC + (ch0 - 768));
#pragma unroll 1
            for (int l0 = 0; l0 < 64; l0 += 16) {
            unsigned uu[16];
#pragma unroll
            for (int i = 0; i < 16; ++i) uu[i] = src[(l0 + i) * (NPROJ / 2)];
#pragma unroll
            for (int li = 0; li < 16; li += 2) {
                const int l = l0 + li;
                const unsigned ua = uu[li], ub = uu[li + 1];
                const f32x2 xa = {bflo(ua), bfhi(ua)}, xc = {bflo(ub), bfhi(ub)};
                f32x2 ya = bb + w0 * xm3 + w1 * xm2 + w2 * xm1 + w3 * xa;
                f32x2 yb = bb + w0 * xm2 + w1 * xm1 + w2 * xa + w3 * xc;
                xm3 = xm1; xm2 = xa; xm1 = xc;
                ya.x = fsilu(ya.x); ya.y = fsilu(ya.y); yb.x = fsilu(yb.x); yb.y = fsilu(yb.y);
                if (ch0 < 512) {
                    *(LAS unsigned*)(sXT + ch0 * 72 + l) = pk2(ya.x, yb.x);
                    *(LAS unsigned*)(sXT + (ch0 + 1) * 72 + l) = pk2(ya.y, yb.y);
                } else {
                    *(LAS unsigned*)(nat + l * 264) = pk2(ya.x, ya.y);
                    *(LAS unsigned*)(nat + (l + 1) * 264) = pk2(yb.x, yb.y);
                }
            }
            }
        }
        __syncthreads();
        {
            const int g = wave >> 2, lt = wave & 3;
            f32x4 acc[4];
#pragma unroll
            for (int st = 0; st < 4; ++st) acc[st] = (f32x4){0.f, 0.f, 0.f, 0.f};
#pragma unroll
            for (int ks = 0; ks < 4; ++ks) {
                const bf16x8 af = *(const LAS bf16x8*)(sC + (16 * lt + fr) * 264 + g * 128 + 32 * ks + 8 * fq);
#pragma unroll
                for (int st = 0; st < 4; ++st) { const bf16x8 bfr = *(const LAS bf16x8*)(sB + (16 * st + fr) * 264 + g * 128 + 32 * ks + 8 * fq); acc[st] = mfma16(af, bfr, acc[st]); }
            }
            __syncthreads();
#pragma unroll
            for (int st = 0; st < 4; ++st)
#pragma unroll
                for (int e = 0; e < 4; ++e) sCB[(g * 64 + 16 * lt + 4 * fq + e) * 66 + 16 * st + fr] = acc[st][e];
        }
        __syncthreads();
        {
            const int h = wave, g = h >> 2;
            f32x4 acc[4][4];
#pragma unroll
            for (int lt = 0; lt < 4; ++lt)
#pragma unroll
                for (int pt = 0; pt < 4; ++pt) acc[lt][pt] = (f32x4){0.f, 0.f, 0.f, 0.f};
            const bf16* prev = C.states + (size_t)(ck * 8 + h) * 64 * 128;
#pragma unroll
            for (int ks = 0; ks < 4; ++ks) {
                bf16x8 cf[4];
#pragma unroll
                for (int lt = 0; lt < 4; ++lt) cf[lt] = *(const LAS bf16x8*)(sC + (16 * lt + fr) * 264 + g * 128 + 32 * ks + 8 * fq);
#pragma unroll
                for (int pt = 0; pt < 4; ++pt) {
                    const bf16x8 pfr = *(const bf16x8*)(prev + (16 * pt + fr) * 128 + 32 * ks + 8 * fq);
#pragma unroll
                    for (int lt = 0; lt < 4; ++lt) acc[lt][pt] = mfma16(pfr, cf[lt], acc[lt][pt]);
                }
                __builtin_amdgcn_sched_barrier(0);
            }
#pragma unroll
            for (int lt = 0; lt < 4; ++lt) {
                const float ea = fexp(sACS[h * 64 + 16 * lt + fr]);
#pragma unroll
                for (int pt = 0; pt < 4; ++pt) acc[lt][pt] = acc[lt][pt] * ea;
            }
#pragma unroll
            for (int ks2 = 0; ks2 < 2; ++ks2) {
                bf16x8 xf[4];
#pragma unroll
                for (int pt = 0; pt < 4; ++pt) xf[pt] = *(const LAS bf16x8*)(sXT + (h * 64 + 16 * pt + fr) * 72 + 32 * ks2 + 8 * fq);
                const f32x4 as0 = *(const LAS f32x4*)(sACS + h * 64 + 32 * ks2 + 8 * fq), as1 = *(const LAS f32x4*)(sACS + h * 64 + 32 * ks2 + 8 * fq + 4);
                const f32x4 dt0 = *(const LAS f32x4*)(sDT + h * 64 + 32 * ks2 + 8 * fq), dt1 = *(const LAS f32x4*)(sDT + h * 64 + 32 * ks2 + 8 * fq + 4);
#pragma unroll
                for (int lt = 0; lt < 4; ++lt) {
                    if (ks2 == 1 && lt < 2) continue;
                    const int l = 16 * lt + fr; const float al = sACS[h * 64 + l];
                    const LAS f32x2* cbp = (const LAS f32x2*)(sCB + (g * 64 + l) * 66 + 32 * ks2 + 8 * fq);
                    const f32x2 c01 = cbp[0], c23 = cbp[1], c45 = cbp[2], c67 = cbp[3];
                    const float cbv[8] = {c01.x, c01.y, c23.x, c23.y, c45.x, c45.y, c67.x, c67.y};
                    const float asv[8] = {as0[0], as0[1], as0[2], as0[3], as1[0], as1[1], as1[2], as1[3]};
                    const float dtv[8] = {dt0[0], dt0[1], dt0[2], dt0[3], dt1[0], dt1[1], dt1[2], dt1[3]};
                    float v[8];
#pragma unroll
                    for (int jj = 0; jj < 8; ++jj) { const int sidx = 32 * ks2 + 8 * fq + jj; const float t = cbv[jj] * fexp(al - asv[jj]) * dtv[jj]; v[jj] = (sidx <= l) ? t : 0.f; }
                    u32x4 w; w.x = pk2(v[0], v[1]); w.y = pk2(v[2], v[3]); w.z = pk2(v[4], v[5]); w.w = pk2(v[6], v[7]);
                    const bf16x8 af = __builtin_bit_cast(bf16x8, w);
#pragma unroll
                    for (int pt = 0; pt < 4; ++pt) acc[lt][pt] = mfma16(xf[pt], af, acc[lt][pt]);
                }
            }
            const float Dh = launder(C.in[8])[layer * 8 + h];
#pragma unroll
            for (int lt = 0; lt < 4; ++lt) {
                const int l = 16 * lt + fr; float q = 0.f;
#pragma unroll
                for (int pt = 0; pt < 4; ++pt) {
                    const int p0 = 16 * pt + 4 * fq;
                    const u32x2 zz = *(const u32x2*)(C.proj + (size_t)(t0 + l) * NPROJ + PJ_Z + h * 64 + p0);
                    const float zv[4] = {bflo(zz.x), bfhi(zz.x), bflo(zz.y), bfhi(zz.y)};
#pragma unroll
                    for (int e = 0; e < 4; ++e) {
                        const float xv = bf2f(sXT[(h * 64 + p0 + e) * 72 + l]);
                        const float y = (acc[lt][pt][e] + xv * Dh) * fsilu(zv[e]);
                        acc[lt][pt][e] = y; q += y * y;
                    }
                }
                q += shflx(q, 16, lane); q += shflx(q, 32, lane);
                if (fq == 0) sPART[h * 64 + l] = q;
            }
            __syncthreads();
            const float* ng = launder(C.in[9]) + layer * 512 + h * 64;
#pragma unroll
            for (int lt = 0; lt < 4; ++lt) {
                const int l = 16 * lt + fr;
                const float tot = (sPART[(4 * g) * 64 + l] + sPART[(4 * g + 1) * 64 + l]) + (sPART[(4 * g + 2) * 64 + l] + sPART[(4 * g + 3) * 64 + l]);
                const float rs = 1.0f / sqrtf(tot * (1.f / 256.f) + 1e-6f);
#pragma unroll
                for (int pt = 0; pt < 4; ++pt) {
                    const int p0 = 16 * pt + 4 * fq;
                    const f32x4 gg = *(const f32x4*)(ng + p0);
                    u32x2 w; w.x = pk2(acc[lt][pt][0] * rs * gg[0], acc[lt][pt][1] * rs * gg[1]); w.y = pk2(acc[lt][pt][2] * rs * gg[2], acc[lt][pt][3] * rs * gg[3]);
                    *(u32x2*)(C.mix + (size_t)(t0 + l) * DM + MX_B + h * 64 + p0) = w;
                }
            }
        }
        __syncthreads();
    }
}

__device__ __forceinline__ void final_phase(const Ctx& C) {
    const int gw = C.bid * 8 + C.wave, NGW = C.nblk * 8, lane = C.lane;
    f32x4 gg[2][2];
#pragma unroll
    for (int j = 0; j < 2; ++j) { gg[j][0] = *(const f32x4*)(C.in[19] + 512 * j + 8 * lane); gg[j][1] = *(const f32x4*)(C.in[19] + 512 * j + 8 * lane + 4); }
    for (int row0 = gw * 2; row0 < M; row0 += NGW * 2) {
        u32x4 v[2][2]; float rs[2];
#pragma unroll
        for (int r = 0; r < 2; ++r) {
            rs[r] = pg8::rstd_of(C.ssq, row0 + r);
#pragma unroll
            for (int j = 0; j < 2; ++j) v[r][j] = __builtin_nontemporal_load((const u32x4*)(C.xb + (size_t)(row0 + r) * DM + 512 * j + 8 * lane));
        }
#pragma unroll
        for (int r = 0; r < 2; ++r)
#pragma unroll
            for (int j = 0; j < 2; ++j) {
                const u32x4 w = v[r][j];
                const f32x4 a = {bflo(w.x), bfhi(w.x), bflo(w.y), bfhi(w.y)}, b = {bflo(w.z), bfhi(w.z), bflo(w.w), bfhi(w.w)};
                float* o = C.out + (size_t)(row0 + r) * DM + 512 * j + 8 * lane;
                *(f32x4*)o = a * rs[r] * gg[j][0]; *(f32x4*)(o + 4) = b * rs[r] * gg[j][1];
            }
    }
}

#define XB_TMO      128
#define XB_XCNT(j)  (256  + 64 * (j))
#define XB_XSUB(j)  (1280 + 64 * (j))
#define XB_XGEN(j)  (2304 + 64 * (j))
#define XB_TOP      3328
#define XB_TOPGEN   3392
#define XCD_BAR_WORDS 3456
#define XB_SPIN_CAP (1u << 18)

__device__ __forceinline__ unsigned xb_ld(unsigned* p)              { return __hip_atomic_load(p, __ATOMIC_RELAXED, __HIP_MEMORY_SCOPE_AGENT); }
__device__ __forceinline__ unsigned xb_add(unsigned* p, unsigned v) { return __hip_atomic_fetch_add(p, v, __ATOMIC_RELAXED, __HIP_MEMORY_SCOPE_AGENT); }
__device__ __forceinline__ unsigned xb_xcc_id() { return (unsigned)__builtin_amdgcn_s_getreg((3 << 11) | 20) & 0xFu; }
#define XB_SPIN(cond, bar) do { unsigned _sp = 0; while (cond) { __builtin_amdgcn_s_sleep(1); \
    if ((++_sp & 255u) == 0u) { if (xb_ld(&(bar)[XB_TMO])) break; if (_sp > XB_SPIN_CAP) { atomicAdd(&(bar)[XB_TMO], 1u); break; } } } } while (0)

struct XcdBarrier {
    unsigned* bar; unsigned x;
    volatile LAS unsigned* st;
};

__device__ __forceinline__ XcdBarrier xcd_barrier_post(unsigned* bar, volatile LAS unsigned* st) {
    XcdBarrier b; b.bar = bar; b.x = xb_xcc_id(); b.st = st;
    if (threadIdx.x == 0) (void)xb_add(&bar[XB_XCNT(b.x)], 1u);
    return b;
}
__device__ __forceinline__ void xcd_barrier_complete(unsigned* bar, unsigned x, unsigned& nloc, unsigned& nx) {
    const unsigned G = gridDim.x * gridDim.y * gridDim.z;
    unsigned sum, cnt, mine, sp = 0u;
    for (;;) {
        sum = 0u; cnt = 0u; mine = 0u;
#pragma unroll
        for (unsigned j = 0; j < 16; ++j) { const unsigned c = xb_ld(&bar[XB_XCNT(j)]); sum += c; cnt += (c > 0u) ? 1u : 0u; mine = (j == x) ? c : mine; }
        if (sum == G) break;
        __builtin_amdgcn_s_sleep(1);
        if ((++sp & 255u) == 0u) { if (xb_ld(&bar[XB_TMO])) break; if (sp > XB_SPIN_CAP) { atomicAdd(&bar[XB_TMO], 1u); break; } }
    }
    nloc = mine > 0u ? mine : 1u; nx = cnt > 0u ? cnt : 1u;
}

__device__ __forceinline__ void xcd_barrier(const XcdBarrier& b) {
    asm volatile("s_waitcnt vmcnt(0)" ::: "memory");
    __syncthreads();
    if (threadIdx.x == 0) {
        unsigned* bar = b.bar;
        __builtin_amdgcn_s_waitcnt(0);
        unsigned nloc = b.st[0], nx = b.st[1];
        if (nloc == 0u) { xcd_barrier_complete(bar, b.x, nloc, nx); b.st[0] = nloc; b.st[1] = nx; }
        const unsigned old = xb_add(&bar[XB_XSUB(b.x)], 1u);
        const unsigned gen = old / nloc;
        if (old + 1u == (gen + 1u) * nloc) {
            __builtin_amdgcn_fence(__ATOMIC_RELEASE, "agent");
            asm volatile("s_waitcnt vmcnt(0)" ::: "memory");
            const unsigned og = xb_add(&bar[XB_TOP], 1u);
            const unsigned tg = og / nx;
            if (og + 1u == (tg + 1u) * nx) xb_add(&bar[XB_TOPGEN], 1u);
            else XB_SPIN(xb_ld(&bar[XB_TOPGEN]) == tg, bar);
            __builtin_amdgcn_fence(__ATOMIC_ACQUIRE, "agent");
            xb_add(&bar[XB_XGEN(b.x)], 1u);
            asm volatile("s_waitcnt vmcnt(0)" ::: "memory");
        } else {
            XB_SPIN(xb_ld(&bar[XB_XGEN(b.x)]) == gen, bar);
            __builtin_amdgcn_fence(__ATOMIC_ACQUIRE, "agent");
            asm volatile("s_waitcnt vmcnt(0)" ::: "memory");
        }
    }
    __syncthreads();
}

#ifndef PHMASK
#define PHMASK 0x1ff
#endif
#define PHEN(x) (((PHMASK) >> (x)) & 1)
#define CAS __attribute__((address_space(4)))
__device__ __forceinline__ Ctx make_ctx(const CAS Args* ap, LAS unsigned char* lds, int tidv, int bid, int nblk) {
    Ctx C; C.bid = bid; C.nblk = nblk;
    C.lds = lds; C.tid = tidv; C.lane = tidv & 63; C.wave = __builtin_amdgcn_readfirstlane(tidv >> 6);
#pragma unroll
    for (int i = 0; i < 20; ++i) C.in[i] = ap->in[i];
    C.out = ap->out;
    unsigned char* ws = ap->ws;
    C.Win = (bf16*)(ws + WS_WIN); C.Wout = (bf16*)(ws + WS_WOUT); C.Wgu = (bf16*)(ws + WS_WGU); C.Wdn = (bf16*)(ws + WS_WDN);
    C.xb = (bf16*)(ws + WS_XB); C.mix = (bf16*)(ws + WS_MIX); C.states = (bf16*)(ws + WS_ST); C.proj = (bf16*)(ws + WS_PROJ);
    C.ssq = (float*)(ws + WS_SSQ); C.dtraw = (float*)(ws + WS_DT); C.cdecay = (float*)(ws + WS_CD);
    return C;
}
__global__ void __launch_bounds__(512, 2) fwd_kernel(Args a_unused) {
    extern __shared__ __attribute__((aligned(16))) unsigned char lds_raw[];
    cg::grid_group grid = cg::this_grid();
    LAS unsigned char* lds = (LAS unsigned char*)lds_raw;
    const CAS Args* ap0 = (const CAS Args*)__builtin_amdgcn_kernarg_segment_ptr();
    const int ph_lo = ap0->ph_lo, ph_hi = ap0->ph_hi, coop = ap0->coop;
    volatile LAS unsigned* MISC = (volatile LAS unsigned*)(lds + LDS_BYTES - 64);
    if (threadIdx.x < 16) MISC[threadIdx.x] = 0u;
    __syncthreads();
    unsigned* barw = (unsigned*)(ap0->ws);
    XcdBarrier bar; bar.bar = barw; bar.x = 0; bar.st = MISC;
    if (coop) bar = xcd_barrier_post(barw, MISC);
    for (int ph = ph_lo; ph < ph_hi; ++ph) {
        const CAS Args* ap = ap0; asm volatile("" : "+s"(ap));
        int tidv = threadIdx.x; asm volatile("" : "+v"(tidv));
        int bid = blockIdx.x, nblk = gridDim.x; asm volatile("" : "+s"(bid), "+s"(nblk));
        if (ph == NPHASES - 1) { if (PHEN(8)) { const Ctx C = make_ctx(ap, lds, tidv, bid, nblk); final_phase(C); } }
        else {
            const int l = (ph == 0) ? 0 : (ph - 1) / 7, t = (ph == 0) ? 2 : (ph - 1) % 7;
            if (t == 0 || t >= 4) { if (PHEN(1)) {
                const Ctx C = make_ctx(ap, lds, tidv, bid, nblk);
                pg8::Gemm g; int N;
                pg8::EpiAny E; E.e0 = pg8::EpiInProj{C.proj, C.dtraw, (const LAS float*)(lds + 131072)}; E.e1 = pg8::EpiResid{(l == 0 && t == 4) ? C.in[0] : (const float*)nullptr, C.xb, C.ssq}; E.e2 = pg8::EpiGateUp{C.proj, (const LAS float*)(lds + 131072)};
                if (t == 0)      { g = pg8::Gemm{C.xb, C.Win + (size_t)l * 3072 * 1024, M, 3072, 1024}; N = 3072; E.mode = 0; }
                else if (t == 4) { g = pg8::Gemm{C.mix, C.Wout + (size_t)l * 1024 * 1024, M, 1024, 1024}; N = 1024; E.mode = 1; }
                else if (t == 5) { g = pg8::Gemm{C.xb, C.Wgu + (size_t)l * 5632 * 1024, M, 5632, 1024}; N = 5632; E.mode = 2; }
                else             { g = pg8::Gemm{C.proj, C.Wdn + (size_t)l * 1024 * 2816, M, 1024, 2816}; N = 1024; E.mode = 1; }
                pg8::StaticOrder S; S.init(M, N, nblk, bid);
                LAS float* rsl = (LAS float*)(lds + 131072);
                if (E.mode != 1) {
                    pg8::Unit uu;
                    for (int i = 0; i < 16 && S.next(i, uu); ++i) if (tidv < 256) rsl[i * 256 + tidv] = pg8::rstd_of(C.ssq, uu.pm * 256 + tidv);
                    __syncthreads();
                }
                pg8::gemm_phase<pg8::EpiAny, pg8::StaticOrder, true, true>(lds, g, S, E, tidv); }
            } else if (t == 1) { if (PHEN(2)) { const Ctx C = make_ctx(ap, lds, tidv, bid, nblk); mix1_phase(C, l); } }
            else if (t == 2) { if (PHEN(3)) { const Ctx C = make_ctx(ap, lds, tidv, bid, nblk); if (ph == 0) aux_phase(C, 0, l); else scanatt_phase(C, l); } }
            else { if (PHEN(4)) { const Ctx C = make_ctx(ap, lds, tidv, bid, nblk); mix3_phase(C, l); } }
        }
        if (ph + 1 < ph_hi && coop) {
            if (coop == 2) grid.sync();
            xcd_barrier(bar);
        }
    }
}

#ifndef MK_MULTI
#define MK_MULTI 0
#endif
extern "C" void kernel_launch(void* const* d_in, const int* in_sizes, int n_in, void* d_out, int out_size, void* d_ws, size_t ws_size, hipStream_t stream) {
    static int grid = 0;
    if (grid == 0) {
        if (n_in != 20 || out_size != M * DM || ws_size < WS_END) { fprintf(stderr, "kernel_launch: unexpected shapes (n_in %d out %d ws %zu)\n", n_in, out_size, ws_size); grid = -1; return; }
        int dev = 0, cus = 0, per_cu = 0;
        hipGetDevice(&dev); hipDeviceGetAttribute(&cus, hipDeviceAttributeMultiprocessorCount, dev);
        if (hipFuncSetAttribute((const void*)fwd_kernel, hipFuncAttributeMaxDynamicSharedMemorySize, LDS_BYTES) != hipSuccess) { fprintf(stderr, "kernel_launch: hipFuncSetAttribute failed\n"); grid = -1; return; }
        if (hipOccupancyMaxActiveBlocksPerMultiprocessor(&per_cu, (const void*)fwd_kernel, 512, LDS_BYTES) != hipSuccess || per_cu < 1) { fprintf(stderr, "kernel_launch: occupancy query gave %d\n", per_cu); per_cu = 1; (void)hipGetLastError(); }
        grid = cus * per_cu; if (grid > 256) grid = 256;
    }
    if (grid < 0) return;
    Args a{};
    for (int i = 0; i < 20; ++i) a.in[i] = (const float*)d_in[i];
    a.out = (float*)d_out; a.ws = (unsigned char*)d_ws;
#if MK_MULTI
    a.coop = 0;
    for (int ph = 0; ph < NPHASES; ++ph) { a.ph_lo = ph; a.ph_hi = ph + 1; hipLaunchKernelGGL(fwd_kernel, dim3(grid), dim3(512), LDS_BYTES, stream, a); }
#else
    a.coop = 1; a.ph_lo = 0; a.ph_hi = NPHASES;
    if (hipMemsetAsync(d_ws, 0, 32768, stream) != hipSuccess) { fprintf(stderr, "kernel_launch: hipMemsetAsync failed\n"); return; }
    void* args[] = {&a};
    hipError_t e = hipLaunchCooperativeKernel((const void*)fwd_kernel, dim3(grid), dim3(512), args, LDS_BYTES, stream);
    if (e != hipSuccess) fprintf(stderr, "kernel_launch: cooperative launch failed: %s (grid %d)\n", hipGetErrorString(e), grid);
#endif
}
```
